# Optimizing an MI355X kernel written in HIP

```python
import jax, jax.numpy as jnp
from jax import lax
import numpy as np

D_MODEL = 1024
BATCH = 2
SEQ = 8192
DEPTH = 2

N_MEM = 256
D_A = D_MODEL // 2
D_B = D_MODEL // 2
A_KERNEL = 31
B_KERNEL = 3
D_EVEN_IN = 2 * D_A + 3 * D_B
CHUNK = 128
C_GROUPS = 8
D_C = D_MODEL
C_GROUP_DIM = D_C // C_GROUPS
XA_HEADS = 4
XA_HEAD_DIM = D_MODEL // XA_HEADS
D_FF = ((8 * D_MODEL // 3 + 255) // 256) * 256
N_EVEN = (DEPTH + 1) // 2
N_ODD = DEPTH // 2
RMS_EPS = 1e-6
LN_EPS = 1e-5

kernel_name = 'hybrid_conv_sgu_memxattn_encoder'


def rms_norm(x, g):
    xf = x.astype(jnp.float32)
    y = xf * lax.rsqrt(jnp.mean(xf * xf, axis=-1, keepdims=True) + RMS_EPS)
    return (y * g.astype(jnp.float32)).astype(x.dtype)


def layer_norm(x, g, b):
    xf = x.astype(jnp.float32)
    mu = jnp.mean(xf, axis=-1, keepdims=True)
    var = jnp.mean(jnp.square(xf - mu), axis=-1, keepdims=True)
    y = (xf - mu) * lax.rsqrt(var + LN_EPS)
    return (y * g.astype(jnp.float32) + b.astype(jnp.float32)).astype(x.dtype)


def depthwise_conv(x, w, b):
    k = w.shape[0]
    pad = k // 2
    y = lax.conv_general_dilated(
        x, w[:, None, :].astype(x.dtype), window_strides=(1,),
        padding=[(pad, pad)], dimension_numbers=('NWC', 'WIO', 'NWC'),
        feature_group_count=x.shape[-1])
    return y + b


def conv_pair_mixer(n, w_in, a_conv_w, a_conv_b, a_ln_g, a_ln_b, b_conv_w, b_conv_b, w_out):
    z = n @ w_in
    a_val, a_gate, b_h, b_gb, b_gc = jnp.split(
        z, [D_A, 2 * D_A, 2 * D_A + D_B, 2 * D_A + 2 * D_B], axis=-1)
    a = a_val * jax.nn.sigmoid(a_gate)
    a = depthwise_conv(a, a_conv_w, a_conv_b)
    a = jax.nn.silu(layer_norm(a, a_ln_g, a_ln_b))
    b = b_gb * depthwise_conv(b_gc * b_h, b_conv_w, b_conv_b)
    return jnp.concatenate([a, b], axis=-1) @ w_out


def chunked_sgu_mixer(n, w_in, c_ln_g, c_ln_b, w_s, b_s, w_out):
    bsz, s, _ = n.shape
    z = jax.nn.gelu(n @ w_in)
    u, v = jnp.split(z, 2, axis=-1)
    v = layer_norm(v, c_ln_g, c_ln_b)
    v = v.reshape(bsz, s // CHUNK, CHUNK, C_GROUPS, C_GROUP_DIM)
    sv = jnp.einsum('gpq,bnqgc->bnpgc', w_s, v) + jnp.transpose(b_s)[:, :, None]
    y = u * sv.reshape(bsz, s, D_C)
    return y @ w_out


def memory_cross_attention(n, mem_n, w_q, w_k, w_v, w_o):
    bsz, s, _ = n.shape
    m = mem_n.shape[1]
    q = (n @ w_q).reshape(bsz, s, XA_HEADS, XA_HEAD_DIM)
    k = (mem_n @ w_k).reshape(bsz, m, XA_HEADS, XA_HEAD_DIM)
    v = (mem_n @ w_v).reshape(bsz, m, XA_HEADS, XA_HEAD_DIM)
    scores = jnp.einsum('bshd,bmhd->bhsm', q, k).astype(jnp.float32) * (XA_HEAD_DIM ** -0.5)
    p = jax.nn.softmax(scores, axis=-1).astype(v.dtype)
    o = jnp.einsum('bhsm,bmhd->bshd', p, v).reshape(bsz, s, D_MODEL)
    return o @ w_o


def swiglu(n, w_gate, w_up, w_down):
    return (jax.nn.silu(n @ w_gate) * (n @ w_up)) @ w_down


def setup_inputs(seed: int = 0) -> dict:
    key = jax.random.key(seed)
    ks = iter(jax.random.split(key, 40))

    def nrm(shape, scale):
        return jax.random.normal(next(ks), shape, jnp.float32) * scale

    def gain(shape):
        return 1.0 + 0.1 * jax.random.normal(next(ks), shape, jnp.float32)

    D = D_MODEL
    return {
        'x': nrm((BATCH, SEQ, D), 1.0),
        'mem': nrm((BATCH, N_MEM, D), 1.0),
        'g_mix': gain((DEPTH, D)),
        'g_xattn': gain((DEPTH, D)),
        'g_mem': gain((DEPTH, D)),
        'g_ffn': gain((DEPTH, D)),
        'g_final': gain((D,)),
        'ev_w_in': nrm((N_EVEN, D, D_EVEN_IN), D ** -0.5),
        'ev_a_conv_w': nrm((N_EVEN, A_KERNEL, D_A), A_KERNEL ** -0.5),
        'ev_a_conv_b': nrm((N_EVEN, D_A), 0.02),
        'ev_a_ln_g': gain((N_EVEN, D_A)),
        'ev_a_ln_b': nrm((N_EVEN, D_A), 0.02),
        'ev_b_conv_w': nrm((N_EVEN, B_KERNEL, D_B), B_KERNEL ** -0.5),
        'ev_b_conv_b': nrm((N_EVEN, D_B), 0.02),
        'ev_w_out': nrm((N_EVEN, D_A + D_B, D), (D_A + D_B) ** -0.5),
        'od_w_in': nrm((N_ODD, D, 2 * D_C), D ** -0.5),
        'od_c_ln_g': gain((N_ODD, D_C)),
        'od_c_ln_b': nrm((N_ODD, D_C), 0.02),
        'od_w_s': nrm((N_ODD, C_GROUPS, CHUNK, CHUNK), CHUNK ** -0.5),
        'od_b_s': gain((N_ODD, C_GROUPS, CHUNK)),
        'od_w_out': nrm((N_ODD, D_C, D), D_C ** -0.5),
        'xa_w_q': nrm((DEPTH, D, D), D ** -0.5),
        'xa_w_k': nrm((DEPTH, D, D), D ** -0.5),
        'xa_w_v': nrm((DEPTH, D, D), D ** -0.5),
        'xa_w_o': nrm((DEPTH, D, D), D ** -0.5),
        'ffn_w_gate': nrm((DEPTH, D, D_FF), D ** -0.5),
        'ffn_w_up': nrm((DEPTH, D, D_FF), D ** -0.5),
        'ffn_w_down': nrm((DEPTH, D_FF, D), D_FF ** -0.5),
    }


def reference(x, mem, g_mix, g_xattn, g_mem, g_ffn, g_final,
              ev_w_in, ev_a_conv_w, ev_a_conv_b, ev_a_ln_g, ev_a_ln_b,
              ev_b_conv_w, ev_b_conv_b, ev_w_out,
              od_w_in, od_c_ln_g, od_c_ln_b, od_w_s, od_b_s, od_w_out,
              xa_w_q, xa_w_k, xa_w_v, xa_w_o,
              ffn_w_gate, ffn_w_up, ffn_w_down):
    h = x
    for i in range(DEPTH):
        j = i // 2
        n = rms_norm(h, g_mix[i])
        if i % 2 == 0:
            h = h + conv_pair_mixer(n, ev_w_in[j], ev_a_conv_w[j], ev_a_conv_b[j],
                                    ev_a_ln_g[j], ev_a_ln_b[j], ev_b_conv_w[j],
                                    ev_b_conv_b[j], ev_w_out[j])
        else:
            h = h + chunked_sgu_mixer(n, od_w_in[j], od_c_ln_g[j], od_c_ln_b[j],
                                      od_w_s[j], od_b_s[j], od_w_out[j])
        mem_n = rms_norm(mem, g_mem[i])
        h = h + memory_cross_attention(rms_norm(h, g_xattn[i]), mem_n,
                                       xa_w_q[i], xa_w_k[i], xa_w_v[i], xa_w_o[i])
        h = h + swiglu(rms_norm(h, g_ffn[i]), ffn_w_gate[i], ffn_w_up[i], ffn_w_down[i])
    return rms_norm(h, g_final)
```

```cpp
#include <hip/hip_runtime.h>
#include <hip/hip_cooperative_groups.h>
#include <cstdio>
#include <cstdint>
namespace cg = cooperative_groups;
namespace pg8 {
#define PG8_LAS __attribute__((address_space(3)))
typedef unsigned short bf16_t;
typedef short bf16x8 __attribute__((ext_vector_type(8)));
typedef float f32x4 __attribute__((ext_vector_type(4)));
typedef unsigned u32x4 __attribute__((ext_vector_type(4)));
constexpr int BM = 256, BK = 64, HALF = 128, HTB = HALF * BK * 2  , STAGE_BYTES = 8 * HTB, NXCD = 8, WGM = 8;

__host__ __device__ __forceinline__ int lds_byte(int r, int c) { const int st = (r >> 4) * 2 + (c >> 5), rr = r & 15, cc = c & 31, ob = rr * 64 + cc * 2; return st * 1024 + (ob ^ (((ob >> 9) & 1) << 5)); }
__host__ __device__ __forceinline__ void stage_rc(int b, int& R, int& C) { const int st = b / 1024, sb = b % 1024, swz = sb ^ (((sb >> 9) & 1) << 5); R = (st >> 1) * 16 + swz / 64; C = (st & 1) * 32 + (swz % 64) / 2; }
__host__ __device__ __forceinline__ int perm32(int rho) { const int n = rho >> 4, i = rho & 15; return 8 * (i >> 2) + 4 * n + (i & 3); }

struct Unit { int pm, pn; };
struct Gemm { const bf16_t* A; const bf16_t* Bt; int M, N, K; };

struct StaticOrder {
    int nM, nN, nwg, G, c;
    __host__ __device__ void init(int M, int N, int G_, int c_) { nM = M / BM; nN = N / BM; nwg = nM * nN; G = G_; c = c_; }
    __host__ __device__ bool next(int i, Unit& u) const {
        const long L = (long)i * G + c; if (L >= nwg) return false;
        int wgid = (int)L; { const int q = nwg / NXCD, r = nwg % NXCD, xcd = wgid % NXCD, off = wgid / NXCD; wgid = (xcd < r ? xcd * (q + 1) : r * (q + 1) + (xcd - r) * q) + off; }
        const int nig = WGM * nN, gid = wgid / nig, fm = gid * WGM, gsz = (nM - fm) < WGM ? (nM - fm) : WGM;
        u.pm = fm + ((wgid % nig) % gsz); u.pn = (wgid % nig) / gsz; return true;
    }
    __device__ __forceinline__ void a_ready(const Unit&) const {}
    __device__ __forceinline__ void done(const Unit&) const {}
};

__device__ __forceinline__ unsigned cvt_pk_bf16(float lo, float hi) { unsigned r; asm volatile("v_cvt_pk_bf16_f32 %0, %1, %2" : "=v"(r) : "v"(lo), "v"(hi)); return r; }
typedef float f32x2 __attribute__((ext_vector_type(2)));
template <class Epi, class Sched, bool ALIGN_EPI = false, bool SP2 = false>
__device__ __forceinline__ void gemm_phase(PG8_LAS unsigned char* lds, const Gemm g, const Sched& S, const Epi& E) {
    int tid_ = threadIdx.x; asm volatile("" : "+v"(tid_));
    const int tid = tid_, wid = __builtin_amdgcn_readfirstlane(tid >> 6), lane = tid & 63, wr = wid >> 2, wc = wid & 3, fr = lane & 15, fq = lane >> 4;
    const int K = g.K, nt = K / BK;
    unsigned voffA[2], voffB[2];
#pragma unroll
    for (int i = 0; i < 2; ++i) { int R, C; stage_rc(tid * 16 + i * 8192, R, C); const int Rb = Epi::PERM ? ((R & ~31) + perm32(R & 31)) : R;
        voffA[i] = (unsigned)(R * K + C) * 2u; voffB[i] = (unsigned)(Rb * K + C) * 2u; }
    const size_t kstep = (size_t)(BK * 2);
    const size_t hstep = (size_t)HALF * K * 2;
    const size_t tstep = 2 * hstep;
    const unsigned ldsw = (unsigned)wid * 1024u;
    const int aoff = lds_byte(wr * 64 + fr, fq * 8), boff = lds_byte(wc * 32 + fr, fq * 8);
#define PG8_SA(b, h) (((b) * 2 + (h)) * HTB)
#define PG8_SB(b, h) ((4 + (b) * 2 + (h)) * HTB)
#define PG8_STAGE(bufoff, gbase, voff) do { _Pragma("unroll") for (int _i = 0; _i < 2; ++_i) \
        __builtin_amdgcn_global_load_lds((const unsigned*)((const char*)(gbase) + (voff)[_i]), (PG8_LAS unsigned*)(lds + (bufoff) + ldsw + _i * 8192), 16, 0, 0); } while (0)
#define PG8_LDA(dst, b, h) do { _Pragma("unroll") for (int m = 0; m < 4; ++m) _Pragma("unroll") for (int k = 0; k < 2; ++k) dst[m][k] = *(const PG8_LAS bf16x8*)(lds + PG8_SA(b, h) + aoff + m * 2048 + k * 1024); } while (0)
#define PG8_LDB(dst, b, h) do { _Pragma("unroll") for (int n = 0; n < 2; ++n) _Pragma("unroll") for (int k = 0; k < 2; ++k) dst[n][k] = *(const PG8_LAS bf16x8*)(lds + PG8_SB(b, h) + boff + n * 2048 + k * 1024); } while (0)
#define PG8_MMA(ai, bj, At, Bt) do { __builtin_amdgcn_s_setprio(1); _Pragma("unroll") for (int m = 0; m < 4; ++m) _Pragma("unroll") for (int n = 0; n < 2; ++n) _Pragma("unroll") for (int k = 0; k < 2; ++k) \
        acc[ai][bj][m][n] = __builtin_amdgcn_mfma_f32_16x16x32_bf16(Bt[n][k], At[m][k], acc[ai][bj][m][n], 0, 0, 0); __builtin_amdgcn_s_setprio(0); } while (0)
#define PG8_WAIT_V(n) asm volatile("s_waitcnt vmcnt(" #n ")" ::: "memory")
#define PG8_WAIT_L(n) asm volatile("s_waitcnt lgkmcnt(" #n ")" ::: "memory")
#define PG8_BAR __builtin_amdgcn_s_barrier()
#define PG8_SCHED __builtin_amdgcn_sched_barrier(0)
    Unit cur, nxt; int ui = 0;
    if (!S.next(0, cur)) return;
    f32x4 acc[2][2][4][2];
#pragma unroll
    for (int a = 0; a < 2; ++a)
#pragma unroll
        for (int b = 0; b < 2; ++b)
#pragma unroll
            for (int m = 0; m < 4; ++m)
#pragma unroll
                for (int n = 0; n < 2; ++n) acc[a][b][m][n] = (f32x4){0.f, 0.f, 0.f, 0.f};
    bf16x8 At[4][2], B0[2][2], B1[2][2];
    const char* cA = (const char*)g.A + (size_t)cur.pm * tstep; const char* cB = (const char*)g.Bt + (size_t)cur.pn * tstep;
    S.a_ready(cur);
    if constexpr (SP2) {
        PG8_STAGE(PG8_SB(0, 0), cB, voffB); PG8_STAGE(PG8_SB(0, 1), cB + hstep, voffB); PG8_STAGE(PG8_SA(0, 0), cA, voffA); PG8_STAGE(PG8_SA(0, 1), cA + hstep, voffA);
        if (wr == 1) PG8_BAR;
        PG8_WAIT_V(2); PG8_BAR;
        PG8_STAGE(PG8_SB(1, 0), cB + kstep, voffB); PG8_STAGE(PG8_SA(1, 0), cA + kstep, voffA); PG8_STAGE(PG8_SB(1, 1), cB + hstep + kstep, voffB);
        PG8_WAIT_V(6); PG8_BAR;
    } else {
        PG8_STAGE(PG8_SB(0, 0), cB, voffB); PG8_STAGE(PG8_SA(0, 0), cA, voffA); PG8_STAGE(PG8_SB(0, 1), cB + hstep, voffB); PG8_STAGE(PG8_SA(0, 1), cA + hstep, voffA);
        if (wr == 1) PG8_BAR;
        PG8_WAIT_V(4); PG8_BAR;
        PG8_STAGE(PG8_SB(1, 0), cB + kstep, voffB); PG8_STAGE(PG8_SA(1, 0), cA + kstep, voffA); PG8_STAGE(PG8_SB(1, 1), cB + hstep + kstep, voffB);
        PG8_WAIT_V(6); PG8_BAR;
    }
    for (;;) {
        const bool has_next = S.next(ui + 1, nxt);
        const char* nA = has_next ? (const char*)g.A + (size_t)nxt.pm * tstep : cA; const char* nB = has_next ? (const char*)g.Bt + (size_t)nxt.pn * tstep : cB;
        for (int t = 0; t < nt; t += 2) {
            const bool last = (t == nt - 2);
            const char* a1 = cA + (size_t)(t + 1) * kstep;
            const char* a2 = last ? nA : cA + (size_t)(t + 2) * kstep; const char* b2 = last ? nB : cB + (size_t)(t + 2) * kstep;
            const char* a3 = a2 + kstep; const char* b3 = b2 + kstep;
            if (last && has_next) S.a_ready(nxt);
            if constexpr (SP2) {
            PG8_LDB(B0, 0, 0); PG8_LDB(B1, 0, 1); PG8_SCHED; PG8_LDA(At, 0, 0); PG8_STAGE(PG8_SA(1, 1), a1 + hstep, voffA);
            PG8_WAIT_V(8); PG8_WAIT_L(0); PG8_BAR; PG8_MMA(0, 0, At, B0); PG8_MMA(0, 1, At, B1); PG8_BAR; PG8_SCHED;
            PG8_LDA(At, 0, 1); PG8_STAGE(PG8_SB(0, 0), b2, voffB); PG8_STAGE(PG8_SB(0, 1), b2 + hstep, voffB); PG8_STAGE(PG8_SA(0, 0), a2, voffA);
            PG8_WAIT_V(8); PG8_WAIT_L(0); PG8_BAR; PG8_MMA(1, 0, At, B0); PG8_MMA(1, 1, At, B1); PG8_BAR; PG8_SCHED;
            PG8_LDB(B0, 1, 0); PG8_LDB(B1, 1, 1); PG8_SCHED; PG8_LDA(At, 1, 0); PG8_STAGE(PG8_SA(0, 1), a2 + hstep, voffA);
            PG8_WAIT_V(8); PG8_WAIT_L(0); PG8_BAR; PG8_MMA(0, 0, At, B0); PG8_MMA(0, 1, At, B1); PG8_BAR; PG8_SCHED;
            PG8_LDA(At, 1, 1); PG8_STAGE(PG8_SB(1, 0), b3, voffB); PG8_STAGE(PG8_SB(1, 1), b3 + hstep, voffB); PG8_STAGE(PG8_SA(1, 0), a3, voffA);
            PG8_WAIT_V(8); PG8_WAIT_L(0); PG8_BAR; PG8_MMA(1, 0, At, B0); PG8_MMA(1, 1, At, B1); PG8_BAR; PG8_SCHED;
            } else {
            PG8_LDB(B0, 0, 0); PG8_SCHED; PG8_LDA(At, 0, 0); PG8_STAGE(PG8_SA(1, 1), a1 + hstep, voffA);
            PG8_WAIT_L(8); PG8_BAR; PG8_WAIT_L(0); PG8_MMA(0, 0, At, B0); PG8_BAR; PG8_SCHED;
            PG8_LDB(B1, 0, 1); PG8_STAGE(PG8_SB(0, 0), b2, voffB);
            PG8_BAR; PG8_WAIT_L(0); PG8_MMA(0, 1, At, B1); PG8_BAR;
            PG8_LDA(At, 0, 1); PG8_STAGE(PG8_SA(0, 0), a2, voffA);
            PG8_BAR; PG8_WAIT_L(0); PG8_MMA(1, 0, At, B0); PG8_BAR; PG8_SCHED;
            PG8_STAGE(PG8_SB(0, 1), b2 + hstep, voffB);
            PG8_WAIT_V(6); PG8_BAR; PG8_MMA(1, 1, At, B1); PG8_BAR;
            PG8_LDB(B0, 1, 0); PG8_SCHED; PG8_LDA(At, 1, 0); PG8_STAGE(PG8_SA(0, 1), a2 + hstep, voffA);
            PG8_WAIT_L(8); PG8_BAR; PG8_WAIT_L(0); PG8_MMA(0, 0, At, B0); PG8_BAR; PG8_SCHED;
            PG8_LDB(B1, 1, 1); PG8_STAGE(PG8_SB(1, 0), b3, voffB);
            PG8_BAR; PG8_WAIT_L(0); PG8_MMA(0, 1, At, B1); PG8_BAR;
            PG8_LDA(At, 1, 1); PG8_STAGE(PG8_SA(1, 0), a3, voffA);
            PG8_BAR; PG8_WAIT_L(0); PG8_MMA(1, 0, At, B0); PG8_BAR; PG8_SCHED;
            PG8_STAGE(PG8_SB(1, 1), b3 + hstep, voffB);
            PG8_WAIT_V(6); PG8_BAR; PG8_MMA(1, 1, At, B1); PG8_BAR;
            }
        }
        if constexpr (ALIGN_EPI) { if (wr == 0) PG8_BAR; }
        if constexpr (!Epi::AFTER_DRAIN) { E(acc, cur, wr, wc, fr, fq); S.done(cur); }
        if (!has_next) break;
#pragma unroll
        for (int a = 0; a < 2; ++a)
#pragma unroll
            for (int b = 0; b < 2; ++b)
#pragma unroll
                for (int m = 0; m < 4; ++m)
#pragma unroll
                    for (int n = 0; n < 2; ++n) acc[a][b][m][n] = (f32x4){0.f, 0.f, 0.f, 0.f};
        cur = nxt; cA = nA; cB = nB; ++ui;
        if constexpr (ALIGN_EPI) { if (wr == 1) PG8_BAR; }
    }
    PG8_WAIT_V(0);
    if constexpr (!ALIGN_EPI) { if (wr == 0) PG8_BAR; }
    PG8_BAR;
    if constexpr (Epi::AFTER_DRAIN) { E.fused(acc, cur, wr, wc, fr, fq, lds, wid, lane); S.done(cur); }
#undef PG8_SA
#undef PG8_SB
#undef PG8_STAGE
#undef PG8_LDA
#undef PG8_LDB
#undef PG8_MMA
#undef PG8_WAIT_V
#undef PG8_WAIT_L
#undef PG8_BAR
#undef PG8_SCHED
}
}
#define LAS __attribute__((address_space(3)))
#define XB_TMO      128
#define XB_XCNT(j)  (256  + 64 * (j))
#define XB_XSUB(j)  (1280 + 64 * (j))
#define XB_XGEN(j)  (2304 + 64 * (j))
#define XB_TOP      3328
#define XB_TOPGEN   3392
#define XCD_BAR_WORDS 3456
#define XB_SPIN_CAP (1u << 18)

__device__ __forceinline__ unsigned xb_ld(unsigned* p)              { return __hip_atomic_load(p, __ATOMIC_RELAXED, __HIP_MEMORY_SCOPE_AGENT); }
__device__ __forceinline__ unsigned xb_add(unsigned* p, unsigned v) { return __hip_atomic_fetch_add(p, v, __ATOMIC_RELAXED, __HIP_MEMORY_SCOPE_AGENT); }
__device__ __forceinline__ unsigned xb_xcc_id() { return (unsigned)__builtin_amdgcn_s_getreg((3 << 11) | 20) & 0xFu; }
#define XB_SPIN(cond, bar) do { unsigned _sp = 0; while (cond) { __builtin_amdgcn_s_sleep(1); \
    if ((++_sp & 255u) == 0u) { if (xb_ld(&(bar)[XB_TMO])) break; if (_sp > XB_SPIN_CAP) { atomicAdd(&(bar)[XB_TMO], 1u); break; } } } } while (0)

struct XcdBarrier {
    unsigned* bar; unsigned x;
    volatile LAS unsigned* st;
};

__device__ __forceinline__ XcdBarrier xcd_barrier_post(unsigned* bar, volatile LAS unsigned* st) {
    XcdBarrier b; b.bar = bar; b.x = xb_xcc_id(); b.st = st;
    if (threadIdx.x == 0) (void)xb_add(&bar[XB_XCNT(b.x)], 1u);
    return b;
}
__device__ __forceinline__ void xcd_barrier_complete(unsigned* bar, unsigned x, unsigned& nloc, unsigned& nx) {
    const unsigned G = gridDim.x * gridDim.y * gridDim.z;
    unsigned sum, cnt, mine, sp = 0u;
    for (;;) {
        sum = 0u; cnt = 0u; mine = 0u;
#pragma unroll
        for (unsigned j = 0; j < 16; ++j) { const unsigned c = xb_ld(&bar[XB_XCNT(j)]); sum += c; cnt += (c > 0u) ? 1u : 0u; mine = (j == x) ? c : mine; }
        if (sum == G) break;
        __builtin_amdgcn_s_sleep(1);
        if ((++sp & 255u) == 0u) { if (xb_ld(&bar[XB_TMO])) break; if (sp > XB_SPIN_CAP) { atomicAdd(&bar[XB_TMO], 1u); break; } }
    }
    nloc = mine > 0u ? mine : 1u; nx = cnt > 0u ? cnt : 1u;
}

__device__ __forceinline__ void xcd_barrier(const XcdBarrier& b) {
    asm volatile("s_waitcnt vmcnt(0)" ::: "memory");
    __syncthreads();
    if (threadIdx.x == 0) {
        unsigned* bar = b.bar;
        __builtin_amdgcn_s_waitcnt(0);
        unsigned nloc = b.st[0], nx = b.st[1];
        if (nloc == 0u) { xcd_barrier_complete(bar, b.x, nloc, nx); b.st[0] = nloc; b.st[1] = nx; }
        const unsigned old = xb_add(&bar[XB_XSUB(b.x)], 1u);
        const unsigned gen = old / nloc;
        if (old + 1u == (gen + 1u) * nloc) {
            __builtin_amdgcn_fence(__ATOMIC_RELEASE, "agent");
            asm volatile("s_waitcnt vmcnt(0)" ::: "memory");
            const unsigned og = xb_add(&bar[XB_TOP], 1u);
            const unsigned tg = og / nx;
            if (og + 1u == (tg + 1u) * nx) xb_add(&bar[XB_TOPGEN], 1u);
            else XB_SPIN(xb_ld(&bar[XB_TOPGEN]) == tg, bar);
            __builtin_amdgcn_fence(__ATOMIC_ACQUIRE, "agent");
            xb_add(&bar[XB_XGEN(b.x)], 1u);
            asm volatile("s_waitcnt vmcnt(0)" ::: "memory");
        } else {
            XB_SPIN(xb_ld(&bar[XB_XGEN(b.x)]) == gen, bar);
            __builtin_amdgcn_fence(__ATOMIC_ACQUIRE, "agent");
            asm volatile("s_waitcnt vmcnt(0)" ::: "memory");
        }
    }
    __syncthreads();
}
#undef LAS
using namespace pg8;
#define LAS __attribute__((address_space(3)))
typedef unsigned u32x2 __attribute__((ext_vector_type(2)));

constexpr int NWAVES = 8, NTHR = 512;
constexpr int SEQ = 8192, NBATCH = 2, T = NBATCH * SEQ, D = 1024, DZ0 = 2560, DZ1 = 2048, DFF = 2816, NGU = 2 * DFF, NMEM = 256;
constexpr float RMS_EPS = 1e-6f, LN_EPS = 1e-5f;
constexpr size_t MiB = 1u << 20;
constexpr size_t WS_CTL = 0, CTL_ZERO_BYTES = 64 * 1024;
constexpr size_t WS_W = 2 * MiB, W_LAYER = 32 * MiB;
constexpr size_t W_IN = 0, W_OUT = 5 * MiB, W_Q = 7 * MiB, W_KV = 9 * MiB, W_O = 13 * MiB, W_GU = 15 * MiB, W_DN = 26 * MiB;
constexpr size_t WS_WSB = 66 * MiB;
constexpr size_t WS_SSQ = 67 * MiB;
constexpr size_t WS_VST = 68 * MiB;
constexpr size_t WS_MEMN = 70 * MiB;
constexpr size_t WS_KB = 72 * MiB;
constexpr size_t WS_VT = 74 * MiB;
constexpr size_t WS_HB = 76 * MiB;
constexpr size_t WS_MB = 108 * MiB;
constexpr size_t WS_BIG = 140 * MiB;
constexpr size_t WS_END = 228 * MiB;
constexpr int LDS_BYTES = 147456, MISC_OFF = 139264;

__device__ __forceinline__ float wave_sum(float v) {
#pragma unroll
    for (int o = 1; o < 64; o <<= 1) v += __shfl_xor(v, o);
    return v;
}
__device__ __forceinline__ float bf2f(unsigned short b) { return __uint_as_float((unsigned)b << 16); }
__device__ __forceinline__ float bflo(unsigned w) { return __uint_as_float(w << 16); }
__device__ __forceinline__ float bfhi(unsigned w) { return __uint_as_float(w & 0xffff0000u); }
__device__ __forceinline__ unsigned short f2bf(float f) { return (unsigned short)(cvt_pk_bf16(f, 0.f) & 0xffffu); }
__device__ __forceinline__ float sigm(float x) { return __builtin_amdgcn_rcpf(1.f + __builtin_amdgcn_exp2f(-1.44269504f * x)); }
__device__ __forceinline__ float gelu_tanh(float x) { const float y = 1.5957691216f * (x + 0.044715f * x * x * x); return x * sigm(y); }

__device__ __forceinline__ float row_rstd(const float* ssq, int row, int fq) {
    const f32x4 a = *(const f32x4*)(ssq + (size_t)row * 16 + 4 * fq);
    float s = (a[0] + a[1]) + (a[2] + a[3]);
    s += __shfl_xor(s, 16); s += __shfl_xor(s, 32);
    return rsqrtf(s * (1.0f / 1024.0f) + RMS_EPS);
}
__device__ __forceinline__ u32x4 pack8(const f32x4 v0, const f32x4 v1) { u32x4 w; w.x = cvt_pk_bf16(v0[0], v0[1]); w.y = cvt_pk_bf16(v0[2], v0[3]); w.z = cvt_pk_bf16(v1[0], v1[1]); w.w = cvt_pk_bf16(v1[2], v1[3]); return w; }

struct EpiScale {
    static constexpr bool PERM = true, AFTER_DRAIN = false;
    bf16_t* O; int ldc; const float* ssq;
    __device__ __forceinline__ void operator()(const f32x4 (&acc)[2][2][4][2], const Unit& u, int wr, int wc, int fr, int fq) const {
        const int row0 = u.pm * BM + wr * 64 + fr, col0 = u.pn * BM + wc * 32 + 8 * fq;
#pragma unroll
        for (int ai = 0; ai < 2; ++ai)
#pragma unroll
            for (int m = 0; m < 4; ++m) { const int row = row0 + ai * HALF + m * 16; const float rs = ssq ? row_rstd(ssq, row, fq) : 1.f; bf16_t* rowp = O + (size_t)row * ldc + col0;
#pragma unroll
                for (int bj = 0; bj < 2; ++bj) *(u32x4*)(rowp + bj * HALF) = pack8(acc[ai][bj][m][0] * rs, acc[ai][bj][m][1] * rs); }
    }
};
struct EpiRes {
    static constexpr bool PERM = true, AFTER_DRAIN = false;
    const float* base; float* out; bf16_t* hb; float* ssq;
    __device__ __forceinline__ void operator()(const f32x4 (&acc)[2][2][4][2], const Unit& u, int wr, int wc, int fr, int fq) const {
        const int row0 = u.pm * BM + wr * 64 + fr, col0 = u.pn * BM + wc * 32 + 8 * fq;
#pragma unroll
        for (int ai = 0; ai < 2; ++ai)
#pragma unroll
            for (int m = 0; m < 4; ++m) { const int row = row0 + ai * HALF + m * 16; const size_t off = (size_t)row * D + col0; float q = 0.f;
#pragma unroll
                for (int bj = 0; bj < 2; ++bj) { const f32x4 b0 = *(const f32x4*)(base + off + bj * HALF), b1 = *(const f32x4*)(base + off + bj * HALF + 4);
                    const f32x4 v0 = b0 + acc[ai][bj][m][0], v1 = b1 + acc[ai][bj][m][1];
                    *(f32x4*)(out + off + bj * HALF) = v0; *(f32x4*)(out + off + bj * HALF + 4) = v1; *(u32x4*)(hb + off + bj * HALF) = pack8(v0, v1);
                    q += ((v0[0] * v0[0] + v0[1] * v0[1]) + (v0[2] * v0[2] + v0[3] * v0[3])) + ((v1[0] * v1[0] + v1[1] * v1[1]) + (v1[2] * v1[2] + v1[3] * v1[3])); }
                q += __shfl_xor(q, 16); q += __shfl_xor(q, 32);
                if (fq == 0) ssq[(size_t)row * 16 + u.pn * 4 + wc] = q;
                if (m & 1) asm volatile("" ::: "memory"); }
    }
};
struct EpiGU {
    static constexpr bool PERM = true, AFTER_DRAIN = false;
    bf16_t* O; const float* ssq;
    __device__ __forceinline__ void operator()(const f32x4 (&acc)[2][2][4][2], const Unit& u, int wr, int wc, int fr, int fq) const {
        const int row0 = u.pm * BM + wr * 64 + fr, col0 = u.pn * HALF + wc * 32 + 8 * fq;
#pragma unroll
        for (int ai = 0; ai < 2; ++ai)
#pragma unroll
            for (int m = 0; m < 4; ++m) { const int row = row0 + ai * HALF + m * 16; const float rs = row_rstd(ssq, row, fq);
                f32x4 h[2];
#pragma unroll
                for (int n = 0; n < 2; ++n)
#pragma unroll
                    for (int j = 0; j < 4; ++j) { const float g = acc[ai][0][m][n][j] * rs, up = acc[ai][1][m][n][j] * rs; h[n][j] = g * sigm(g) * up; }
                *(u32x4*)(O + (size_t)row * DFF + col0) = pack8(h[0], h[1]); }
    }
};
struct EpiZ1 {
    static constexpr bool PERM = true, AFTER_DRAIN = false;
    bf16_t* O; const float* ssq; float* vst;
    __device__ __forceinline__ void operator()(const f32x4 (&acc)[2][2][4][2], const Unit& u, int wr, int wc, int fr, int fq) const {
        const int row0 = u.pm * BM + wr * 64 + fr, col0 = u.pn * BM + wc * 32 + 8 * fq;
#pragma unroll
        for (int ai = 0; ai < 2; ++ai)
#pragma unroll
            for (int m = 0; m < 4; ++m) { const int row = row0 + ai * HALF + m * 16; const float rs = row_rstd(ssq, row, fq); bf16_t* rowp = O + (size_t)row * DZ1 + col0; float s = 0.f, q = 0.f;
#pragma unroll
                for (int bj = 0; bj < 2; ++bj) { f32x4 v[2];
#pragma unroll
                    for (int n = 0; n < 2; ++n)
#pragma unroll
                        for (int j = 0; j < 4; ++j) { const float g = gelu_tanh(acc[ai][bj][m][n][j] * rs); v[n][j] = g; s += g; q += g * g; }
                    *(u32x4*)(rowp + bj * HALF) = pack8(v[0], v[1]); }
                if (u.pn >= 4) { s += __shfl_xor(s, 16); s += __shfl_xor(s, 32); q += __shfl_xor(q, 16); q += __shfl_xor(q, 32);
                    if (fq == 0) { float* p = vst + ((size_t)row * 16 + (u.pn - 4) * 4 + wc) * 2; p[0] = s; p[1] = q; } } }
    }
};
struct EpiKV {
    static constexpr bool PERM = true, AFTER_DRAIN = false;
    bf16_t* Kb; bf16_t* Vt;
    __device__ __forceinline__ void operator()(const f32x4 (&acc)[2][2][4][2], const Unit& u, int wr, int wc, int fr, int fq) const {
        const int col0 = (u.pn & 3) * BM + wc * 32 + 8 * fq;
#pragma unroll
        for (int ai = 0; ai < 2; ++ai)
#pragma unroll
            for (int m = 0; m < 4; ++m) { const int key = ai * HALF + wr * 64 + m * 16 + fr;
                if (u.pn < 4) { bf16_t* rowp = Kb + (size_t)(u.pm * BM + key) * D + col0;
#pragma unroll
                    for (int bj = 0; bj < 2; ++bj) *(u32x4*)(rowp + bj * HALF) = pack8(acc[ai][bj][m][0], acc[ai][bj][m][1]);
                } else { const int kp = (key & ~31) + 8 * ((key >> 2) & 3) + 4 * ((key >> 4) & 1) + (key & 3);
#pragma unroll
                    for (int bj = 0; bj < 2; ++bj)
#pragma unroll
                        for (int n = 0; n < 2; ++n)
#pragma unroll
                            for (int j = 0; j < 4; ++j) Vt[((size_t)u.pm * D + col0 + bj * HALF + 4 * n + j) * NMEM + kp] = f2bf(acc[ai][bj][m][n][j]); } }
    }
};

__device__ __forceinline__ void tr_item(const float* W, int K, int N, bf16_t* WT, const float* g, float cs, int mode, LAS float* scr, int item, int lane) {
    const int nblk = N / 32, kb = item / nblk, nb = item % nblk, k0 = 64 * kb, n0 = 32 * nb;
    const int orow = mode == 0 ? n0 : ((n0 >> 7) * 256 + (n0 & 127) + (mode == 2 ? 128 : 0));
#pragma unroll 8
    for (int i = 0; i < 32; ++i) { const int kk = 2 * i + (lane >> 5); const float sc = g ? g[k0 + kk] * cs : cs; scr[kk * 33 + (lane & 31)] = W[(size_t)(k0 + kk) * N + n0 + (lane & 31)] * sc; }
    asm volatile("s_waitcnt lgkmcnt(0)" ::: "memory");
    const int c = lane & 7;
#pragma unroll
    for (int j = 0; j < 4; ++j) { const int n = (lane >> 3) + 8 * j; const LAS float* s = scr + (8 * c) * 33 + n;
        u32x4 o; o.x = cvt_pk_bf16(s[0 * 33], s[1 * 33]); o.y = cvt_pk_bf16(s[2 * 33], s[3 * 33]); o.z = cvt_pk_bf16(s[4 * 33], s[5 * 33]); o.w = cvt_pk_bf16(s[6 * 33], s[7 * 33]);
        *(u32x4*)(WT + (size_t)(orow + n) * K + k0 + 8 * c) = o; }
    asm volatile("s_waitcnt lgkmcnt(0)" ::: "memory");
}

struct Args { const float* in[28]; float* out; unsigned char* ws; };

__device__ __forceinline__ void p0_prologue(const Args& a, LAS unsigned char* lds, int gw, int NGW, int wave, int lane) {
    unsigned char* ws = a.ws;
    LAS float* scr = (LAS float*)(lds + wave * 16384);
    const float QS = 0.0625f * 1.44269504f;
    constexpr int I_IN0 = 16 * (DZ0 / 32), I_IN1 = 16 * (DZ1 / 32), I_SQ = 16 * 32, I_GU = 16 * (DFF / 32), I_DN = (DFF / 64) * 32;
    constexpr int NITEMS = I_IN0 + I_IN1 + 2 * 5 * I_SQ + 2 * 2 * I_GU + 2 * I_DN;
    for (int it = gw; it < NITEMS; it += NGW) {
        int r = it; bool found = false; const float* W = nullptr; int K = 0, N = 0, mode = 0; bf16_t* WT = nullptr; const float* gv = nullptr; float cs = 1.f;
#define SEL(NI, Wp, K_, N_, WTp, g_, cs_, mode_) if (!found) { if (r < (NI)) { W = (Wp); K = (K_); N = (N_); WT = (bf16_t*)(WTp); gv = (g_); cs = (cs_); mode = (mode_); found = true; } else r -= (NI); }
        SEL(I_IN0, a.in[7], D, DZ0, ws + WS_W + W_IN, a.in[2], 1.f, 0)
        SEL(I_IN1, a.in[15], D, DZ1, ws + WS_W + W_LAYER + W_IN, a.in[2] + D, 1.f, 0)
        SEL(I_SQ, a.in[14], D, D, ws + WS_W + W_OUT, nullptr, 1.f, 0)
        SEL(I_SQ, a.in[20], D, D, ws + WS_W + W_LAYER + W_OUT, nullptr, 1.f, 0)
#pragma unroll
        for (int l = 0; l < 2; ++l) {
            unsigned char* wl = ws + WS_W + l * W_LAYER;
            SEL(I_SQ, a.in[21] + (size_t)l * D * D, D, D, wl + W_Q, a.in[3] + l * D, QS, 0)
            SEL(I_SQ, a.in[22] + (size_t)l * D * D, D, D, wl + W_KV, nullptr, 1.f, 0)
            SEL(I_SQ, a.in[23] + (size_t)l * D * D, D, D, wl + W_KV + (size_t)D * D * 2, nullptr, 1.f, 0)
            SEL(I_SQ, a.in[24] + (size_t)l * D * D, D, D, wl + W_O, nullptr, 1.f, 0)
            SEL(I_GU, a.in[25] + (size_t)l * D * DFF, D, DFF, wl + W_GU, a.in[5] + l * D, 1.f, 1)
            SEL(I_GU, a.in[26] + (size_t)l * D * DFF, D, DFF, wl + W_GU, a.in[5] + l * D, 1.f, 2)
            SEL(I_DN, a.in[27] + (size_t)l * D * DFF, DFF, D, wl + W_DN, nullptr, 1.f, 0)
        }
#undef SEL
        tr_item(W, K, N, WT, gv, cs, mode, scr, r, lane);
    }
    { const f32x4* src = (const f32x4*)a.in[18]; u32x2* dst = (u32x2*)(ws + WS_WSB);
      for (int i = gw * 64 + lane; i < 8 * 128 * 128 / 4; i += NGW * 64) { const f32x4 v = src[i]; u32x2 o; o.x = cvt_pk_bf16(v[0], v[1]); o.y = cvt_pk_bf16(v[2], v[3]); dst[i] = o; } }
    { float* ssq = (float*)(ws + WS_SSQ); bf16_t* HB = (bf16_t*)(ws + WS_HB);
      for (int m = gw; m < T; m += NGW) {
          const f32x4* xr = (const f32x4*)(a.in[0] + (size_t)m * D) + lane; f32x4 v[4]; float s = 0.f;
#pragma unroll
          for (int j = 0; j < 4; ++j) { v[j] = xr[64 * j]; s += (v[j][0] * v[j][0] + v[j][1] * v[j][1]) + (v[j][2] * v[j][2] + v[j][3] * v[j][3]); }
          s = wave_sum(s);
          u32x2* o = (u32x2*)(HB + (size_t)m * D) + lane;
#pragma unroll
          for (int j = 0; j < 4; ++j) { u32x2 w; w.x = cvt_pk_bf16(v[j][0], v[j][1]); w.y = cvt_pk_bf16(v[j][2], v[j][3]); o[64 * j] = w; }
          if (lane < 16) ssq[(size_t)m * 16 + lane] = lane == 0 ? s : 0.f;
      } }
    { bf16_t* MN = (bf16_t*)(ws + WS_MEMN);
      for (int m = gw; m < 2 * 512; m += NGW) { const int l = m >> 9, row = m & 511;
          const f32x4* xr = (const f32x4*)(a.in[1] + (size_t)row * D) + lane; const f32x4* gr = (const f32x4*)(a.in[4] + l * D) + lane; f32x4 v[4]; float s = 0.f;
#pragma unroll
          for (int j = 0; j < 4; ++j) { v[j] = xr[64 * j]; s += (v[j][0] * v[j][0] + v[j][1] * v[j][1]) + (v[j][2] * v[j][2] + v[j][3] * v[j][3]); }
          const float rs = rsqrtf(wave_sum(s) * (1.0f / 1024.0f) + RMS_EPS);
          u32x2* o = (u32x2*)(MN + ((size_t)l * 512 + row) * D) + lane;
#pragma unroll
          for (int j = 0; j < 4; ++j) { const f32x4 g = gr[64 * j]; u32x2 w; w.x = cvt_pk_bf16(v[j][0] * rs * g[0], v[j][1] * rs * g[1]); w.y = cvt_pk_bf16(v[j][2] * rs * g[2], v[j][3] * rs * g[3]); o[64 * j] = w; }
      } }
}

__device__ __forceinline__ void conv_phase(LAS unsigned char* lds, const bf16_t* Z, bf16_t* Mo, const float* cw, const float* cb, const float* lg, const float* lb,
                                           const float* bw, const float* bb, int G, int c) {
    constexpr int TT = 32;
    int tid_ = threadIdx.x; asm volatile("" : "+v"(tid_)); asm volatile("" : "+s"(c), "+s"(G));
    const int tid = tid_, lane = tid & 63, wid = tid >> 6;
    LAS float* os = (LAS float*)lds;
    float w[31];
#pragma unroll
    for (int k = 0; k < 31; ++k) w[k] = cw[k * 512 + tid];
    const float cbias = cb[tid], bw0 = bw[tid], bw1 = bw[512 + tid], bw2 = bw[1024 + tid], bbias = bb[tid];
    for (int u = c; u < T / TT; u += G) {
        const int t0 = u * TT, b = t0 / SEQ, s0 = t0 % SEQ;
        const bf16_t* zb = Z + (size_t)b * SEQ * DZ0;
        float av[TT + 30];
#pragma unroll
        for (int r = 0; r < TT + 30; ++r) { const int s = s0 - 15 + r; const bool ok = (s >= 0) && (s < SEQ); const int sc = ok ? s : s0;
            const float v = bf2f(zb[(size_t)sc * DZ0 + tid]), gt = bf2f(zb[(size_t)sc * DZ0 + 512 + tid]); av[r] = ok ? v * sigm(gt) : 0.f; }
        float o[TT];
#pragma unroll
        for (int t = 0; t < TT; ++t) { float acc = cbias;
#pragma unroll
            for (int k = 0; k < 31; ++k) acc += w[k] * av[t + k];
            o[t] = acc; }
        __syncthreads();
#pragma unroll
        for (int t = 0; t < TT; ++t) os[t * 512 + tid] = o[t];
        __syncthreads();
        { const f32x4 g0 = *(const f32x4*)(lg + 8 * lane), g1 = *(const f32x4*)(lg + 8 * lane + 4), b0 = *(const f32x4*)(lb + 8 * lane), b1 = *(const f32x4*)(lb + 8 * lane + 4);
#pragma unroll
          for (int i = 0; i < TT / 8; ++i) { const int t = (TT / 8) * wid + i;
              const f32x4 v0 = *(const LAS f32x4*)(os + t * 512 + 8 * lane), v1 = *(const LAS f32x4*)(os + t * 512 + 8 * lane + 4);
              const float mean = wave_sum(((v0[0] + v0[1]) + (v0[2] + v0[3])) + ((v1[0] + v1[1]) + (v1[2] + v1[3]))) * (1.0f / 512.0f);
              const f32x4 d0 = v0 - mean, d1 = v1 - mean;
              const float var = wave_sum(((d0[0] * d0[0] + d0[1] * d0[1]) + (d0[2] * d0[2] + d0[3] * d0[3])) + ((d1[0] * d1[0] + d1[1] * d1[1]) + (d1[2] * d1[2] + d1[3] * d1[3]))) * (1.0f / 512.0f);
              const float rstd = rsqrtf(var + LN_EPS);
              f32x4 y0 = d0 * rstd * g0 + b0, y1 = d1 * rstd * g1 + b1;
#pragma unroll
              for (int j = 0; j < 4; ++j) { y0[j] = y0[j] * sigm(y0[j]); y1[j] = y1[j] * sigm(y1[j]); }
              *(u32x4*)(Mo + (size_t)(t0 + t) * D + 8 * lane) = pack8(y0, y1); } }
        float xv[TT + 2];
#pragma unroll
        for (int r = 0; r < TT + 2; ++r) { const int s = s0 - 1 + r; const bool ok = (s >= 0) && (s < SEQ); const int sc = ok ? s : s0;
            const float hv = bf2f(zb[(size_t)sc * DZ0 + 1024 + tid]), gc = bf2f(zb[(size_t)sc * DZ0 + 2048 + tid]); xv[r] = ok ? hv * gc : 0.f; }
#pragma unroll
        for (int t = 0; t < TT; ++t) { const float y = bw0 * xv[t] + bw1 * xv[t + 1] + bw2 * xv[t + 2] + bbias; const float gb = bf2f(zb[(size_t)(s0 + t) * DZ0 + 1536 + tid]);
            Mo[(size_t)(t0 + t) * D + 512 + tid] = f2bf(gb * y); }
    }
}

__device__ __forceinline__ void sgu_phase(LAS unsigned char* lds, const bf16_t* Z1, const float* vst, const bf16_t* Wsb, const float* bs, const float* lg, const float* lb, bf16_t* Y, int G, int c) {
    constexpr int RS = 272;
    int tid_ = threadIdx.x; asm volatile("" : "+v"(tid_)); asm volatile("" : "+s"(c), "+s"(G));
    const int tid = tid_, lane = tid & 63, wid = tid >> 6, fr = lane & 15, fq = lane >> 4;
    LAS unsigned char* Wl = lds; LAS unsigned char* Vl = lds + 128 * RS; LAS float* st = (LAS float*)(lds + 256 * RS);
    for (int u = c; u < 1024; u += G) {
        const int n = u >> 3, g = u & 7, t0 = n * 128, cg0 = g * 128;
        __syncthreads();
#pragma unroll
        for (int i = 0; i < 4; ++i) { const int idx = tid + 512 * i, p = idx >> 4, chn = idx & 15;
            *(LAS u32x4*)(Wl + p * RS + chn * 16) = *(const u32x4*)(Wsb + ((size_t)g * 128 + p) * 128 + chn * 8); }
        if (tid < 128) { const f32x4* p = (const f32x4*)(vst + (size_t)(t0 + tid) * 32); float s = 0.f, q = 0.f;
#pragma unroll
            for (int j = 0; j < 8; ++j) { const f32x4 v = p[j]; s += v[0] + v[2]; q += v[1] + v[3]; }
            const float mean = s * (1.0f / 1024.0f), var = q * (1.0f / 1024.0f) - mean * mean;
            st[2 * tid] = mean; st[2 * tid + 1] = rsqrtf(var + LN_EPS); }
        __syncthreads();
#pragma unroll
        for (int i = 0; i < 4; ++i) { const int idx = tid + 512 * i, q = idx >> 4, c0 = (idx & 15) * 8;
            const u32x4 raw = *(const u32x4*)(Z1 + (size_t)(t0 + q) * DZ1 + 1024 + cg0 + c0);
            const float mean = st[2 * q], rstd = st[2 * q + 1];
            const f32x4 g0 = *(const f32x4*)(lg + cg0 + c0), g1 = *(const f32x4*)(lg + cg0 + c0 + 4), b0 = *(const f32x4*)(lb + cg0 + c0), b1 = *(const f32x4*)(lb + cg0 + c0 + 4);
            float v[8]; v[0] = bflo(raw.x); v[1] = bfhi(raw.x); v[2] = bflo(raw.y); v[3] = bfhi(raw.y); v[4] = bflo(raw.z); v[5] = bfhi(raw.z); v[6] = bflo(raw.w); v[7] = bfhi(raw.w);
#pragma unroll
            for (int j = 0; j < 8; ++j) { const float gg = j < 4 ? g0[j & 3] : g1[j & 3], bbv = j < 4 ? b0[j & 3] : b1[j & 3];
                *(LAS bf16_t*)(Vl + (c0 + j) * RS + q * 2) = f2bf((v[j] - mean) * rstd * gg + bbv); } }
        __syncthreads();
        bf16x8 wf[4];
#pragma unroll
        for (int ks = 0; ks < 4; ++ks) wf[ks] = *(const LAS bf16x8*)(Wl + (16 * wid + fr) * RS + (32 * ks + 8 * fq) * 2);
        f32x4 acc[8];
#pragma unroll
        for (int cb = 0; cb < 8; ++cb) { acc[cb] = (f32x4){0.f, 0.f, 0.f, 0.f};
#pragma unroll
            for (int ks = 0; ks < 4; ++ks) { const bf16x8 vf = *(const LAS bf16x8*)(Vl + (16 * cb + fr) * RS + (32 * ks + 8 * fq) * 2);
                acc[cb] = __builtin_amdgcn_mfma_f32_16x16x32_bf16(vf, wf[ks], acc[cb], 0, 0, 0); } }
        const int p = 16 * wid + fr, row = t0 + p; const float bias = bs[g * 128 + p];
#pragma unroll
        for (int cb = 0; cb < 8; ++cb) { const int cc = cg0 + 16 * cb + 4 * fq; const u32x2 uu = *(const u32x2*)(Z1 + (size_t)row * DZ1 + cc);
            u32x2 o; o.x = cvt_pk_bf16(bflo(uu.x) * (acc[cb][0] + bias), bfhi(uu.x) * (acc[cb][1] + bias)); o.y = cvt_pk_bf16(bflo(uu.y) * (acc[cb][2] + bias), bfhi(uu.y) * (acc[cb][3] + bias));
            *(u32x2*)(Y + (size_t)row * D + cc) = o; }
    }
}

__device__ __forceinline__ void attn_phase(LAS unsigned char* lds, const bf16_t* Q, const bf16_t* Kb, const bf16_t* Vt, bf16_t* O, int G, int c) {
    constexpr int RS = 528;
    int tid_ = threadIdx.x; asm volatile("" : "+v"(tid_)); asm volatile("" : "+s"(c), "+s"(G));
    const int tid = tid_, lane = tid & 63, wid = tid >> 6, fr = lane & 15, fq = lane >> 4;
    for (int u = c; u < 512; u += G) {
        const int qb = u >> 2, h = u & 3, b = qb >> 6, q0 = qb * 128;
        const bf16_t* qrow = Q + (size_t)(q0 + 16 * wid + fr) * D + h * 256 + 8 * fq;
        bf16x8 qf[8];
#pragma unroll
        for (int ks = 0; ks < 8; ++ks) qf[ks] = *(const bf16x8*)(qrow + 32 * ks);
        __syncthreads();
#pragma unroll
        for (int i = 0; i < 16; ++i) { const int idx = tid + 512 * i, key = idx >> 5, ch = idx & 31;
            *(LAS u32x4*)(lds + key * RS + ch * 16) = *(const u32x4*)(Kb + (size_t)(b * 256 + key) * D + h * 256 + ch * 8); }
        __syncthreads();
        f32x4 S[16];
#pragma unroll
        for (int kb = 0; kb < 16; ++kb) { S[kb] = (f32x4){0.f, 0.f, 0.f, 0.f};
#pragma unroll
            for (int ks = 0; ks < 8; ++ks) { const bf16x8 kf = *(const LAS bf16x8*)(lds + (16 * kb + fr) * RS + (32 * ks + 8 * fq) * 2);
                S[kb] = __builtin_amdgcn_mfma_f32_16x16x32_bf16(kf, qf[ks], S[kb], 0, 0, 0); } }
        float mx = -3.0e38f;
#pragma unroll
        for (int kb = 0; kb < 16; ++kb) mx = fmaxf(mx, fmaxf(fmaxf(S[kb][0], S[kb][1]), fmaxf(S[kb][2], S[kb][3])));
        mx = fmaxf(mx, __shfl_xor(mx, 16)); mx = fmaxf(mx, __shfl_xor(mx, 32));
        float l = 0.f;
#pragma unroll
        for (int kb = 0; kb < 16; ++kb)
#pragma unroll
            for (int j = 0; j < 4; ++j) { const float p = __builtin_amdgcn_exp2f(S[kb][j] - mx); S[kb][j] = p; l += p; }
        l += __shfl_xor(l, 16); l += __shfl_xor(l, 32);
        bf16x8 pf[8];
#pragma unroll
        for (int cc = 0; cc < 8; ++cc) { const u32x4 w = pack8(S[2 * cc], S[2 * cc + 1]); pf[cc] = __builtin_bit_cast(bf16x8, w); }
        __syncthreads();
#pragma unroll
        for (int i = 0; i < 16; ++i) { const int idx = tid + 512 * i, d = idx >> 5, ch = idx & 31;
            *(LAS u32x4*)(lds + d * RS + ch * 16) = *(const u32x4*)(Vt + ((size_t)b * D + h * 256 + d) * NMEM + ch * 8); }
        __syncthreads();
        const float inv = 1.0f / l;
        bf16_t* orow = O + (size_t)(q0 + 16 * wid + fr) * D + h * 256 + 4 * fq;
#pragma unroll
        for (int db = 0; db < 16; ++db) { f32x4 oa = (f32x4){0.f, 0.f, 0.f, 0.f};
#pragma unroll
            for (int cc = 0; cc < 8; ++cc) { const bf16x8 vf = *(const LAS bf16x8*)(lds + (16 * db + fr) * RS + (32 * cc + 8 * fq) * 2);
                oa = __builtin_amdgcn_mfma_f32_16x16x32_bf16(vf, pf[cc], oa, 0, 0, 0); }
            u32x2 o; o.x = cvt_pk_bf16(oa[0] * inv, oa[1] * inv); o.y = cvt_pk_bf16(oa[2] * inv, oa[3] * inv);
            *(u32x2*)(orow + 16 * db) = o; }
    }
}

#ifndef LSTART
#define LSTART 0
#endif
#ifndef LEND
#define LEND 2
#endif
__global__ void __launch_bounds__(NTHR, 2) fwd_kernel(Args a) {
    extern __shared__ __attribute__((aligned(16))) unsigned char lds_raw[];
    LAS unsigned char* lds = (LAS unsigned char*)lds_raw;
    volatile LAS unsigned* MISC = (volatile LAS unsigned*)(lds + MISC_OFF);
    const int tid = threadIdx.x, lane = tid & 63, wave = __builtin_amdgcn_readfirstlane(tid >> 6);
    const int G = gridDim.x, bx = blockIdx.x, vcu = (G % 8 == 0) ? (bx % 8) * (G / 8) + bx / 8 : bx;
    unsigned char* ws = a.ws;
    if (tid < 32) MISC[tid] = 0u;
    __syncthreads();
    XcdBarrier bar = xcd_barrier_post((unsigned*)(ws + WS_CTL), MISC + 8);
    const int gw = vcu * NWAVES + wave, NGW = G * NWAVES;
    float* out = a.out; float* ssq = (float*)(ws + WS_SSQ); float* vst = (float*)(ws + WS_VST);
    bf16_t* HB = (bf16_t*)(ws + WS_HB); bf16_t* MB = (bf16_t*)(ws + WS_MB); bf16_t* BIG = (bf16_t*)(ws + WS_BIG);
    bf16_t* MEMN = (bf16_t*)(ws + WS_MEMN); bf16_t* KB = (bf16_t*)(ws + WS_KB); bf16_t* VT = (bf16_t*)(ws + WS_VT);
#define GRID_BAR() xcd_barrier(bar)
#ifdef NO_GEMM
#define GEMM(EpiT, E, Ap, Bp, M_, N_, K_, cc) do {} while (0)
#else
#define GEMM(EpiT, E, Ap, Bp, M_, N_, K_, cc) do { Gemm g{(const bf16_t*)(Ap), (const bf16_t*)(Bp), (M_), (N_), (K_)}; int cc_ = (cc); asm volatile("" : "+s"(cc_)); StaticOrder S; S.init((M_), (N_), G, cc_); gemm_phase<EpiT, StaticOrder, true, true>(lds, g, S, (E)); } while (0)
#endif

#ifndef NO_P0
    p0_prologue(a, lds, gw, NGW, wave, lane);
#endif
    cg::this_grid().sync();

#pragma unroll
    for (int l = LSTART; l < LEND; ++l) {
        unsigned char* wl = ws + WS_W + (size_t)l * W_LAYER;
        if (l == 0) {
            { EpiScale E{BIG, DZ0, ssq}; GEMM(EpiScale, E, HB, wl + W_IN, T, DZ0, D, bx); }
#pragma unroll 1
            for (int l2 = 0; l2 < 2; ++l2) { EpiKV E{KB + (size_t)l2 * 512 * D, VT + (size_t)l2 * 2 * D * NMEM};
                const int c2 = (G - 1 - bx + (l2 ? G - 16 : 0)) % G;
                GEMM(EpiKV, E, MEMN + (size_t)l2 * 512 * D, ws + WS_W + (size_t)l2 * W_LAYER + W_KV, 512, 2 * D, D, c2); }
            GRID_BAR();
#ifndef NO_CONV
            conv_phase(lds, BIG, MB, a.in[8], a.in[9], a.in[10], a.in[11], a.in[12], a.in[13], G, bx);
#endif
            GRID_BAR();
            { EpiRes E{a.in[0], out, HB, ssq}; GEMM(EpiRes, E, MB, wl + W_OUT, T, D, D, bx); }
        } else {
            { EpiZ1 E{BIG, ssq, vst}; GEMM(EpiZ1, E, HB, wl + W_IN, T, DZ1, D, bx); }
            GRID_BAR();
#ifndef NO_SGU
            sgu_phase(lds, BIG, vst, (const bf16_t*)(ws + WS_WSB), a.in[19], a.in[16], a.in[17], MB, G, bx);
#endif
            GRID_BAR();
            { EpiRes E{out, out, HB, ssq}; GEMM(EpiRes, E, MB, wl + W_OUT, T, D, D, bx); }
        }
        GRID_BAR();
        { EpiScale E{BIG, D, ssq}; GEMM(EpiScale, E, HB, wl + W_Q, T, D, D, bx); }
        GRID_BAR();
#ifndef NO_ATTN
        attn_phase(lds, BIG, KB + (size_t)l * 512 * D, VT + (size_t)l * 2 * D * NMEM, MB, G, bx);
#endif
        GRID_BAR();
        { EpiRes E{out, out, HB, ssq}; GEMM(EpiRes, E, MB, wl + W_O, T, D, D, bx); }
        GRID_BAR();
        { EpiGU E{BIG, ssq}; GEMM(EpiGU, E, HB, wl + W_GU, T, NGU, D, bx); }
        GRID_BAR();
        { EpiRes E{out, out, HB, ssq}; GEMM(EpiRes, E, BIG, wl + W_DN, T, D, DFF, bx); }
        GRID_BAR();
    }
    { const f32x4* gr = (const f32x4*)a.in[6] + lane;
      for (int m = gw; m < T; m += NGW) { f32x4* p = (f32x4*)(out + (size_t)m * D) + lane; f32x4 v[4]; float s = 0.f;
#pragma unroll
          for (int j = 0; j < 4; ++j) { v[j] = p[64 * j]; s += (v[j][0] * v[j][0] + v[j][1] * v[j][1]) + (v[j][2] * v[j][2] + v[j][3] * v[j][3]); }
          const float rs = rsqrtf(wave_sum(s) * (1.0f / 1024.0f) + RMS_EPS);
#pragma unroll
          for (int j = 0; j < 4; ++j) p[64 * j] = v[j] * rs * gr[64 * j]; } }
}

extern "C" void kernel_launch(void* const* d_in, const int* in_sizes, int n_in, void* d_out, int out_size, void* d_ws, size_t ws_size, hipStream_t stream) {
    static int grid = 0;
    if (grid == 0) {
        if (n_in != 28 || out_size != T * D || ws_size < WS_END) { fprintf(stderr, "kernel_launch: unexpected shapes (n_in %d out %d ws %zu)\n", n_in, out_size, ws_size); grid = -1; return; }
        int dev = 0, cus = 0, per_cu = 0;
        (void)hipGetDevice(&dev); (void)hipDeviceGetAttribute(&cus, hipDeviceAttributeMultiprocessorCount, dev);
        (void)hipFuncSetAttribute((const void*)fwd_kernel, hipFuncAttributeMaxDynamicSharedMemorySize, LDS_BYTES);
        (void)hipOccupancyMaxActiveBlocksPerMultiprocessor(&per_cu, (const void*)fwd_kernel, NTHR, LDS_BYTES);
        if (per_cu < 1) per_cu = 1;
        (void)hipGetLastError();
        grid = cus;
        if (grid % 8 != 0 || grid < 64) fprintf(stderr, "kernel_launch: unusual CU count %d\n", grid);
    }
    if (grid < 0) return;
    (void)hipMemsetAsync((char*)d_ws + WS_CTL, 0, CTL_ZERO_BYTES, stream);
    Args a{};
    for (int i = 0; i < 28; ++i) a.in[i] = (const float*)d_in[i];
    a.out = (float*)d_out; a.ws = (unsigned char*)d_ws;
    void* args[] = {&a};
    hipError_t e = hipLaunchCooperativeKernel((const void*)fwd_kernel, dim3(grid), dim3(NTHR), args, LDS_BYTES, stream);
    if (e != hipSuccess) fprintf(stderr, "cooperative launch failed: %s (grid %d)\n", hipGetErrorString(e), grid);
}
```

```cpp
#include <hip/hip_runtime.h>
#include <hip/hip_cooperative_groups.h>
#include <cstdio>
#include <cstdint>
namespace cg = cooperative_groups;
namespace pg8 {
#define PG8_LAS __attribute__((address_space(3)))
typedef unsigned short bf16_t;
typedef short bf16x8 __attribute__((ext_vector_type(8)));
typedef float f32x4 __attribute__((ext_vector_type(4)));
typedef unsigned u32x4 __attribute__((ext_vector_type(4)));
constexpr int BM = 256, BK = 64, HALF = 128, HTB = HALF * BK * 2  , STAGE_BYTES = 8 * HTB, NXCD = 8, WGM = 8;

__host__ __device__ __forceinline__ int lds_byte(int r, int c) { const int st = (r >> 4) * 2 + (c >> 5), rr = r & 15, cc = c & 31, ob = rr * 64 + cc * 2; return st * 1024 + (ob ^ (((ob >> 9) & 1) << 5)); }
__host__ __device__ __forceinline__ void stage_rc(int b, int& R, int& C) { const int st = b / 1024, sb = b % 1024, swz = sb ^ (((sb >> 9) & 1) << 5); R = (st >> 1) * 16 + swz / 64; C = (st & 1) * 32 + (swz % 64) / 2; }
__host__ __device__ __forceinline__ int perm32(int rho) { const int n = rho >> 4, i = rho & 15; return 8 * (i >> 2) + 4 * n + (i & 3); }

struct Unit { int pm, pn; };
struct Gemm { const bf16_t* A; const bf16_t* Bt; int M, N, K; };

struct StaticOrder {
    int nM, nN, nwg, G, c;
    __host__ __device__ void init(int M, int N, int G_, int c_) { nM = M / BM; nN = N / BM; nwg = nM * nN; G = G_; c = c_; }
    __host__ __device__ bool next(int i, Unit& u) const {
        const long L = (long)i * G + c; if (L >= nwg) return false;
        int wgid = (int)L; { const int q = nwg / NXCD, r = nwg % NXCD, xcd = wgid % NXCD, off = wgid / NXCD; wgid = (xcd < r ? xcd * (q + 1) : r * (q + 1) + (xcd - r) * q) + off; }
        const int nig = WGM * nN, gid = wgid / nig, fm = gid * WGM, gsz = (nM - fm) < WGM ? (nM - fm) : WGM;
        u.pm = fm + ((wgid % nig) % gsz); u.pn = (wgid % nig) / gsz; return true;
    }
    __device__ __forceinline__ void a_ready(const Unit&) const {}
    __device__ __forceinline__ void done(const Unit&) const {}
};

__device__ __forceinline__ unsigned cvt_pk_bf16(float lo, float hi) { unsigned r; asm volatile("v_cvt_pk_bf16_f32 %0, %1, %2" : "=v"(r) : "v"(lo), "v"(hi)); return r; }
typedef float f32x2 __attribute__((ext_vector_type(2)));
template <class Epi, class Sched, bool ALIGN_EPI = false, bool SP2 = false>
__device__ __forceinline__ void gemm_phase(PG8_LAS unsigned char* lds, const Gemm g, const Sched& S, const Epi& E) {
    int tid_ = threadIdx.x; asm volatile("" : "+v"(tid_));
    const int tid = tid_, wid = __builtin_amdgcn_readfirstlane(tid >> 6), lane = tid & 63, wr = wid >> 2, wc = wid & 3, fr = lane & 15, fq = lane >> 4;
    const int K = g.K, nt = K / BK;
    unsigned voffA[2], voffB[2];
#pragma unroll
    for (int i = 0; i < 2; ++i) { int R, C; stage_rc(tid * 16 + i * 8192, R, C); const int Rb = Epi::PERM ? ((R & ~31) + perm32(R & 31)) : R;
        voffA[i] = (unsigned)(R * K + C) * 2u; voffB[i] = (unsigned)(Rb * K + C) * 2u; }
    const size_t kstep = (size_t)(BK * 2);
    const size_t hstep = (size_t)HALF * K * 2;
    const size_t tstep = 2 * hstep;
    const unsigned ldsw = (unsigned)wid * 1024u;
    const int aoff = lds_byte(wr * 64 + fr, fq * 8), boff = lds_byte(wc * 32 + fr, fq * 8);
#define PG8_SA(b, h) (((b) * 2 + (h)) * HTB)
#define PG8_SB(b, h) ((4 + (b) * 2 + (h)) * HTB)
#define PG8_STAGE(bufoff, gbase, voff) do { _Pragma("unroll") for (int _i = 0; _i < 2; ++_i) \
        __builtin_amdgcn_global_load_lds((const unsigned*)((const char*)(gbase) + (voff)[_i]), (PG8_LAS unsigned*)(lds + (bufoff) + ldsw + _i * 8192), 16, 0, 0); } while (0)
#define PG8_LDA(dst, b, h) do { _Pragma("unroll") for (int m = 0; m < 4; ++m) _Pragma("unroll") for (int k = 0; k < 2; ++k) dst[m][k] = *(const PG8_LAS bf16x8*)(lds + PG8_SA(b, h) + aoff + m * 2048 + k * 1024); } while (0)
#define PG8_LDB(dst, b, h) do { _Pragma("unroll") for (int n = 0; n < 2; ++n) _Pragma("unroll") for (int k = 0; k < 2; ++k) dst[n][k] = *(const PG8_LAS bf16x8*)(lds + PG8_SB(b, h) + boff + n * 2048 + k * 1024); } while (0)
#define PG8_MMA(ai, bj, At, Bt) do { __builtin_amdgcn_s_setprio(1); _Pragma("unroll") for (int m = 0; m < 4; ++m) _Pragma("unroll") for (int n = 0; n < 2; ++n) _Pragma("unroll") for (int k = 0; k < 2; ++k) \
        acc[ai][bj][m][n] = __builtin_amdgcn_mfma_f32_16x16x32_bf16(Bt[n][k], At[m][k], acc[ai][bj][m][n], 0, 0, 0); __builtin_amdgcn_s_setprio(0); } while (0)
#define PG8_WAIT_V(n) asm volatile("s_waitcnt vmcnt(" #n ")" ::: "memory")
#define PG8_WAIT_L(n) asm volatile("s_waitcnt lgkmcnt(" #n ")" ::: "memory")
#define PG8_BAR __builtin_amdgcn_s_barrier()
#define PG8_SCHED __builtin_amdgcn_sched_barrier(0)
    Unit cur, nxt; int ui = 0;
    if (!S.next(0, cur)) return;
    f32x4 acc[2][2][4][2];
#pragma unroll
    for (int a = 0; a < 2; ++a)
#pragma unroll
        for (int b = 0; b < 2; ++b)
#pragma unroll
            for (int m = 0; m < 4; ++m)
#pragma unroll
                for (int n = 0; n < 2; ++n) acc[a][b][m][n] = (f32x4){0.f, 0.f, 0.f, 0.f};
    bf16x8 At[4][2], B0[2][2], B1[2][2];
    const char* cA = (const char*)g.A + (size_t)cur.pm * tstep; const char* cB = (const char*)g.Bt + (size_t)cur.pn * tstep;
    S.a_ready(cur);
    if constexpr (SP2) {
        PG8_STAGE(PG8_SB(0, 0), cB, voffB); PG8_STAGE(PG8_SB(0, 1), cB + hstep, voffB); PG8_STAGE(PG8_SA(0, 0), cA, voffA); PG8_STAGE(PG8_SA(0, 1), cA + hstep, voffA);
        if (wr == 1) PG8_BAR;
        PG8_WAIT_V(2); PG8_BAR;
        PG8_STAGE(PG8_SB(1, 0), cB + kstep, voffB); PG8_STAGE(PG8_SA(1, 0), cA + kstep, voffA); PG8_STAGE(PG8_SB(1, 1), cB + hstep + kstep, voffB);
        PG8_WAIT_V(6); PG8_BAR;
    } else {
        PG8_STAGE(PG8_SB(0, 0), cB, voffB); PG8_STAGE(PG8_SA(0, 0), cA, voffA); PG8_STAGE(PG8_SB(0, 1), cB + hstep, voffB); PG8_STAGE(PG8_SA(0, 1), cA + hstep, voffA);
        if (wr == 1) PG8_BAR;
        PG8_WAIT_V(4); PG8_BAR;
        PG8_STAGE(PG8_SB(1, 0), cB + kstep, voffB); PG8_STAGE(PG8_SA(1, 0), cA + kstep, voffA); PG8_STAGE(PG8_SB(1, 1), cB + hstep + kstep, voffB);
        PG8_WAIT_V(6); PG8_BAR;
    }
    for (;;) {
        const bool has_next = S.next(ui + 1, nxt);
        const char* nA = has_next ? (const char*)g.A + (size_t)nxt.pm * tstep : cA; const char* nB = has_next ? (const char*)g.Bt + (size_t)nxt.pn * tstep : cB;
        for (int t = 0; t < nt; t += 2) {
            const bool last = (t == nt - 2);
            const char* a1 = cA + (size_t)(t + 1) * kstep;
            const char* a2 = last ? nA : cA + (size_t)(t + 2) * kstep; const char* b2 = last ? nB : cB + (size_t)(t + 2) * kstep;
            const char* a3 = a2 + kstep; const char* b3 = b2 + kstep;
            if (last && has_next) S.a_ready(nxt);
            if constexpr (SP2) {
            PG8_LDB(B0, 0, 0); PG8_LDB(B1, 0, 1); PG8_SCHED; PG8_LDA(At, 0, 0); PG8_STAGE(PG8_SA(1, 1), a1 + hstep, voffA);
            PG8_WAIT_V(8); PG8_WAIT_L(0); PG8_BAR; PG8_MMA(0, 0, At, B0); PG8_MMA(0, 1, At, B1); PG8_BAR; PG8_SCHED;
            PG8_LDA(At, 0, 1); PG8_STAGE(PG8_SB(0, 0), b2, voffB); PG8_STAGE(PG8_SB(0, 1), b2 + hstep, voffB); PG8_STAGE(PG8_SA(0, 0), a2, voffA);
            PG8_WAIT_V(8); PG8_WAIT_L(0); PG8_BAR; PG8_MMA(1, 0, At, B0); PG8_MMA(1, 1, At, B1); PG8_BAR; PG8_SCHED;
            PG8_LDB(B0, 1, 0); PG8_LDB(B1, 1, 1); PG8_SCHED; PG8_LDA(At, 1, 0); PG8_STAGE(PG8_SA(0, 1), a2 + hstep, voffA);
            PG8_WAIT_V(8); PG8_WAIT_L(0); PG8_BAR; PG8_MMA(0, 0, At, B0); PG8_MMA(0, 1, At, B1); PG8_BAR; PG8_SCHED;
            PG8_LDA(At, 1, 1); PG8_STAGE(PG8_SB(1, 0), b3, voffB); PG8_STAGE(PG8_SB(1, 1), b3 + hstep, voffB); PG8_STAGE(PG8_SA(1, 0), a3, voffA);
            PG8_WAIT_V(8); PG8_WAIT_L(0); PG8_BAR; PG8_MMA(1, 0, At, B0); PG8_MMA(1, 1, At, B1); PG8_BAR; PG8_SCHED;
            } else {
            PG8_LDB(B0, 0, 0); PG8_SCHED; PG8_LDA(At, 0, 0); PG8_STAGE(PG8_SA(1, 1), a1 + hstep, voffA);
            PG8_WAIT_L(8); PG8_BAR; PG8_WAIT_L(0); PG8_MMA(0, 0, At, B0); PG8_BAR; PG8_SCHED;
            PG8_LDB(B1, 0, 1); PG8_STAGE(PG8_SB(0, 0), b2, voffB);
            PG8_BAR; PG8_WAIT_L(0); PG8_MMA(0, 1, At, B1); PG8_BAR;
            PG8_LDA(At, 0, 1); PG8_STAGE(PG8_SA(0, 0), a2, voffA);
            PG8_BAR; PG8_WAIT_L(0); PG8_MMA(1, 0, At, B0); PG8_BAR; PG8_SCHED;
            PG8_STAGE(PG8_SB(0, 1), b2 + hstep, voffB);
            PG8_WAIT_V(6); PG8_BAR; PG8_MMA(1, 1, At, B1); PG8_BAR;
            PG8_LDB(B0, 1, 0); PG8_SCHED; PG8_LDA(At, 1, 0); PG8_STAGE(PG8_SA(0, 1), a2 + hstep, voffA);
            PG8_WAIT_L(8); PG8_BAR; PG8_WAIT_L(0); PG8_MMA(0, 0, At, B0); PG8_BAR; PG8_SCHED;
            PG8_LDB(B1, 1, 1); PG8_STAGE(PG8_SB(1, 0), b3, voffB);
            PG8_BAR; PG8_WAIT_L(0); PG8_MMA(0, 1, At, B1); PG8_BAR;
            PG8_LDA(At, 1, 1); PG8_STAGE(PG8_SA(1, 0), a3, voffA);
            PG8_BAR; PG8_WAIT_L(0); PG8_MMA(1, 0, At, B0); PG8_BAR; PG8_SCHED;
            PG8_STAGE(PG8_SB(1, 1), b3 + hstep, voffB);
            PG8_WAIT_V(6); PG8_BAR; PG8_MMA(1, 1, At, B1); PG8_BAR;
            }
        }
        if constexpr (ALIGN_EPI) { if (wr == 0) PG8_BAR; }
        if constexpr (!Epi::AFTER_DRAIN) { E(acc, cur, wr, wc, fr, fq); S.done(cur); }
        if (!has_next) break;
#pragma unroll
        for (int a = 0; a < 2; ++a)
#pragma unroll
            for (int b = 0; b < 2; ++b)
#pragma unroll
                for (int m = 0; m < 4; ++m)
#pragma unroll
                    for (int n = 0; n < 2; ++n) acc[a][b][m][n] = (f32x4){0.f, 0.f, 0.f, 0.f};
        cur = nxt; cA = nA; cB = nB; ++ui;
        if constexpr (ALIGN_EPI) { if (wr == 1) PG8_BAR; }
    }
    PG8_WAIT_V(0);
    if constexpr (!ALIGN_EPI) { if (wr == 0) PG8_BAR; }
    PG8_BAR;
    if constexpr (Epi::AFTER_DRAIN) { E.fused(acc, cur, wr, wc, fr, fq, lds, wid, lane); S.done(cur); }
#undef PG8_SA
#undef PG8_SB
#undef PG8_STAGE
#undef PG8_LDA
#undef PG8_LDB
#undef PG8_MMA
#undef PG8_WAIT_V
#undef PG8_WAIT_L
#undef PG8_BAR
#undef PG8_SCHED
}
}
#define LAS __attribute__((address_space(3)))
#define XB_TMO      128
#define XB_XCNT(j)  (256  + 64 * (j))
#define XB_XSUB(j)  (1280 + 64 * (j))
#define XB_XGEN(j)  (2304 + 64 * (j))
#define XB_TOP      3328
#define XB_TOPGEN   3392
#define XCD_BAR_WORDS 3456
#define XB_SPIN_CAP (1u << 18)

__device__ __forceinline__ unsigned xb_ld(unsigned* p)              { return __hip_atomic_load(p, __ATOMIC_RELAXED, __HIP_MEMORY_SCOPE_AGENT); }
__device__ __forceinline__ unsigned xb_add(unsigned* p, unsigned v) { return __hip_atomic_fetch_add(p, v, __ATOMIC_RELAXED, __HIP_MEMORY_SCOPE_AGENT); }
__device__ __forceinline__ unsigned xb_xcc_id() { return (unsigned)__builtin_amdgcn_s_getreg((3 << 11) | 20) & 0xFu; }
#define XB_SPIN(cond, bar) do { unsigned _sp = 0; while (cond) { __builtin_amdgcn_s_sleep(1); \
    if ((++_sp & 255u) == 0u) { if (xb_ld(&(bar)[XB_TMO])) break; if (_sp > XB_SPIN_CAP) { atomicAdd(&(bar)[XB_TMO], 1u); break; } } } } while (0)

struct XcdBarrier {
    unsigned* bar; unsigned x;
    volatile LAS unsigned* st;
};

__device__ __forceinline__ XcdBarrier xcd_barrier_post(unsigned* bar, volatile LAS unsigned* st) {
    XcdBarrier b; b.bar = bar; b.x = xb_xcc_id(); b.st = st;
    if (threadIdx.x == 0) (void)xb_add(&bar[XB_XCNT(b.x)], 1u);
    return b;
}
__device__ __forceinline__ void xcd_barrier_complete(unsigned* bar, unsigned x, unsigned& nloc, unsigned& nx) {
    const unsigned G = gridDim.x * gridDim.y * gridDim.z;
    unsigned sum, cnt, mine, sp = 0u;
    for (;;) {
        sum = 0u; cnt = 0u; mine = 0u;
#pragma unroll
        for (unsigned j = 0; j < 16; ++j) { const unsigned c = xb_ld(&bar[XB_XCNT(j)]); sum += c; cnt += (c > 0u) ? 1u : 0u; mine = (j == x) ? c : mine; }
        if (sum == G) break;
        __builtin_amdgcn_s_sleep(1);
        if ((++sp & 255u) == 0u) { if (xb_ld(&bar[XB_TMO])) break; if (sp > XB_SPIN_CAP) { atomicAdd(&bar[XB_TMO], 1u); break; } }
    }
    nloc = mine > 0u ? mine : 1u; nx = cnt > 0u ? cnt : 1u;
}

__device__ __forceinline__ void xcd_barrier(const XcdBarrier& b) {
    asm volatile("s_waitcnt vmcnt(0)" ::: "memory");
    __syncthreads();
    if (threadIdx.x == 0) {
        unsigned* bar = b.bar;
        __builtin_amdgcn_s_waitcnt(0);
        unsigned nloc = b.st[0], nx = b.st[1];
        if (nloc == 0u) { xcd_barrier_complete(bar, b.x, nloc, nx); b.st[0] = nloc; b.st[1] = nx; }
        const unsigned old = xb_add(&bar[XB_XSUB(b.x)], 1u);
        const unsigned gen = old / nloc;
        if (old + 1u == (gen + 1u) * nloc) {
            __builtin_amdgcn_fence(__ATOMIC_RELEASE, "agent");
            asm volatile("s_waitcnt vmcnt(0)" ::: "memory");
            const unsigned og = xb_add(&bar[XB_TOP], 1u);
            const unsigned tg = og / nx;
            if (og + 1u == (tg + 1u) * nx) xb_add(&bar[XB_TOPGEN], 1u);
            else XB_SPIN(xb_ld(&bar[XB_TOPGEN]) == tg, bar);
            __builtin_amdgcn_fence(__ATOMIC_ACQUIRE, "agent");
            xb_add(&bar[XB_XGEN(b.x)], 1u);
            asm volatile("s_waitcnt vmcnt(0)" ::: "memory");
        } else {
            XB_SPIN(xb_ld(&bar[XB_XGEN(b.x)]) == gen, bar);
            __builtin_amdgcn_fence(__ATOMIC_ACQUIRE, "agent");
            asm volatile("s_waitcnt vmcnt(0)" ::: "memory");
        }
    }
    __syncthreads();
}
#undef LAS
using namespace pg8;
#define LAS __attribute__((address_space(3)))
typedef unsigned u32x2 __attribute__((ext_vector_type(2)));

constexpr int NWAVES = 8, NTHR = 512;
constexpr int SEQ = 8192, NBATCH = 2, T = NBATCH * SEQ, D = 1024, DZ0 = 2560, DZ1 = 2048, DFF = 2816, NGU = 2 * DFF, NMEM = 256;
constexpr float RMS_EPS = 1e-6f, LN_EPS = 1e-5f;
constexpr size_t MiB = 1u << 20;
constexpr size_t WS_CTL = 0, CTL_ZERO_BYTES = 64 * 1024;
constexpr size_t WS_W = 2 * MiB, W_LAYER = 32 * MiB;
constexpr size_t W_IN = 0, W_OUT = 5 * MiB, W_Q = 7 * MiB, W_KV = 9 * MiB, W_O = 13 * MiB, W_GU = 15 * MiB, W_DN = 26 * MiB;
constexpr size_t WS_WSB = 66 * MiB;
constexpr size_t WS_SSQ = 67 * MiB;
constexpr size_t WS_VST = 68 * MiB;
constexpr size_t WS_MEMN = 70 * MiB;
constexpr size_t WS_KB = 72 * MiB;
constexpr size_t WS_VT = 74 * MiB;
constexpr size_t WS_HB = 76 * MiB;
constexpr size_t WS_MB = 108 * MiB;
constexpr size_t WS_BIG = 140 * MiB;
constexpr size_t WS_END = 228 * MiB;
constexpr int LDS_BYTES = 147456, MISC_OFF = 139264;

__device__ __forceinline__ float wave_sum(float v) {
#pragma unroll
    for (int o = 1; o < 64; o <<= 1) v += __shfl_xor(v, o);
    return v;
}
__device__ __forceinline__ float bf2f(unsigned short b) { return __uint_as_float((unsigned)b << 16); }
__device__ __forceinline__ float bflo(unsigned w) { return __uint_as_float(w << 16); }
__device__ __forceinline__ float bfhi(unsigned w) { return __uint_as_float(w & 0xffff0000u); }
__device__ __forceinline__ unsigned short f2bf(float f) { return (unsigned short)(cvt_pk_bf16(f, 0.f) & 0xffffu); }
__device__ __forceinline__ float sigm(float x) { return __builtin_amdgcn_rcpf(1.f + __builtin_amdgcn_exp2f(-1.44269504f * x)); }
__device__ __forceinline__ float gelu_tanh(float x) { const float y = 1.5957691216f * (x + 0.044715f * x * x * x); return x * sigm(y); }

__device__ __forceinline__ float row_rstd(const float* ssq, int row, int fq) {
    const f32x4 a = *(const f32x4*)(ssq + (size_t)row * 16 + 4 * fq);
    float s = (a[0] + a[1]) + (a[2] + a[3]);
    s += __shfl_xor(s, 16); s += __shfl_xor(s, 32);
    return rsqrtf(s * (1.0f / 1024.0f) + RMS_EPS);
}
__device__ __forceinline__ u32x4 pack8(const f32x4 v0, const f32x4 v1) { u32x4 w; w.x = cvt_pk_bf16(v0[0], v0[1]); w.y = cvt_pk_bf16(v0[2], v0[3]); w.z = cvt_pk_bf16(v1[0], v1[1]); w.w = cvt_pk_bf16(v1[2], v1[3]); return w; }

struct EpiScale {
    static constexpr bool PERM = true, AFTER_DRAIN = false;
    bf16_t* O; int ldc; const float* ssq;
    __device__ __forceinline__ void operator()(const f32x4 (&acc)[2][2][4][2], const Unit& u, int wr, int wc, int fr, int fq) const {
        const int row0 = u.pm * BM + wr * 64 + fr, col0 = u.pn * BM + wc * 32 + 8 * fq;
#pragma unroll
        for (int ai = 0; ai < 2; ++ai)
#pragma unroll
            for (int m = 0; m < 4; ++m) { const int row = row0 + ai * HALF + m * 16; const float rs = ssq ? row_rstd(ssq, row, fq) : 1.f; bf16_t* rowp = O + (size_t)row * ldc + col0;
#pragma unroll
                for (int bj = 0; bj < 2; ++bj) *(u32x4*)(rowp + bj * HALF) = pack8(acc[ai][bj][m][0] * rs, acc[ai][bj][m][1] * rs); }
    }
};
struct EpiRes {
    static constexpr bool PERM = true, AFTER_DRAIN = false;
    const float* base; float* out; bf16_t* hb; float* ssq;
    __device__ __forceinline__ void operator()(const f32x4 (&acc)[2][2][4][2], const Unit& u, int wr, int wc, int fr, int fq) const {
        const int row0 = u.pm * BM + wr * 64 + fr, col0 = u.pn * BM + wc * 32 + 8 * fq;
#pragma unroll
        for (int ai = 0; ai < 2; ++ai)
#pragma unroll
            for (int m = 0; m < 4; ++m) { const int row = row0 + ai * HALF + m * 16; const size_t off = (size_t)row * D + col0; float q = 0.f;
#pragma unroll
                for (int bj = 0; bj < 2; ++bj) { const f32x4 b0 = *(const f32x4*)(base + off + bj * HALF), b1 = *(const f32x4*)(base + off + bj * HALF + 4);
                    const f32x4 v0 = b0 + acc[ai][bj][m][0], v1 = b1 + acc[ai][bj][m][1];
                    *(f32x4*)(out + off + bj * HALF) = v0; *(f32x4*)(out + off + bj * HALF + 4) = v1; *(u32x4*)(hb + off + bj * HALF) = pack8(v0, v1);
                    q += ((v0[0] * v0[0] + v0[1] * v0[1]) + (v0[2] * v0[2] + v0[3] * v0[3])) + ((v1[0] * v1[0] + v1[1] * v1[1]) + (v1[2] * v1[2] + v1[3] * v1[3])); }
                q += __shfl_xor(q, 16); q += __shfl_xor(q, 32);
                if (fq == 0) ssq[(size_t)row * 16 + u.pn * 4 + wc] = q;
                if (m & 1) asm volatile("" ::: "memory"); }
    }
};
struct EpiGU {
    static constexpr bool PERM = true, AFTER_DRAIN = false;
    bf16_t* O; const float* ssq;
    __device__ __forceinline__ void operator()(const f32x4 (&acc)[2][2][4][2], const Unit& u, int wr, int wc, int fr, int fq) const {
        const int row0 = u.pm * BM + wr * 64 + fr, col0 = u.pn * HALF + wc * 32 + 8 * fq;
#pragma unroll
        for (int ai = 0; ai < 2; ++ai)
#pragma unroll
            for (int m = 0; m < 4; ++m) { const int row = row0 + ai * HALF + m * 16; const float rs = row_rstd(ssq, row, fq);
                f32x4 h[2];
#pragma unroll
                for (int n = 0; n < 2; ++n)
#pragma unroll
                    for (int j = 0; j < 4; ++j) { const float g = acc[ai][0][m][n][j] * rs, up = acc[ai][1][m][n][j] * rs; h[n][j] = g * sigm(g) * up; }
                *(u32x4*)(O + (size_t)row * DFF + col0) = pack8(h[0], h[1]); }
    }
};
struct EpiZ1 {
    static constexpr bool PERM = true, AFTER_DRAIN = false;
    bf16_t* O; const float* ssq; float* vst;
    __device__ __forceinline__ void operator()(const f32x4 (&acc)[2][2][4][2], const Unit& u, int wr, int wc, int fr, int fq) const {
        const int row0 = u.pm * BM + wr * 64 + fr, col0 = u.pn * BM + wc * 32 + 8 * fq;
#pragma unroll
        for (int ai = 0; ai < 2; ++ai)
#pragma unroll
            for (int m = 0; m < 4; ++m) { const int row = row0 + ai * HALF + m * 16; const float rs = row_rstd(ssq, row, fq); bf16_t* rowp = O + (size_t)row * DZ1 + col0; float s = 0.f, q = 0.f;
#pragma unroll
                for (int bj = 0; bj < 2; ++bj) { f32x4 v[2];
#pragma unroll
                    for (int n = 0; n < 2; ++n)
#pragma unroll
                        for (int j = 0; j < 4; ++j) { const float g = gelu_tanh(acc[ai][bj][m][n][j] * rs); v[n][j] = g; s += g; q += g * g; }
                    *(u32x4*)(rowp + bj * HALF) = pack8(v[0], v[1]); }
                if (u.pn >= 4) { s += __shfl_xor(s, 16); s += __shfl_xor(s, 32); q += __shfl_xor(q, 16); q += __shfl_xor(q, 32);
                    if (fq == 0) { float* p = vst + ((size_t)row * 16 + (u.pn - 4) * 4 + wc) * 2; p[0] = s; p[1] = q; } } }
    }
};
struct EpiKV {
    static constexpr bool PERM = true, AFTER_DRAIN = false;
    bf16_t* Kb; bf16_t* Vt;
    __device__ __forceinline__ void operator()(const f32x4 (&acc)[2][2][4][2], const Unit& u, int wr, int wc, int fr, int fq) const {
        const int col0 = (u.pn & 3) * BM + wc * 32 + 8 * fq;
#pragma unroll
        for (int ai = 0; ai < 2; ++ai)
#pragma unroll
            for (int m = 0; m < 4; ++m) { const int key = ai * HALF + wr * 64 + m * 16 + fr;
                if (u.pn < 4) { bf16_t* rowp = Kb + (size_t)(u.pm * BM + key) * D + col0;
#pragma unroll
                    for (int bj = 0; bj < 2; ++bj) *(u32x4*)(rowp + bj * HALF) = pack8(acc[ai][bj][m][0], acc[ai][bj][m][1]);
                } else { const int kp = (key & ~31) + 8 * ((key >> 2) & 3) + 4 * ((key >> 4) & 1) + (key & 3);
#pragma unroll
                    for (int bj = 0; bj < 2; ++bj)
#pragma unroll
                        for (int n = 0; n < 2; ++n)
#pragma unroll
                            for (int j = 0; j < 4; ++j) Vt[((size_t)u.pm * D + col0 + bj * HALF + 4 * n + j) * NMEM + kp] = f2bf(acc[ai][bj][m][n][j]); } }
    }
};

__device__ __forceinline__ void tr_item(const float* W, int K, int N, bf16_t* WT, const float* g, float cs, int mode, LAS float* scr, int item, int lane) {
    const int nblk = N / 64, kb = item / nblk, nb = item % nblk, k0 = 64 * kb, n0 = 64 * nb;
    const int orow = mode == 0 ? n0 : ((n0 >> 7) * 256 + (n0 & 127) + (mode == 2 ? 128 : 0));
    const int kq = lane >> 4, n4 = (lane & 15) * 4;
    f32x4 v[16]; float sc[16];
#pragma unroll
    for (int i = 0; i < 16; ++i) { const int kk = 4 * i + kq; v[i] = *(const f32x4*)(W + (size_t)(k0 + kk) * N + n0 + n4); sc[i] = g ? g[k0 + kk] * cs : cs; }
    __builtin_amdgcn_sched_barrier(0);
#pragma unroll
    for (int i = 0; i < 16; ++i) { const int kk = 4 * i + kq; LAS float* d = scr + kk * 65 + n4; d[0] = v[i][0] * sc[i]; d[1] = v[i][1] * sc[i]; d[2] = v[i][2] * sc[i]; d[3] = v[i][3] * sc[i]; }
    asm volatile("s_waitcnt lgkmcnt(0)" ::: "memory");
    const int c = lane & 7;
#pragma unroll
    for (int j = 0; j < 8; ++j) { const int n = (lane >> 3) + 8 * j; const LAS float* p = scr + (8 * c) * 65 + n;
        u32x4 o; o.x = cvt_pk_bf16(p[0 * 65], p[1 * 65]); o.y = cvt_pk_bf16(p[2 * 65], p[3 * 65]); o.z = cvt_pk_bf16(p[4 * 65], p[5 * 65]); o.w = cvt_pk_bf16(p[6 * 65], p[7 * 65]);
        *(u32x4*)(WT + (size_t)(orow + n) * K + k0 + 8 * c) = o; }
    asm volatile("s_waitcnt lgkmcnt(0)" ::: "memory");
}

struct Args { const float* in[28]; float* out; unsigned char* ws; };

__device__ __forceinline__ void p0_prologue(const Args& a, LAS unsigned char* lds, int gw, int NGW, int wave, int lane) {
    unsigned char* ws = a.ws;
    LAS float* scr = (LAS float*)(lds + wave * 16640);
    const float QS = 0.0625f * 1.44269504f;
    constexpr int I_IN0 = 16 * (DZ0 / 64), I_IN1 = 16 * (DZ1 / 64), I_SQ = 16 * 16, I_GU = 16 * (DFF / 64), I_DN = (DFF / 64) * 16;
    constexpr int NITEMS = I_IN0 + I_IN1 + 2 * 5 * I_SQ + 2 * 2 * I_GU + 2 * I_DN;
    for (int it = gw; it < NITEMS; it += NGW) {
        int r = it; bool found = false; const float* W = nullptr; int K = 0, N = 0, mode = 0; bf16_t* WT = nullptr; const float* gv = nullptr; float cs = 1.f;
#define SEL(NI, Wp, K_, N_, WTp, g_, cs_, mode_) if (!found) { if (r < (NI)) { W = (Wp); K = (K_); N = (N_); WT = (bf16_t*)(WTp); gv = (g_); cs = (cs_); mode = (mode_); found = true; } else r -= (NI); }
        SEL(I_IN0, a.in[7], D, DZ0, ws + WS_W + W_IN, a.in[2], 1.f, 0)
        SEL(I_IN1, a.in[15], D, DZ1, ws + WS_W + W_LAYER + W_IN, a.in[2] + D, 1.f, 0)
        SEL(I_SQ, a.in[14], D, D, ws + WS_W + W_OUT, nullptr, 1.f, 0)
        SEL(I_SQ, a.in[20], D, D, ws + WS_W + W_LAYER + W_OUT, nullptr, 1.f, 0)
#pragma unroll
        for (int l = 0; l < 2; ++l) {
            unsigned char* wl = ws + WS_W + l * W_LAYER;
            SEL(I_SQ, a.in[21] + (size_t)l * D * D, D, D, wl + W_Q, a.in[3] + l * D, QS, 0)
            SEL(I_SQ, a.in[22] + (size_t)l * D * D, D, D, wl + W_KV, nullptr, 1.f, 0)
            SEL(I_SQ, a.in[23] + (size_t)l * D * D, D, D, wl + W_KV + (size_t)D * D * 2, nullptr, 1.f, 0)
            SEL(I_SQ, a.in[24] + (size_t)l * D * D, D, D, wl + W_O, nullptr, 1.f, 0)
            SEL(I_GU, a.in[25] + (size_t)l * D * DFF, D, DFF, wl + W_GU, a.in[5] + l * D, 1.f, 1)
            SEL(I_GU, a.in[26] + (size_t)l * D * DFF, D, DFF, wl + W_GU, a.in[5] + l * D, 1.f, 2)
            SEL(I_DN, a.in[27] + (size_t)l * D * DFF, DFF, D, wl + W_DN, nullptr, 1.f, 0)
        }
#undef SEL
        tr_item(W, K, N, WT, gv, cs, mode, scr, r, lane);
    }
    { const f32x4* src = (const f32x4*)a.in[18]; u32x2* dst = (u32x2*)(ws + WS_WSB);
      for (int i = gw * 64 + lane; i < 8 * 128 * 128 / 4; i += NGW * 64) { const f32x4 v = src[i]; u32x2 o; o.x = cvt_pk_bf16(v[0], v[1]); o.y = cvt_pk_bf16(v[2], v[3]); dst[i] = o; } }
    { float* ssq = (float*)(ws + WS_SSQ); bf16_t* HB = (bf16_t*)(ws + WS_HB);
      for (int m0 = gw * 4; m0 < T; m0 += NGW * 4) {
          f32x4 v[4][4];
#pragma unroll
          for (int r = 0; r < 4; ++r) { const f32x4* xr = (const f32x4*)(a.in[0] + (size_t)(m0 + r) * D) + lane;
#pragma unroll
              for (int j = 0; j < 4; ++j) v[r][j] = xr[64 * j]; }
          __builtin_amdgcn_sched_barrier(0);
#pragma unroll
          for (int r = 0; r < 4; ++r) { float s = 0.f;
#pragma unroll
              for (int j = 0; j < 4; ++j) s += (v[r][j][0] * v[r][j][0] + v[r][j][1] * v[r][j][1]) + (v[r][j][2] * v[r][j][2] + v[r][j][3] * v[r][j][3]);
              s = wave_sum(s);
              u32x2* o = (u32x2*)(HB + (size_t)(m0 + r) * D) + lane;
#pragma unroll
              for (int j = 0; j < 4; ++j) { u32x2 w; w.x = cvt_pk_bf16(v[r][j][0], v[r][j][1]); w.y = cvt_pk_bf16(v[r][j][2], v[r][j][3]); o[64 * j] = w; }
              if (lane < 16) ssq[(size_t)(m0 + r) * 16 + lane] = lane == 0 ? s : 0.f; }
      } }
    { bf16_t* MN = (bf16_t*)(ws + WS_MEMN);
      for (int m = gw; m < 2 * 512; m += NGW) { const int l = m >> 9, row = m & 511;
          const f32x4* xr = (const f32x4*)(a.in[1] + (size_t)row * D) + lane; const f32x4* gr = (const f32x4*)(a.in[4] + l * D) + lane; f32x4 v[4]; float s = 0.f;
#pragma unroll
          for (int j = 0; j < 4; ++j) { v[j] = xr[64 * j]; s += (v[j][0] * v[j][0] + v[j][1] * v[j][1]) + (v[j][2] * v[j][2] + v[j][3] * v[j][3]); }
          const float rs = rsqrtf(wave_sum(s) * (1.0f / 1024.0f) + RMS_EPS);
          u32x2* o = (u32x2*)(MN + ((size_t)l * 512 + row) * D) + lane;
#pragma unroll
          for (int j = 0; j < 4; ++j) { const f32x4 g = gr[64 * j]; u32x2 w; w.x = cvt_pk_bf16(v[j][0] * rs * g[0], v[j][1] * rs * g[1]); w.y = cvt_pk_bf16(v[j][2] * rs * g[2], v[j][3] * rs * g[3]); o[64 * j] = w; }
      } }
}

__device__ __forceinline__ void unpack8(const u32x4 r, float (&v)[8]) { v[0] = bflo(r.x); v[1] = bfhi(r.x); v[2] = bflo(r.y); v[3] = bfhi(r.y); v[4] = bflo(r.z); v[5] = bfhi(r.z); v[6] = bflo(r.w); v[7] = bfhi(r.w); }
__device__ __forceinline__ void conv_phase(LAS unsigned char* lds, const bf16_t* Z, bf16_t* Mo, const float* cw, const float* cb, const float* lg, const float* lb,
                                           const float* bw, const float* bb, int G, int c) {
    constexpr int TT = 32, RR = TT + 30;
    int tid_ = threadIdx.x; asm volatile("" : "+v"(tid_)); asm volatile("" : "+s"(c), "+s"(G));
    const int tid = tid_, lane = tid & 63, wid = tid >> 6;
    LAS float* as = (LAS float*)lds;
    LAS float* os = (LAS float*)lds;
    for (int u = c; u < T / TT; u += G) {
        const int t0 = u * TT, b = t0 / SEQ, s0 = t0 % SEQ;
        const bf16_t* zb = Z + (size_t)b * SEQ * DZ0;
        __syncthreads();
        { u32x4 rv[8], rg[8];
#pragma unroll
          for (int i = 0; i < 8; ++i) { const int idx = tid + 512 * i, r = idx >> 6, cc = idx & 63, sq = s0 - 15 + r; const bool ok = (idx < RR * 64) && (sq >= 0) && (sq < SEQ);
              const bf16_t* p = zb + (size_t)(ok ? sq : s0) * DZ0 + cc * 8; rv[i] = *(const u32x4*)p; rg[i] = *(const u32x4*)(p + 512);
              if (!ok) rv[i] = (u32x4){0u, 0u, 0u, 0u}; }
          __builtin_amdgcn_sched_barrier(0);
#pragma unroll
          for (int i = 0; i < 8; ++i) { const int idx = tid + 512 * i, r = idx >> 6, cc = idx & 63; float v[8], gt[8]; unpack8(rv[i], v); unpack8(rg[i], gt);
              f32x4 a0, a1;
#pragma unroll
              for (int j = 0; j < 4; ++j) { a0[j] = v[j] * sigm(gt[j]); a1[j] = v[4 + j] * sigm(gt[4 + j]); }
              if (idx < RR * 64) { *(LAS f32x4*)(as + r * 512 + cc * 8) = a0; *(LAS f32x4*)(as + r * 512 + cc * 8 + 4) = a1; } } }
        __syncthreads();
        float o[TT];
        { float w[31]; const float* cw_ = cw; const float* cb_ = cb; asm volatile("" : "+s"(cw_), "+s"(cb_));
#pragma unroll
          for (int k = 0; k < 31; ++k) w[k] = cw_[k * 512 + tid];
          const float cbias = cb_[tid];
          float av[RR];
#pragma unroll
          for (int r = 0; r < RR; ++r) av[r] = as[r * 512 + tid];
#pragma unroll
          for (int t = 0; t < TT; ++t) { float acc = cbias;
#pragma unroll
              for (int k = 0; k < 31; ++k) acc += w[k] * av[t + k];
              o[t] = acc; } }
        __syncthreads();
#pragma unroll
        for (int t = 0; t < TT; ++t) os[t * 512 + tid] = o[t];
        __syncthreads();
        { const float* lg_ = lg; const float* lb_ = lb; asm volatile("" : "+s"(lg_), "+s"(lb_));
          const f32x4 g0 = *(const f32x4*)(lg_ + 8 * lane), g1 = *(const f32x4*)(lg_ + 8 * lane + 4), b0 = *(const f32x4*)(lb_ + 8 * lane), b1 = *(const f32x4*)(lb_ + 8 * lane + 4);
#pragma unroll
          for (int i = 0; i < TT / 8; ++i) { const int t = (TT / 8) * wid + i;
              const f32x4 v0 = *(const LAS f32x4*)(os + t * 512 + 8 * lane), v1 = *(const LAS f32x4*)(os + t * 512 + 8 * lane + 4);
              const float mean = wave_sum(((v0[0] + v0[1]) + (v0[2] + v0[3])) + ((v1[0] + v1[1]) + (v1[2] + v1[3]))) * (1.0f / 512.0f);
              const f32x4 d0 = v0 - mean, d1 = v1 - mean;
              const float var = wave_sum(((d0[0] * d0[0] + d0[1] * d0[1]) + (d0[2] * d0[2] + d0[3] * d0[3])) + ((d1[0] * d1[0] + d1[1] * d1[1]) + (d1[2] * d1[2] + d1[3] * d1[3]))) * (1.0f / 512.0f);
              const float rstd = rsqrtf(var + LN_EPS);
              f32x4 y0 = d0 * rstd * g0 + b0, y1 = d1 * rstd * g1 + b1;
#pragma unroll
              for (int j = 0; j < 4; ++j) { y0[j] = y0[j] * sigm(y0[j]); y1[j] = y1[j] * sigm(y1[j]); }
              *(u32x4*)(Mo + (size_t)(t0 + t) * D + 8 * lane) = pack8(y0, y1); } }
        { const int cc = tid & 63, rgp = tid >> 6, sb = s0 + 4 * rgp;
          u32x4 hh[6], gc[6], gb[4];
#pragma unroll
          for (int r = 0; r < 6; ++r) { const int sq = sb - 1 + r; const bool ok = (sq >= 0) && (sq < SEQ); const bf16_t* p = zb + (size_t)(ok ? sq : s0) * DZ0 + cc * 8;
              hh[r] = *(const u32x4*)(p + 1024); gc[r] = *(const u32x4*)(p + 2048); if (!ok) hh[r] = (u32x4){0u, 0u, 0u, 0u};
              if (r >= 1 && r <= 4) gb[r - 1] = *(const u32x4*)(p + 1536); }
          const float* bw_ = bw; const float* bb_ = bb; asm volatile("" : "+s"(bw_), "+s"(bb_));
          const f32x4 w0a = *(const f32x4*)(bw_ + cc * 8), w0b = *(const f32x4*)(bw_ + cc * 8 + 4), w1a = *(const f32x4*)(bw_ + 512 + cc * 8), w1b = *(const f32x4*)(bw_ + 512 + cc * 8 + 4),
                      w2a = *(const f32x4*)(bw_ + 1024 + cc * 8), w2b = *(const f32x4*)(bw_ + 1024 + cc * 8 + 4), bba = *(const f32x4*)(bb_ + cc * 8), bbb = *(const f32x4*)(bb_ + cc * 8 + 4);
          __builtin_amdgcn_sched_barrier(0);
          float x[6][8];
#pragma unroll
          for (int r = 0; r < 6; ++r) { float hv[8], gv[8]; unpack8(hh[r], hv); unpack8(gc[r], gv);
#pragma unroll
              for (int j = 0; j < 8; ++j) x[r][j] = hv[j] * gv[j]; }
#pragma unroll
          for (int t = 0; t < 4; ++t) { float gbv[8]; unpack8(gb[t], gbv); f32x4 y0, y1;
#pragma unroll
              for (int j = 0; j < 4; ++j) { y0[j] = gbv[j] * (w0a[j] * x[t][j] + w1a[j] * x[t + 1][j] + w2a[j] * x[t + 2][j] + bba[j]);
                  y1[j] = gbv[4 + j] * (w0b[j] * x[t][4 + j] + w1b[j] * x[t + 1][4 + j] + w2b[j] * x[t + 2][4 + j] + bbb[j]); }
              *(u32x4*)(Mo + (size_t)(t0 + 4 * rgp + t) * D + 512 + cc * 8) = pack8(y0, y1); } }
    }
}

__device__ __forceinline__ void sgu_phase(LAS unsigned char* lds, const bf16_t* Z1, const float* vst, const bf16_t* Wsb, const float* bs, const float* lg, const float* lb, bf16_t* Y, int G, int c) {
    constexpr int RS = 272;
    int tid_ = threadIdx.x; asm volatile("" : "+v"(tid_)); asm volatile("" : "+s"(c), "+s"(G));
    const int tid = tid_, lane = tid & 63, wid = tid >> 6, fr = lane & 15, fq = lane >> 4;
    LAS unsigned char* Wl = lds; LAS unsigned char* Vl = lds + 128 * RS; LAS float* st = (LAS float*)(lds + 256 * RS);
    for (int u = c; u < 1024; u += G) {
        const int n = u >> 3, g = u & 7, t0 = n * 128, cg0 = g * 128;
        __syncthreads();
#pragma unroll
        for (int i = 0; i < 4; ++i) { const int idx = tid + 512 * i, p = idx >> 4, chn = idx & 15;
            *(LAS u32x4*)(Wl + p * RS + chn * 16) = *(const u32x4*)(Wsb + ((size_t)g * 128 + p) * 128 + chn * 8); }
        if (tid < 128) { const f32x4* p = (const f32x4*)(vst + (size_t)(t0 + tid) * 32); float s = 0.f, q = 0.f;
#pragma unroll
            for (int j = 0; j < 8; ++j) { const f32x4 v = p[j]; s += v[0] + v[2]; q += v[1] + v[3]; }
            const float mean = s * (1.0f / 1024.0f), var = q * (1.0f / 1024.0f) - mean * mean;
            st[2 * tid] = mean; st[2 * tid + 1] = rsqrtf(var + LN_EPS); }
        __syncthreads();
#pragma unroll
        for (int i = 0; i < 4; ++i) { const int idx = tid + 512 * i, q = idx >> 4, c0 = (idx & 15) * 8;
            const u32x4 raw = *(const u32x4*)(Z1 + (size_t)(t0 + q) * DZ1 + 1024 + cg0 + c0);
            const float mean = st[2 * q], rstd = st[2 * q + 1];
            const f32x4 g0 = *(const f32x4*)(lg + cg0 + c0), g1 = *(const f32x4*)(lg + cg0 + c0 + 4), b0 = *(const f32x4*)(lb + cg0 + c0), b1 = *(const f32x4*)(lb + cg0 + c0 + 4);
            float v[8]; v[0] = bflo(raw.x); v[1] = bfhi(raw.x); v[2] = bflo(raw.y); v[3] = bfhi(raw.y); v[4] = bflo(raw.z); v[5] = bfhi(raw.z); v[6] = bflo(raw.w); v[7] = bfhi(raw.w);
#pragma unroll
            for (int j = 0; j < 8; ++j) { const float gg = j < 4 ? g0[j & 3] : g1[j & 3], bbv = j < 4 ? b0[j & 3] : b1[j & 3];
                *(LAS bf16_t*)(Vl + (c0 + j) * RS + q * 2) = f2bf((v[j] - mean) * rstd * gg + bbv); } }
        __syncthreads();
        bf16x8 wf[4];
#pragma unroll
        for (int ks = 0; ks < 4; ++ks) wf[ks] = *(const LAS bf16x8*)(Wl + (16 * wid + fr) * RS + (32 * ks + 8 * fq) * 2);
        f32x4 acc[8];
#pragma unroll
        for (int cb = 0; cb < 8; ++cb) { acc[cb] = (f32x4){0.f, 0.f, 0.f, 0.f};
#pragma unroll
            for (int ks = 0; ks < 4; ++ks) { const bf16x8 vf = *(const LAS bf16x8*)(Vl + (16 * cb + fr) * RS + (32 * ks + 8 * fq) * 2);
                acc[cb] = __builtin_amdgcn_mfma_f32_16x16x32_bf16(vf, wf[ks], acc[cb], 0, 0, 0); } }
        const int p = 16 * wid + fr, row = t0 + p; const float bias = bs[g * 128 + p];
#pragma unroll
        for (int cb = 0; cb < 8; ++cb) { const int cc = cg0 + 16 * cb + 4 * fq; const u32x2 uu = *(const u32x2*)(Z1 + (size_t)row * DZ1 + cc);
            u32x2 o; o.x = cvt_pk_bf16(bflo(uu.x) * (acc[cb][0] + bias), bfhi(uu.x) * (acc[cb][1] + bias)); o.y = cvt_pk_bf16(bflo(uu.y) * (acc[cb][2] + bias), bfhi(uu.y) * (acc[cb][3] + bias));
            *(u32x2*)(Y + (size_t)row * D + cc) = o; }
    }
}

__device__ __forceinline__ void attn_phase(LAS unsigned char* lds, const bf16_t* Q, const bf16_t* Kb, const bf16_t* Vt, bf16_t* O, int G, int c) {
    constexpr int RS = 528;
    int tid_ = threadIdx.x; asm volatile("" : "+v"(tid_)); asm volatile("" : "+s"(c), "+s"(G));
    const int tid = tid_, lane = tid & 63, wid = tid >> 6, fr = lane & 15, fq = lane >> 4;
    for (int u = c; u < 512; u += G) {
        const int qb = u >> 2, h = u & 3, b = qb >> 6, q0 = qb * 128;
        const bf16_t* qrow = Q + (size_t)(q0 + 16 * wid + fr) * D + h * 256 + 8 * fq;
        bf16x8 qf[8];
#pragma unroll
        for (int ks = 0; ks < 8; ++ks) qf[ks] = *(const bf16x8*)(qrow + 32 * ks);
        __syncthreads();
        { u32x4 tv[16];
#pragma unroll
          for (int i = 0; i < 16; ++i) { const int idx = tid + 512 * i, key = idx >> 5, ch = idx & 31; tv[i] = *(const u32x4*)(Kb + (size_t)(b * 256 + key) * D + h * 256 + ch * 8); }
          __builtin_amdgcn_sched_barrier(0);
#pragma unroll
          for (int i = 0; i < 16; ++i) { const int idx = tid + 512 * i, key = idx >> 5, ch = idx & 31; *(LAS u32x4*)(lds + key * RS + ch * 16) = tv[i]; } }
        __syncthreads();
        f32x4 S[16];
#pragma unroll
        for (int kb = 0; kb < 16; ++kb) { S[kb] = (f32x4){0.f, 0.f, 0.f, 0.f};
#pragma unroll
            for (int ks = 0; ks < 8; ++ks) { const bf16x8 kf = *(const LAS bf16x8*)(lds + (16 * kb + fr) * RS + (32 * ks + 8 * fq) * 2);
                S[kb] = __builtin_amdgcn_mfma_f32_16x16x32_bf16(kf, qf[ks], S[kb], 0, 0, 0); } }
        float mx = -3.0e38f;
#pragma unroll
        for (int kb = 0; kb < 16; ++kb) mx = fmaxf(mx, fmaxf(fmaxf(S[kb][0], S[kb][1]), fmaxf(S[kb][2], S[kb][3])));
        mx = fmaxf(mx, __shfl_xor(mx, 16)); mx = fmaxf(mx, __shfl_xor(mx, 32));
        float l = 0.f;
#pragma unroll
        for (int kb = 0; kb < 16; ++kb)
#pragma unroll
            for (int j = 0; j < 4; ++j) { const float p = __builtin_amdgcn_exp2f(S[kb][j] - mx); S[kb][j] = p; l += p; }
        l += __shfl_xor(l, 16); l += __shfl_xor(l, 32);
        bf16x8 pf[8];
#pragma unroll
        for (int cc = 0; cc < 8; ++cc) { const u32x4 w = pack8(S[2 * cc], S[2 * cc + 1]); pf[cc] = __builtin_bit_cast(bf16x8, w); }
        __syncthreads();
        { u32x4 tv[16];
#pragma unroll
          for (int i = 0; i < 16; ++i) { const int idx = tid + 512 * i, d = idx >> 5, ch = idx & 31; tv[i] = *(const u32x4*)(Vt + ((size_t)b * D + h * 256 + d) * NMEM + ch * 8); }
          __builtin_amdgcn_sched_barrier(0);
#pragma unroll
          for (int i = 0; i < 16; ++i) { const int idx = tid + 512 * i, d = idx >> 5, ch = idx & 31; *(LAS u32x4*)(lds + d * RS + ch * 16) = tv[i]; } }
        __syncthreads();
        const float inv = 1.0f / l;
        bf16_t* orow = O + (size_t)(q0 + 16 * wid + fr) * D + h * 256 + 4 * fq;
#pragma unroll
        for (int db = 0; db < 16; ++db) { f32x4 oa = (f32x4){0.f, 0.f, 0.f, 0.f};
#pragma unroll
            for (int cc = 0; cc < 8; ++cc) { const bf16x8 vf = *(const LAS bf16x8*)(lds + (16 * db + fr) * RS + (32 * cc + 8 * fq) * 2);
                oa = __builtin_amdgcn_mfma_f32_16x16x32_bf16(vf, pf[cc], oa, 0, 0, 0); }
            u32x2 o; o.x = cvt_pk_bf16(oa[0] * inv, oa[1] * inv); o.y = cvt_pk_bf16(oa[2] * inv, oa[3] * inv);
            *(u32x2*)(orow + 16 * db) = o; }
    }
}

#ifndef REP_P0
#define REP_P0 1
#endif
#ifndef REP_CONV
#define REP_CONV 1
#endif
#ifndef REP_SGU
#define REP_SGU 1
#endif
#ifndef REP_ATTN
#define REP_ATTN 1
#endif
#ifndef LSTART
#define LSTART 0
#endif
#ifndef LEND
#define LEND 2
#endif
__global__ void __launch_bounds__(NTHR, 2) fwd_kernel(Args a) {
    extern __shared__ __attribute__((aligned(16))) unsigned char lds_raw[];
    LAS unsigned char* lds = (LAS unsigned char*)lds_raw;
    volatile LAS unsigned* MISC = (volatile LAS unsigned*)(lds + MISC_OFF);
    const int tid = threadIdx.x, lane = tid & 63, wave = __builtin_amdgcn_readfirstlane(tid >> 6);
    const int G = gridDim.x, bx = blockIdx.x, vcu = (G % 8 == 0) ? (bx % 8) * (G / 8) + bx / 8 : bx;
    unsigned char* ws = a.ws;
    if (tid < 32) MISC[tid] = 0u;
    __syncthreads();
    XcdBarrier bar = xcd_barrier_post((unsigned*)(ws + WS_CTL), MISC + 8);
    const int gw = vcu * NWAVES + wave, NGW = G * NWAVES;
    float* out = a.out; float* ssq = (float*)(ws + WS_SSQ); float* vst = (float*)(ws + WS_VST);
    bf16_t* HB = (bf16_t*)(ws + WS_HB); bf16_t* MB = (bf16_t*)(ws + WS_MB); bf16_t* BIG = (bf16_t*)(ws + WS_BIG);
    bf16_t* MEMN = (bf16_t*)(ws + WS_MEMN); bf16_t* KB = (bf16_t*)(ws + WS_KB); bf16_t* VT = (bf16_t*)(ws + WS_VT);
#define GRID_BAR() xcd_barrier(bar)
#ifdef NO_GEMM
#define GEMM(EpiT, E, Ap, Bp, M_, N_, K_, cc) do {} while (0)
#else
#define GEMM(EpiT, E, Ap, Bp, M_, N_, K_, cc) do { Gemm g{(const bf16_t*)(Ap), (const bf16_t*)(Bp), (M_), (N_), (K_)}; int cc_ = (cc); asm volatile("" : "+s"(cc_)); StaticOrder S; S.init((M_), (N_), G, cc_); gemm_phase<EpiT, StaticOrder, true, true>(lds, g, S, (E)); } while (0)
#endif

    _Pragma("unroll 1") for (int rep = 0; rep < REP_P0; ++rep) { if (rep) GRID_BAR(); p0_prologue(a, lds, gw, NGW, wave, lane); }
    cg::this_grid().sync();

#pragma unroll
    for (int l = LSTART; l < LEND; ++l) {
        unsigned char* wl = ws + WS_W + (size_t)l * W_LAYER;
        if (l == 0) {
            { EpiScale E{BIG, DZ0, ssq}; GEMM(EpiScale, E, HB, wl + W_IN, T, DZ0, D, bx); }
#pragma unroll 1
            for (int l2 = 0; l2 < 2; ++l2) { EpiKV E{KB + (size_t)l2 * 512 * D, VT + (size_t)l2 * 2 * D * NMEM};
                const int c2 = (G - 1 - bx + (l2 ? G - 16 : 0)) % G;
                GEMM(EpiKV, E, MEMN + (size_t)l2 * 512 * D, ws + WS_W + (size_t)l2 * W_LAYER + W_KV, 512, 2 * D, D, c2); }
            GRID_BAR();
            _Pragma("unroll 1") for (int rep = 0; rep < REP_CONV; ++rep) { if (rep) GRID_BAR();
            conv_phase(lds, BIG, MB, a.in[8], a.in[9], a.in[10], a.in[11], a.in[12], a.in[13], G, bx); }
            GRID_BAR();
            { EpiRes E{a.in[0], out, HB, ssq}; GEMM(EpiRes, E, MB, wl + W_OUT, T, D, D, bx); }
        } else {
            { EpiZ1 E{BIG, ssq, vst}; GEMM(EpiZ1, E, HB, wl + W_IN, T, DZ1, D, bx); }
            GRID_BAR();
            _Pragma("unroll 1") for (int rep = 0; rep < REP_SGU; ++rep) { if (rep) GRID_BAR(); sgu_phase(lds, BIG, vst, (const bf16_t*)(ws + WS_WSB), a.in[19], a.in[16], a.in[17], MB, G, bx); }
            GRID_BAR();
            { EpiRes E{out, out, HB, ssq}; GEMM(EpiRes, E, MB, wl + W_OUT, T, D, D, bx); }
        }
        GRID_BAR();
        { EpiScale E{BIG, D, ssq}; GEMM(EpiScale, E, HB, wl + W_Q, T, D, D, bx); }
        GRID_BAR();
        _Pragma("unroll 1") for (int rep = 0; rep < REP_ATTN; ++rep) { if (rep) GRID_BAR(); attn_phase(lds, BIG, KB + (size_t)l * 512 * D, VT + (size_t)l * 2 * D * NMEM, MB, G, bx); }
        GRID_BAR();
        { EpiRes E{out, out, HB, ssq}; GEMM(EpiRes, E, MB, wl + W_O, T, D, D, bx); }
        GRID_BAR();
        { EpiGU E{BIG, ssq}; GEMM(EpiGU, E, HB, wl + W_GU, T, NGU, D, bx); }
        GRID_BAR();
        { EpiRes E{out, out, HB, ssq}; GEMM(EpiRes, E, BIG, wl + W_DN, T, D, DFF, bx); }
        GRID_BAR();
    }
    { int t2 = threadIdx.x; asm volatile("" : "+v"(t2)); const int lane = t2 & 63, gw = vcu * NWAVES + __builtin_amdgcn_readfirstlane(t2 >> 6);
      const f32x4* gr = (const f32x4*)a.in[6] + lane;
      for (int m = gw; m < T; m += NGW) { f32x4* p = (f32x4*)(out + (size_t)m * D) + lane; f32x4 v[4]; float s = 0.f;
#pragma unroll
          for (int j = 0; j < 4; ++j) { v[j] = p[64 * j]; s += (v[j][0] * v[j][0] + v[j][1] * v[j][1]) + (v[j][2] * v[j][2] + v[j][3] * v[j][3]); }
          const float rs = rsqrtf(wave_sum(s) * (1.0f / 1024.0f) + RMS_EPS);
#pragma unroll
          for (int j = 0; j < 4; ++j) p[64 * j] = v[j] * rs * gr[64 * j]; } }
}

extern "C" void kernel_launch(void* const* d_in, const int* in_sizes, int n_in, void* d_out, int out_size, void* d_ws, size_t ws_size, hipStream_t stream) {
    static int grid = 0;
    if (grid == 0) {
        if (n_in != 28 || out_size != T * D || ws_size < WS_END) { fprintf(stderr, "kernel_launch: unexpected shapes (n_in %d out %d ws %zu)\n", n_in, out_size, ws_size); grid = -1; return; }
        int dev = 0, cus = 0, per_cu = 0;
        (void)hipGetDevice(&dev); (void)hipDeviceGetAttribute(&cus, hipDeviceAttributeMultiprocessorCount, dev);
        (void)hipFuncSetAttribute((const void*)fwd_kernel, hipFuncAttributeMaxDynamicSharedMemorySize, LDS_BYTES);
        (void)hipOccupancyMaxActiveBlocksPerMultiprocessor(&per_cu, (const void*)fwd_kernel, NTHR, LDS_BYTES);
        if (per_cu < 1) per_cu = 1;
        (void)hipGetLastError();
        grid = cus;
        if (grid % 8 != 0 || grid < 64) fprintf(stderr, "kernel_launch: unusual CU count %d\n", grid);
    }
    if (grid < 0) return;
    (void)hipMemsetAsync((char*)d_ws + WS_CTL, 0, CTL_ZERO_BYTES, stream);
    Args a{};
    for (int i = 0; i < 28; ++i) a.in[i] = (const float*)d_in[i];
    a.out = (float*)d_out; a.ws = (unsigned char*)d_ws;
    void* args[] = {&a};
    hipError_t e = hipLaunchCooperativeKernel((const void*)fwd_kernel, dim3(grid), dim3(NTHR), args, LDS_BYTES, stream);
    if (e != hipSuccess) fprintf(stderr, "cooperative launch failed: %s (grid %d)\n", hipGetErrorString(e), grid);
}
```

```cpp
#include <hip/hip_runtime.h>
#include <hip/hip_cooperative_groups.h>
#include <cstdio>
#include <cstdint>
namespace cg = cooperative_groups;
namespace pg8 {
#define PG8_LAS __attribute__((address_space(3)))
typedef unsigned short bf16_t;
typedef short bf16x8 __attribute__((ext_vector_type(8)));
typedef float f32x4 __attribute__((ext_vector_type(4)));
typedef unsigned u32x4 __attribute__((ext_vector_type(4)));
constexpr int BM = 256, BK = 64, HALF = 128, HTB = HALF * BK * 2  , STAGE_BYTES = 8 * HTB, NXCD = 8, WGM = 8;

__host__ __device__ __forceinline__ int lds_byte(int r, int c) { const int st = (r >> 4) * 2 + (c >> 5), rr = r & 15, cc = c & 31, ob = rr * 64 + cc * 2; return st * 1024 + (ob ^ (((ob >> 9) & 1) << 5)); }
__host__ __device__ __forceinline__ void stage_rc(int b, int& R, int& C) { const int st = b / 1024, sb = b % 1024, swz = sb ^ (((sb >> 9) & 1) << 5); R = (st >> 1) * 16 + swz / 64; C = (st & 1) * 32 + (swz % 64) / 2; }
__host__ __device__ __forceinline__ int perm32(int rho) { const int n = rho >> 4, i = rho & 15; return 8 * (i >> 2) + 4 * n + (i & 3); }

struct Unit { int pm, pn; };
struct Gemm { const bf16_t* A; const bf16_t* Bt; int M, N, K; };

struct StaticOrder {
    int nM, nN, nwg, G, c;
    __host__ __device__ void init(int M, int N, int G_, int c_) { nM = M / BM; nN = N / BM; nwg = nM * nN; G = G_; c = c_; }
    __host__ __device__ bool next(int i, Unit& u) const {
        const long L = (long)i * G + c; if (L >= nwg) return false;
        int wgid = (int)L; { const int q = nwg / NXCD, r = nwg % NXCD, xcd = wgid % NXCD, off = wgid / NXCD; wgid = (xcd < r ? xcd * (q + 1) : r * (q + 1) + (xcd - r) * q) + off; }
        const int nig = WGM * nN, gid = wgid / nig, fm = gid * WGM, gsz = (nM - fm) < WGM ? (nM - fm) : WGM;
        u.pm = fm + ((wgid % nig) % gsz); u.pn = (wgid % nig) / gsz; return true;
    }
    __device__ __forceinline__ void a_ready(const Unit&) const {}
    __device__ __forceinline__ void done(const Unit&) const {}
};

__device__ __forceinline__ unsigned cvt_pk_bf16(float lo, float hi) { unsigned r; asm volatile("v_cvt_pk_bf16_f32 %0, %1, %2" : "=v"(r) : "v"(lo), "v"(hi)); return r; }
typedef float f32x2 __attribute__((ext_vector_type(2)));
template <class Epi, class Sched, bool ALIGN_EPI = false, bool SP2 = false>
__device__ __forceinline__ void gemm_phase(PG8_LAS unsigned char* lds, const Gemm g, const Sched& S, const Epi& E) {
    int tid_ = threadIdx.x; asm volatile("" : "+v"(tid_));
    const int tid = tid_, wid = __builtin_amdgcn_readfirstlane(tid >> 6), lane = tid & 63, wr = wid >> 2, wc = wid & 3, fr = lane & 15, fq = lane >> 4;
    const int K = g.K, nt = K / BK;
    unsigned voffA[2], voffB[2];
#pragma unroll
    for (int i = 0; i < 2; ++i) { int R, C; stage_rc(tid * 16 + i * 8192, R, C); const int Rb = Epi::PERM ? ((R & ~31) + perm32(R & 31)) : R;
        voffA[i] = (unsigned)(R * K + C) * 2u; voffB[i] = (unsigned)(Rb * K + C) * 2u; }
    const size_t kstep = (size_t)(BK * 2);
    const size_t hstep = (size_t)HALF * K * 2;
    const size_t tstep = 2 * hstep;
    const unsigned ldsw = (unsigned)wid * 1024u;
    const int aoff = lds_byte(wr * 64 + fr, fq * 8), boff = lds_byte(wc * 32 + fr, fq * 8);
#define PG8_SA(b, h) (((b) * 2 + (h)) * HTB)
#define PG8_SB(b, h) ((4 + (b) * 2 + (h)) * HTB)
#define PG8_STAGE(bufoff, gbase, voff) do { _Pragma("unroll") for (int _i = 0; _i < 2; ++_i) \
        __builtin_amdgcn_global_load_lds((const unsigned*)((const char*)(gbase) + (voff)[_i]), (PG8_LAS unsigned*)(lds + (bufoff) + ldsw + _i * 8192), 16, 0, 0); } while (0)
#define PG8_LDA(dst, b, h) do { _Pragma("unroll") for (int m = 0; m < 4; ++m) _Pragma("unroll") for (int k = 0; k < 2; ++k) dst[m][k] = *(const PG8_LAS bf16x8*)(lds + PG8_SA(b, h) + aoff + m * 2048 + k * 1024); } while (0)
#define PG8_LDB(dst, b, h) do { _Pragma("unroll") for (int n = 0; n < 2; ++n) _Pragma("unroll") for (int k = 0; k < 2; ++k) dst[n][k] = *(const PG8_LAS bf16x8*)(lds + PG8_SB(b, h) + boff + n * 2048 + k * 1024); } while (0)
#define PG8_MMA(ai, bj, At, Bt) do { __builtin_amdgcn_s_setprio(1); _Pragma("unroll") for (int m = 0; m < 4; ++m) _Pragma("unroll") for (int n = 0; n < 2; ++n) _Pragma("unroll") for (int k = 0; k < 2; ++k) \
        acc[ai][bj][m][n] = __builtin_amdgcn_mfma_f32_16x16x32_bf16(Bt[n][k], At[m][k], acc[ai][bj][m][n], 0, 0, 0); __builtin_amdgcn_s_setprio(0); } while (0)
#define PG8_WAIT_V(n) asm volatile("s_waitcnt vmcnt(" #n ")" ::: "memory")
#define PG8_WAIT_L(n) asm volatile("s_waitcnt lgkmcnt(" #n ")" ::: "memory")
#define PG8_BAR __builtin_amdgcn_s_barrier()
#define PG8_SCHED __builtin_amdgcn_sched_barrier(0)
    Unit cur, nxt; int ui = 0;
    if (!S.next(0, cur)) return;
    f32x4 acc[2][2][4][2];
#pragma unroll
    for (int a = 0; a < 2; ++a)
#pragma unroll
        for (int b = 0; b < 2; ++b)
#pragma unroll
            for (int m = 0; m < 4; ++m)
#pragma unroll
                for (int n = 0; n < 2; ++n) acc[a][b][m][n] = (f32x4){0.f, 0.f, 0.f, 0.f};
    bf16x8 At[4][2], B0[2][2], B1[2][2];
    const char* cA = (const char*)g.A + (size_t)cur.pm * tstep; const char* cB = (const char*)g.Bt + (size_t)cur.pn * tstep;
    S.a_ready(cur);
    if constexpr (SP2) {
        PG8_STAGE(PG8_SB(0, 0), cB, voffB); PG8_STAGE(PG8_SB(0, 1), cB + hstep, voffB); PG8_STAGE(PG8_SA(0, 0), cA, voffA); PG8_STAGE(PG8_SA(0, 1), cA + hstep, voffA);
        if (wr == 1) PG8_BAR;
        PG8_WAIT_V(2); PG8_BAR;
        PG8_STAGE(PG8_SB(1, 0), cB + kstep, voffB); PG8_STAGE(PG8_SA(1, 0), cA + kstep, voffA); PG8_STAGE(PG8_SB(1, 1), cB + hstep + kstep, voffB);
        PG8_WAIT_V(6); PG8_BAR;
    } else {
        PG8_STAGE(PG8_SB(0, 0), cB, voffB); PG8_STAGE(PG8_SA(0, 0), cA, voffA); PG8_STAGE(PG8_SB(0, 1), cB + hstep, voffB); PG8_STAGE(PG8_SA(0, 1), cA + hstep, voffA);
        if (wr == 1) PG8_BAR;
        PG8_WAIT_V(4); PG8_BAR;
        PG8_STAGE(PG8_SB(1, 0), cB + kstep, voffB); PG8_STAGE(PG8_SA(1, 0), cA + kstep, voffA); PG8_STAGE(PG8_SB(1, 1), cB + hstep + kstep, voffB);
        PG8_WAIT_V(6); PG8_BAR;
    }
    for (;;) {
        const bool has_next = S.next(ui + 1, nxt);
        const char* nA = has_next ? (const char*)g.A + (size_t)nxt.pm * tstep : cA; const char* nB = has_next ? (const char*)g.Bt + (size_t)nxt.pn * tstep : cB;
        for (int t = 0; t < nt; t += 2) {
            const bool last = (t == nt - 2);
            const char* a1 = cA + (size_t)(t + 1) * kstep;
            const char* a2 = last ? nA : cA + (size_t)(t + 2) * kstep; const char* b2 = last ? nB : cB + (size_t)(t + 2) * kstep;
            const char* a3 = a2 + kstep; const char* b3 = b2 + kstep;
            if (last && has_next) S.a_ready(nxt);
            if constexpr (SP2) {
            PG8_LDB(B0, 0, 0); PG8_LDB(B1, 0, 1); PG8_SCHED; PG8_LDA(At, 0, 0); PG8_STAGE(PG8_SA(1, 1), a1 + hstep, voffA);
            PG8_WAIT_V(8); PG8_WAIT_L(0); PG8_BAR; PG8_MMA(0, 0, At, B0); PG8_MMA(0, 1, At, B1); PG8_BAR; PG8_SCHED;
            PG8_LDA(At, 0, 1); PG8_STAGE(PG8_SB(0, 0), b2, voffB); PG8_STAGE(PG8_SB(0, 1), b2 + hstep, voffB); PG8_STAGE(PG8_SA(0, 0), a2, voffA);
            PG8_WAIT_V(8); PG8_WAIT_L(0); PG8_BAR; PG8_MMA(1, 0, At, B0); PG8_MMA(1, 1, At, B1); PG8_BAR; PG8_SCHED;
            PG8_LDB(B0, 1, 0); PG8_LDB(B1, 1, 1); PG8_SCHED; PG8_LDA(At, 1, 0); PG8_STAGE(PG8_SA(0, 1), a2 + hstep, voffA);
            PG8_WAIT_V(8); PG8_WAIT_L(0); PG8_BAR; PG8_MMA(0, 0, At, B0); PG8_MMA(0, 1, At, B1); PG8_BAR; PG8_SCHED;
            PG8_LDA(At, 1, 1); PG8_STAGE(PG8_SB(1, 0), b3, voffB); PG8_STAGE(PG8_SB(1, 1), b3 + hstep, voffB); PG8_STAGE(PG8_SA(1, 0), a3, voffA);
            PG8_WAIT_V(8); PG8_WAIT_L(0); PG8_BAR; PG8_MMA(1, 0, At, B0); PG8_MMA(1, 1, At, B1); PG8_BAR; PG8_SCHED;
            } else {
            PG8_LDB(B0, 0, 0); PG8_SCHED; PG8_LDA(At, 0, 0); PG8_STAGE(PG8_SA(1, 1), a1 + hstep, voffA);
            PG8_WAIT_L(8); PG8_BAR; PG8_WAIT_L(0); PG8_MMA(0, 0, At, B0); PG8_BAR; PG8_SCHED;
            PG8_LDB(B1, 0, 1); PG8_STAGE(PG8_SB(0, 0), b2, voffB);
            PG8_BAR; PG8_WAIT_L(0); PG8_MMA(0, 1, At, B1); PG8_BAR;
            PG8_LDA(At, 0, 1); PG8_STAGE(PG8_SA(0, 0), a2, voffA);
            PG8_BAR; PG8_WAIT_L(0); PG8_MMA(1, 0, At, B0); PG8_BAR; PG8_SCHED;
            PG8_STAGE(PG8_SB(0, 1), b2 + hstep, voffB);
            PG8_WAIT_V(6); PG8_BAR; PG8_MMA(1, 1, At, B1); PG8_BAR;
            PG8_LDB(B0, 1, 0); PG8_SCHED; PG8_LDA(At, 1, 0); PG8_STAGE(PG8_SA(0, 1), a2 + hstep, voffA);
            PG8_WAIT_L(8); PG8_BAR; PG8_WAIT_L(0); PG8_MMA(0, 0, At, B0); PG8_BAR; PG8_SCHED;
            PG8_LDB(B1, 1, 1); PG8_STAGE(PG8_SB(1, 0), b3, voffB);
            PG8_BAR; PG8_WAIT_L(0); PG8_MMA(0, 1, At, B1); PG8_BAR;
            PG8_LDA(At, 1, 1); PG8_STAGE(PG8_SA(1, 0), a3, voffA);
            PG8_BAR; PG8_WAIT_L(0); PG8_MMA(1, 0, At, B0); PG8_BAR; PG8_SCHED;
            PG8_STAGE(PG8_SB(1, 1), b3 + hstep, voffB);
            PG8_WAIT_V(6); PG8_BAR; PG8_MMA(1, 1, At, B1); PG8_BAR;
            }
        }
        if constexpr (ALIGN_EPI) { if (wr == 0) PG8_BAR; }
        if constexpr (!Epi::AFTER_DRAIN) { E(acc, cur, wr, wc, fr, fq); S.done(cur); }
        if (!has_next) break;
#pragma unroll
        for (int a = 0; a < 2; ++a)
#pragma unroll
            for (int b = 0; b < 2; ++b)
#pragma unroll
                for (int m = 0; m < 4; ++m)
#pragma unroll
                    for (int n = 0; n < 2; ++n) acc[a][b][m][n] = (f32x4){0.f, 0.f, 0.f, 0.f};
        cur = nxt; cA = nA; cB = nB; ++ui;
        if constexpr (ALIGN_EPI) { if (wr == 1) PG8_BAR; }
    }
    PG8_WAIT_V(0);
    if constexpr (!ALIGN_EPI) { if (wr == 0) PG8_BAR; }
    PG8_BAR;
    if constexpr (Epi::AFTER_DRAIN) { E.fused(acc, cur, wr, wc, fr, fq, lds, wid, lane); S.done(cur); }
#undef PG8_SA
#undef PG8_SB
#undef PG8_STAGE
#undef PG8_LDA
#undef PG8_LDB
#undef PG8_MMA
#undef PG8_WAIT_V
#undef PG8_WAIT_L
#undef PG8_BAR
#undef PG8_SCHED
}
}
#define LAS __attribute__((address_space(3)))
#define XB_TMO      128
#define XB_XCNT(j)  (256  + 64 * (j))
#define XB_XSUB(j)  (1280 + 64 * (j))
#define XB_XGEN(j)  (2304 + 64 * (j))
#define XB_TOP      3328
#define XB_TOPGEN   3392
#define XCD_BAR_WORDS 3456
#define XB_SPIN_CAP (1u << 18)

__device__ __forceinline__ unsigned xb_ld(unsigned* p)              { return __hip_atomic_load(p, __ATOMIC_RELAXED, __HIP_MEMORY_SCOPE_AGENT); }
__device__ __forceinline__ unsigned xb_add(unsigned* p, unsigned v) { return __hip_atomic_fetch_add(p, v, __ATOMIC_RELAXED, __HIP_MEMORY_SCOPE_AGENT); }
__device__ __forceinline__ unsigned xb_xcc_id() { return (unsigned)__builtin_amdgcn_s_getreg((3 << 11) | 20) & 0xFu; }
#define XB_SPIN(cond, bar) do { unsigned _sp = 0; while (cond) { __builtin_amdgcn_s_sleep(1); \
    if ((++_sp & 255u) == 0u) { if (xb_ld(&(bar)[XB_TMO])) break; if (_sp > XB_SPIN_CAP) { atomicAdd(&(bar)[XB_TMO], 1u); break; } } } } while (0)

struct XcdBarrier {
    unsigned* bar; unsigned x;
    volatile LAS unsigned* st;
};

__device__ __forceinline__ XcdBarrier xcd_barrier_post(unsigned* bar, volatile LAS unsigned* st) {
    XcdBarrier b; b.bar = bar; b.x = xb_xcc_id(); b.st = st;
    if (threadIdx.x == 0) (void)xb_add(&bar[XB_XCNT(b.x)], 1u);
    return b;
}
__device__ __forceinline__ void xcd_barrier_complete(unsigned* bar, unsigned x, unsigned& nloc, unsigned& nx) {
    const unsigned G = gridDim.x * gridDim.y * gridDim.z;
    unsigned sum, cnt, mine, sp = 0u;
    for (;;) {
        sum = 0u; cnt = 0u; mine = 0u;
#pragma unroll
        for (unsigned j = 0; j < 16; ++j) { const unsigned c = xb_ld(&bar[XB_XCNT(j)]); sum += c; cnt += (c > 0u) ? 1u : 0u; mine = (j == x) ? c : mine; }
        if (sum == G) break;
        __builtin_amdgcn_s_sleep(1);
        if ((++sp & 255u) == 0u) { if (xb_ld(&bar[XB_TMO])) break; if (sp > XB_SPIN_CAP) { atomicAdd(&bar[XB_TMO], 1u); break; } }
    }
    nloc = mine > 0u ? mine : 1u; nx = cnt > 0u ? cnt : 1u;
}

__device__ __forceinline__ void xcd_barrier(const XcdBarrier& b) {
    asm volatile("s_waitcnt vmcnt(0)" ::: "memory");
    __syncthreads();
    if (threadIdx.x == 0) {
        unsigned* bar = b.bar; const unsigned bx_ = xb_xcc_id();
        __builtin_amdgcn_s_waitcnt(0);
        unsigned nloc = b.st[0], nx = b.st[1];
        if (nloc == 0u) { xcd_barrier_complete(bar, bx_, nloc, nx); b.st[0] = nloc; b.st[1] = nx; }
        const unsigned old = xb_add(&bar[XB_XSUB(bx_)], 1u);
        const unsigned gen = old / nloc;
        if (old + 1u == (gen + 1u) * nloc) {
            __builtin_amdgcn_fence(__ATOMIC_RELEASE, "agent");
            asm volatile("s_waitcnt vmcnt(0)" ::: "memory");
            const unsigned og = xb_add(&bar[XB_TOP], 1u);
            const unsigned tg = og / nx;
            if (og + 1u == (tg + 1u) * nx) xb_add(&bar[XB_TOPGEN], 1u);
            else XB_SPIN(xb_ld(&bar[XB_TOPGEN]) == tg, bar);
            __builtin_amdgcn_fence(__ATOMIC_ACQUIRE, "agent");
            xb_add(&bar[XB_XGEN(bx_)], 1u);
            asm volatile("s_waitcnt vmcnt(0)" ::: "memory");
        } else {
            XB_SPIN(xb_ld(&bar[XB_XGEN(bx_)]) == gen, bar);
            __builtin_amdgcn_fence(__ATOMIC_ACQUIRE, "agent");
            asm volatile("s_waitcnt vmcnt(0)" ::: "memory");
        }
    }
    __syncthreads();
}
#undef LAS
using namespace pg8;
#define LAS __attribute__((address_space(3)))
typedef unsigned u32x2 __attribute__((ext_vector_type(2)));

constexpr int NWAVES = 8, NTHR = 512;
constexpr int SEQ = 8192, NBATCH = 2, T = NBATCH * SEQ, D = 1024, DZ0 = 2560, DZ1 = 2048, DFF = 2816, NGU = 2 * DFF, NMEM = 256;
constexpr float RMS_EPS = 1e-6f, LN_EPS = 1e-5f;
constexpr size_t MiB = 1u << 20;
constexpr size_t WS_CTL = 0, CTL_ZERO_BYTES = 64 * 1024;
constexpr size_t WS_W = 2 * MiB, W_LAYER = 32 * MiB;
constexpr size_t W_IN = 0, W_OUT = 5 * MiB, W_Q = 7 * MiB, W_KV = 9 * MiB, W_O = 13 * MiB, W_GU = 15 * MiB, W_DN = 26 * MiB;
constexpr size_t WS_WSB = 66 * MiB;
constexpr size_t WS_SSQ = 67 * MiB;
constexpr size_t WS_VST = 68 * MiB;
constexpr size_t WS_MEMN = 70 * MiB;
constexpr size_t WS_KB = 72 * MiB;
constexpr size_t WS_VT = 74 * MiB;
constexpr size_t WS_HB = 76 * MiB;
constexpr size_t WS_MB = 108 * MiB;
constexpr size_t WS_BIG = 140 * MiB;
constexpr size_t WS_END = 228 * MiB;
constexpr int LDS_BYTES = 147456, MISC_OFF = 139264;

__device__ __forceinline__ float wave_sum(float v) {
#pragma unroll
    for (int o = 1; o < 64; o <<= 1) v += __shfl_xor(v, o);
    return v;
}
__device__ __forceinline__ float bf2f(unsigned short b) { return __uint_as_float((unsigned)b << 16); }
__device__ __forceinline__ float bflo(unsigned w) { return __uint_as_float(w << 16); }
__device__ __forceinline__ float bfhi(unsigned w) { return __uint_as_float(w & 0xffff0000u); }
__device__ __forceinline__ unsigned short f2bf(float f) { return (unsigned short)(cvt_pk_bf16(f, 0.f) & 0xffffu); }
__device__ __forceinline__ float sigm(float x) { return __builtin_amdgcn_rcpf(1.f + __builtin_amdgcn_exp2f(-1.44269504f * x)); }
__device__ __forceinline__ float gelu_tanh(float x) { const float y = 1.5957691216f * (x + 0.044715f * x * x * x); return x * sigm(y); }

__device__ __forceinline__ float row_rstd(const float* ssq, int row, int fq) {
    const f32x4 a = *(const f32x4*)(ssq + (size_t)row * 16 + 4 * fq);
    float s = (a[0] + a[1]) + (a[2] + a[3]);
    s += __shfl_xor(s, 16); s += __shfl_xor(s, 32);
    return rsqrtf(s * (1.0f / 1024.0f) + RMS_EPS);
}
__device__ __forceinline__ u32x4 pack8(const f32x4 v0, const f32x4 v1) { u32x4 w; w.x = cvt_pk_bf16(v0[0], v0[1]); w.y = cvt_pk_bf16(v0[2], v0[3]); w.z = cvt_pk_bf16(v1[0], v1[1]); w.w = cvt_pk_bf16(v1[2], v1[3]); return w; }

struct EpiScale {
    static constexpr bool PERM = true, AFTER_DRAIN = false;
    bf16_t* O; int ldc; const float* ssq;
    __device__ __forceinline__ void operator()(const f32x4 (&acc)[2][2][4][2], const Unit& u, int wr, int wc, int fr, int fq) const {
        const int row0 = u.pm * BM + wr * 64 + fr, col0 = u.pn * BM + wc * 32 + 8 * fq;
#pragma unroll
        for (int ai = 0; ai < 2; ++ai)
#pragma unroll
            for (int m = 0; m < 4; ++m) { const int row = row0 + ai * HALF + m * 16; const float rs = ssq ? row_rstd(ssq, row, fq) : 1.f; bf16_t* rowp = O + (size_t)row * ldc + col0;
#pragma unroll
                for (int bj = 0; bj < 2; ++bj) *(u32x4*)(rowp + bj * HALF) = pack8(acc[ai][bj][m][0] * rs, acc[ai][bj][m][1] * rs); }
    }
};
struct EpiRes {
    static constexpr bool PERM = true, AFTER_DRAIN = false;
    bf16_t* hb; float* ssq;
    __device__ __forceinline__ void operator()(const f32x4 (&acc)[2][2][4][2], const Unit& u, int wr, int wc, int fr, int fq) const {
        const int row0 = u.pm * BM + wr * 64 + fr, col0 = u.pn * BM + wc * 32 + 8 * fq;
#pragma unroll
        for (int ai = 0; ai < 2; ++ai)
#pragma unroll
            for (int m = 0; m < 4; ++m) { const int row = row0 + ai * HALF + m * 16; const size_t off = (size_t)row * D + col0; float q = 0.f;
#pragma unroll
                for (int bj = 0; bj < 2; ++bj) { const u32x4 bb = *(const u32x4*)(hb + off + bj * HALF);
                    const f32x4 b0 = (f32x4){bflo(bb.x), bfhi(bb.x), bflo(bb.y), bfhi(bb.y)}, b1 = (f32x4){bflo(bb.z), bfhi(bb.z), bflo(bb.w), bfhi(bb.w)};
                    const f32x4 v0 = b0 + acc[ai][bj][m][0], v1 = b1 + acc[ai][bj][m][1];
                    *(u32x4*)(hb + off + bj * HALF) = pack8(v0, v1);
                    q += ((v0[0] * v0[0] + v0[1] * v0[1]) + (v0[2] * v0[2] + v0[3] * v0[3])) + ((v1[0] * v1[0] + v1[1] * v1[1]) + (v1[2] * v1[2] + v1[3] * v1[3])); }
                q += __shfl_xor(q, 16); q += __shfl_xor(q, 32);
                if (fq == 0) ssq[(size_t)row * 16 + u.pn * 4 + wc] = q; }
    }
};
struct EpiGU {
    static constexpr bool PERM = true, AFTER_DRAIN = false;
    bf16_t* O; const float* ssq;
    __device__ __forceinline__ void operator()(const f32x4 (&acc)[2][2][4][2], const Unit& u, int wr, int wc, int fr, int fq) const {
        const int row0 = u.pm * BM + wr * 64 + fr, col0 = u.pn * HALF + wc * 32 + 8 * fq;
#pragma unroll
        for (int ai = 0; ai < 2; ++ai)
#pragma unroll
            for (int m = 0; m < 4; ++m) { const int row = row0 + ai * HALF + m * 16; const float rs = row_rstd(ssq, row, fq);
                f32x4 h[2];
#pragma unroll
                for (int n = 0; n < 2; ++n)
#pragma unroll
                    for (int j = 0; j < 4; ++j) { const float g = acc[ai][0][m][n][j] * rs, up = acc[ai][1][m][n][j] * rs; h[n][j] = g * sigm(g) * up; }
                *(u32x4*)(O + (size_t)row * DFF + col0) = pack8(h[0], h[1]); }
    }
};
struct EpiZ1 {
    static constexpr bool PERM = true, AFTER_DRAIN = false;
    bf16_t* O; const float* ssq; float* vst;
    __device__ __forceinline__ void operator()(const f32x4 (&acc)[2][2][4][2], const Unit& u, int wr, int wc, int fr, int fq) const {
        const int row0 = u.pm * BM + wr * 64 + fr, col0 = u.pn * BM + wc * 32 + 8 * fq;
#pragma unroll
        for (int ai = 0; ai < 2; ++ai)
#pragma unroll
            for (int m = 0; m < 4; ++m) { const int row = row0 + ai * HALF + m * 16; const float rs = row_rstd(ssq, row, fq); bf16_t* rowp = O + (size_t)row * DZ1 + col0; float s = 0.f, q = 0.f;
#pragma unroll
                for (int bj = 0; bj < 2; ++bj) { f32x4 v[2];
#pragma unroll
                    for (int n = 0; n < 2; ++n)
#pragma unroll
                        for (int j = 0; j < 4; ++j) { const float g = gelu_tanh(acc[ai][bj][m][n][j] * rs); v[n][j] = g; s += g; q += g * g; }
                    *(u32x4*)(rowp + bj * HALF) = pack8(v[0], v[1]); }
                if (u.pn >= 4) { s += __shfl_xor(s, 16); s += __shfl_xor(s, 32); q += __shfl_xor(q, 16); q += __shfl_xor(q, 32);
                    if (fq == 0) { float* p = vst + ((size_t)row * 16 + (u.pn - 4) * 4 + wc) * 2; p[0] = s; p[1] = q; } } }
    }
};
struct EpiKV {
    static constexpr bool PERM = true, AFTER_DRAIN = false;
    bf16_t* Kb; bf16_t* Vt;
    __device__ __forceinline__ void operator()(const f32x4 (&acc)[2][2][4][2], const Unit& u, int wr, int wc, int fr, int fq) const {
        const int col0 = (u.pn & 3) * BM + wc * 32 + 8 * fq;
#pragma unroll
        for (int ai = 0; ai < 2; ++ai)
#pragma unroll
            for (int m = 0; m < 4; ++m) { const int key = ai * HALF + wr * 64 + m * 16 + fr;
                if (u.pn < 4) { bf16_t* rowp = Kb + (size_t)(u.pm * BM + key) * D + col0;
#pragma unroll
                    for (int bj = 0; bj < 2; ++bj) *(u32x4*)(rowp + bj * HALF) = pack8(acc[ai][bj][m][0], acc[ai][bj][m][1]);
                } else { const int kp = (key & ~31) + 8 * ((key >> 2) & 3) + 4 * ((key >> 4) & 1) + (key & 3);
#pragma unroll
                    for (int bj = 0; bj < 2; ++bj)
#pragma unroll
                        for (int n = 0; n < 2; ++n)
#pragma unroll
                            for (int j = 0; j < 4; ++j) Vt[((size_t)u.pm * D + col0 + bj * HALF + 4 * n + j) * NMEM + kp] = f2bf(acc[ai][bj][m][n][j]); } }
    }
};

__device__ __forceinline__ void tr_item(const float* W, int K, int N, bf16_t* WT, const float* g, float cs, int mode, LAS float* scr, int item, int lane) {
    const int nblk = N / 64, kb = item / nblk, nb = item % nblk, k0 = 64 * kb, n0 = 64 * nb;
    const int orow = mode == 0 ? n0 : ((n0 >> 7) * 256 + (n0 & 127) + (mode == 2 ? 128 : 0));
    const int kq = lane >> 4, n4 = (lane & 15) * 4;
    f32x4 v[16]; float sc[16];
#pragma unroll
    for (int i = 0; i < 16; ++i) { const int kk = 4 * i + kq; v[i] = *(const f32x4*)(W + (size_t)(k0 + kk) * N + n0 + n4); sc[i] = g ? g[k0 + kk] * cs : cs; }
    __builtin_amdgcn_sched_barrier(0);
#pragma unroll
    for (int i = 0; i < 16; ++i) { const int kk = 4 * i + kq; LAS float* d = scr + kk * 65 + n4; d[0] = v[i][0] * sc[i]; d[1] = v[i][1] * sc[i]; d[2] = v[i][2] * sc[i]; d[3] = v[i][3] * sc[i]; }
    asm volatile("s_waitcnt lgkmcnt(0)" ::: "memory");
    const int c = lane & 7;
#pragma unroll
    for (int j = 0; j < 8; ++j) { const int n = (lane >> 3) + 8 * j; const LAS float* p = scr + (8 * c) * 65 + n;
        u32x4 o; o.x = cvt_pk_bf16(p[0 * 65], p[1 * 65]); o.y = cvt_pk_bf16(p[2 * 65], p[3 * 65]); o.z = cvt_pk_bf16(p[4 * 65], p[5 * 65]); o.w = cvt_pk_bf16(p[6 * 65], p[7 * 65]);
        *(u32x4*)(WT + (size_t)(orow + n) * K + k0 + 8 * c) = o; }
    asm volatile("s_waitcnt lgkmcnt(0)" ::: "memory");
}

struct Args { const float* in[28]; float* out; unsigned char* ws; };

__device__ __forceinline__ void p0_prologue(const Args& a, LAS unsigned char* lds, int gw, int NGW, int wave, int lane) {
    unsigned char* ws = a.ws;
    LAS float* scr = (LAS float*)(lds + wave * 16640);
    const float QS = 0.0625f * 1.44269504f;
    constexpr int I_IN0 = 16 * (DZ0 / 64), I_IN1 = 16 * (DZ1 / 64), I_SQ = 16 * 16, I_GU = 16 * (DFF / 64), I_DN = (DFF / 64) * 16;
    constexpr int NITEMS = I_IN0 + I_IN1 + 2 * 5 * I_SQ + 2 * 2 * I_GU + 2 * I_DN;
    for (int it = gw; it < NITEMS; it += NGW) {
        int r = it; bool found = false; const float* W = nullptr; int K = 0, N = 0, mode = 0; bf16_t* WT = nullptr; const float* gv = nullptr; float cs = 1.f;
#define SEL(NI, Wp, K_, N_, WTp, g_, cs_, mode_) if (!found) { if (r < (NI)) { W = (Wp); K = (K_); N = (N_); WT = (bf16_t*)(WTp); gv = (g_); cs = (cs_); mode = (mode_); found = true; } else r -= (NI); }
        SEL(I_IN0, a.in[7], D, DZ0, ws + WS_W + W_IN, a.in[2], 1.f, 0)
        SEL(I_IN1, a.in[15], D, DZ1, ws + WS_W + W_LAYER + W_IN, a.in[2] + D, 1.f, 0)
        SEL(I_SQ, a.in[14], D, D, ws + WS_W + W_OUT, nullptr, 1.f, 0)
        SEL(I_SQ, a.in[20], D, D, ws + WS_W + W_LAYER + W_OUT, nullptr, 1.f, 0)
#pragma unroll
        for (int l = 0; l < 2; ++l) {
            unsigned char* wl = ws + WS_W + l * W_LAYER;
            SEL(I_SQ, a.in[21] + (size_t)l * D * D, D, D, wl + W_Q, a.in[3] + l * D, QS, 0)
            SEL(I_SQ, a.in[22] + (size_t)l * D * D, D, D, wl + W_KV, nullptr, 1.f, 0)
            SEL(I_SQ, a.in[23] + (size_t)l * D * D, D, D, wl + W_KV + (size_t)D * D * 2, nullptr, 1.f, 0)
            SEL(I_SQ, a.in[24] + (size_t)l * D * D, D, D, wl + W_O, nullptr, 1.f, 0)
            SEL(I_GU, a.in[25] + (size_t)l * D * DFF, D, DFF, wl + W_GU, a.in[5] + l * D, 1.f, 1)
            SEL(I_GU, a.in[26] + (size_t)l * D * DFF, D, DFF, wl + W_GU, a.in[5] + l * D, 1.f, 2)
            SEL(I_DN, a.in[27] + (size_t)l * D * DFF, DFF, D, wl + W_DN, nullptr, 1.f, 0)
        }
#undef SEL
        tr_item(W, K, N, WT, gv, cs, mode, scr, r, lane);
    }
    { const f32x4* src = (const f32x4*)a.in[18]; u32x2* dst = (u32x2*)(ws + WS_WSB);
      for (int i = gw * 64 + lane; i < 8 * 128 * 128 / 4; i += NGW * 64) { const f32x4 v = src[i]; u32x2 o; o.x = cvt_pk_bf16(v[0], v[1]); o.y = cvt_pk_bf16(v[2], v[3]); dst[i] = o; } }
    { float* ssq = (float*)(ws + WS_SSQ); bf16_t* HB = (bf16_t*)(ws + WS_HB);
      for (int m0 = gw * 4; m0 < T; m0 += NGW * 4) {
          f32x4 v[4][4];
#pragma unroll
          for (int r = 0; r < 4; ++r) { const f32x4* xr = (const f32x4*)(a.in[0] + (size_t)(m0 + r) * D) + lane;
#pragma unroll
              for (int j = 0; j < 4; ++j) v[r][j] = xr[64 * j]; }
          __builtin_amdgcn_sched_barrier(0);
#pragma unroll
          for (int r = 0; r < 4; ++r) { float s = 0.f;
#pragma unroll
              for (int j = 0; j < 4; ++j) s += (v[r][j][0] * v[r][j][0] + v[r][j][1] * v[r][j][1]) + (v[r][j][2] * v[r][j][2] + v[r][j][3] * v[r][j][3]);
              s = wave_sum(s);
              u32x2* o = (u32x2*)(HB + (size_t)(m0 + r) * D) + lane;
#pragma unroll
              for (int j = 0; j < 4; ++j) { u32x2 w; w.x = cvt_pk_bf16(v[r][j][0], v[r][j][1]); w.y = cvt_pk_bf16(v[r][j][2], v[r][j][3]); o[64 * j] = w; }
              if (lane < 16) ssq[(size_t)(m0 + r) * 16 + lane] = lane == 0 ? s : 0.f; }
      } }
    { bf16_t* MN = (bf16_t*)(ws + WS_MEMN);
      for (int m = gw; m < 2 * 512; m += NGW) { const int l = m >> 9, row = m & 511;
          const f32x4* xr = (const f32x4*)(a.in[1] + (size_t)row * D) + lane; const f32x4* gr = (const f32x4*)(a.in[4] + l * D) + lane; f32x4 v[4]; float s = 0.f;
#pragma unroll
          for (int j = 0; j < 4; ++j) { v[j] = xr[64 * j]; s += (v[j][0] * v[j][0] + v[j][1] * v[j][1]) + (v[j][2] * v[j][2] + v[j][3] * v[j][3]); }
          const float rs = rsqrtf(wave_sum(s) * (1.0f / 1024.0f) + RMS_EPS);
          u32x2* o = (u32x2*)(MN + ((size_t)l * 512 + row) * D) + lane;
#pragma unroll
          for (int j = 0; j < 4; ++j) { const f32x4 g = gr[64 * j]; u32x2 w; w.x = cvt_pk_bf16(v[j][0] * rs * g[0], v[j][1] * rs * g[1]); w.y = cvt_pk_bf16(v[j][2] * rs * g[2], v[j][3] * rs * g[3]); o[64 * j] = w; }
      } }
}

__device__ __forceinline__ void unpack8(const u32x4 r, float (&v)[8]) { v[0] = bflo(r.x); v[1] = bfhi(r.x); v[2] = bflo(r.y); v[3] = bfhi(r.y); v[4] = bflo(r.z); v[5] = bfhi(r.z); v[6] = bflo(r.w); v[7] = bfhi(r.w); }
__device__ __forceinline__ void conv_phase(LAS unsigned char* lds, const bf16_t* Z, bf16_t* Mo, const float* cw, const float* cb, const float* lg, const float* lb,
                                           const float* bw, const float* bb, int G, int c) {
    constexpr int TT = 32, RR = TT + 30;
    int tid_ = threadIdx.x; asm volatile("" : "+v"(tid_)); asm volatile("" : "+s"(c), "+s"(G));
    const int tid = tid_, lane = tid & 63, wid = tid >> 6;
    LAS float* as = (LAS float*)lds;
    LAS float* os = (LAS float*)lds;
    for (int u = c; u < T / TT; u += G) {
        const int t0 = u * TT, b = t0 / SEQ, s0 = t0 % SEQ;
        const bf16_t* zb = Z + (size_t)b * SEQ * DZ0;
        __syncthreads();
        { u32x4 rv[8], rg[8];
#pragma unroll
          for (int i = 0; i < 8; ++i) { const int idx = tid + 512 * i, r = idx >> 6, cc = idx & 63, sq = s0 - 15 + r; const bool ok = (idx < RR * 64) && (sq >= 0) && (sq < SEQ);
              const bf16_t* p = zb + (size_t)(ok ? sq : s0) * DZ0 + cc * 8; rv[i] = *(const u32x4*)p; rg[i] = *(const u32x4*)(p + 512);
              if (!ok) rv[i] = (u32x4){0u, 0u, 0u, 0u}; }
          __builtin_amdgcn_sched_barrier(0);
#pragma unroll
          for (int i = 0; i < 8; ++i) { const int idx = tid + 512 * i, r = idx >> 6, cc = idx & 63; float v[8], gt[8]; unpack8(rv[i], v); unpack8(rg[i], gt);
              f32x4 a0, a1;
#pragma unroll
              for (int j = 0; j < 4; ++j) { a0[j] = v[j] * sigm(gt[j]); a1[j] = v[4 + j] * sigm(gt[4 + j]); }
              if (idx < RR * 64) { *(LAS f32x4*)(as + r * 512 + cc * 8) = a0; *(LAS f32x4*)(as + r * 512 + cc * 8 + 4) = a1; } } }
        __syncthreads();
        float o[TT];
        { float w[31]; const float* cw_ = cw; const float* cb_ = cb; asm volatile("" : "+s"(cw_), "+s"(cb_));
#pragma unroll
          for (int k = 0; k < 31; ++k) w[k] = cw_[k * 512 + tid];
          const float cbias = cb_[tid];
          float av[RR];
#pragma unroll
          for (int r = 0; r < RR; ++r) av[r] = as[r * 512 + tid];
#pragma unroll
          for (int t = 0; t < TT; ++t) { float acc = cbias;
#pragma unroll
              for (int k = 0; k < 31; ++k) acc += w[k] * av[t + k];
              o[t] = acc; } }
        __syncthreads();
#pragma unroll
        for (int t = 0; t < TT; ++t) os[t * 512 + tid] = o[t];
        __syncthreads();
        { const float* lg_ = lg; const float* lb_ = lb; asm volatile("" : "+s"(lg_), "+s"(lb_));
          const f32x4 g0 = *(const f32x4*)(lg_ + 8 * lane), g1 = *(const f32x4*)(lg_ + 8 * lane + 4), b0 = *(const f32x4*)(lb_ + 8 * lane), b1 = *(const f32x4*)(lb_ + 8 * lane + 4);
#pragma unroll
          for (int i = 0; i < TT / 8; ++i) { const int t = (TT / 8) * wid + i;
              const f32x4 v0 = *(const LAS f32x4*)(os + t * 512 + 8 * lane), v1 = *(const LAS f32x4*)(os + t * 512 + 8 * lane + 4);
              const float mean = wave_sum(((v0[0] + v0[1]) + (v0[2] + v0[3])) + ((v1[0] + v1[1]) + (v1[2] + v1[3]))) * (1.0f / 512.0f);
              const f32x4 d0 = v0 - mean, d1 = v1 - mean;
              const float var = wave_sum(((d0[0] * d0[0] + d0[1] * d0[1]) + (d0[2] * d0[2] + d0[3] * d0[3])) + ((d1[0] * d1[0] + d1[1] * d1[1]) + (d1[2] * d1[2] + d1[3] * d1[3]))) * (1.0f / 512.0f);
              const float rstd = rsqrtf(var + LN_EPS);
              f32x4 y0 = d0 * rstd * g0 + b0, y1 = d1 * rstd * g1 + b1;
#pragma unroll
              for (int j = 0; j < 4; ++j) { y0[j] = y0[j] * sigm(y0[j]); y1[j] = y1[j] * sigm(y1[j]); }
              *(u32x4*)(Mo + (size_t)(t0 + t) * D + 8 * lane) = pack8(y0, y1); } }
        { const int cc = tid & 63, rgp = tid >> 6, sb = s0 + 4 * rgp;
          u32x4 hh[6], gc[6], gb[4];
#pragma unroll
          for (int r = 0; r < 6; ++r) { const int sq = sb - 1 + r; const bool ok = (sq >= 0) && (sq < SEQ); const bf16_t* p = zb + (size_t)(ok ? sq : s0) * DZ0 + cc * 8;
              hh[r] = *(const u32x4*)(p + 1024); gc[r] = *(const u32x4*)(p + 2048); if (!ok) hh[r] = (u32x4){0u, 0u, 0u, 0u};
              if (r >= 1 && r <= 4) gb[r - 1] = *(const u32x4*)(p + 1536); }
          const float* bw_ = bw; const float* bb_ = bb; asm volatile("" : "+s"(bw_), "+s"(bb_));
          const f32x4 w0a = *(const f32x4*)(bw_ + cc * 8), w0b = *(const f32x4*)(bw_ + cc * 8 + 4), w1a = *(const f32x4*)(bw_ + 512 + cc * 8), w1b = *(const f32x4*)(bw_ + 512 + cc * 8 + 4),
                      w2a = *(const f32x4*)(bw_ + 1024 + cc * 8), w2b = *(const f32x4*)(bw_ + 1024 + cc * 8 + 4), bba = *(const f32x4*)(bb_ + cc * 8), bbb = *(const f32x4*)(bb_ + cc * 8 + 4);
          __builtin_amdgcn_sched_barrier(0);
          float x[6][8];
#pragma unroll
          for (int r = 0; r < 6; ++r) { float hv[8], gv[8]; unpack8(hh[r], hv); unpack8(gc[r], gv);
#pragma unroll
              for (int j = 0; j < 8; ++j) x[r][j] = hv[j] * gv[j]; }
#pragma unroll
          for (int t = 0; t < 4; ++t) { float gbv[8]; unpack8(gb[t], gbv); f32x4 y0, y1;
#pragma unroll
              for (int j = 0; j < 4; ++j) { y0[j] = gbv[j] * (w0a[j] * x[t][j] + w1a[j] * x[t + 1][j] + w2a[j] * x[t + 2][j] + bba[j]);
                  y1[j] = gbv[4 + j] * (w0b[j] * x[t][4 + j] + w1b[j] * x[t + 1][4 + j] + w2b[j] * x[t + 2][4 + j] + bbb[j]); }
              *(u32x4*)(Mo + (size_t)(t0 + 4 * rgp + t) * D + 512 + cc * 8) = pack8(y0, y1); } }
    }
}

__device__ __forceinline__ void sgu_phase(LAS unsigned char* lds, const bf16_t* Z1, const float* vst, const bf16_t* Wsb, const float* bs, const float* lg, const float* lb, bf16_t* Y, int G, int c) {
    constexpr int RS = 272;
    int tid_ = threadIdx.x; asm volatile("" : "+v"(tid_)); asm volatile("" : "+s"(c), "+s"(G));
    const int tid = tid_, lane = tid & 63, wid = tid >> 6, fr = lane & 15, fq = lane >> 4;
    LAS unsigned char* Wl = lds; LAS unsigned char* Vl = lds + 128 * RS;
    for (int u = c; u < 1024; u += G) {
        const int n = u >> 3, g = u & 7, t0 = n * 128, cg0 = g * 128;
        const int q = tid & 127, qc = tid >> 7;
        u32x4 wt[4], vr[4]; f32x4 sp[8];
#pragma unroll
        for (int i = 0; i < 4; ++i) { const int idx = tid + 512 * i, p = idx >> 4, chn = idx & 15; wt[i] = *(const u32x4*)(Wsb + ((size_t)g * 128 + p) * 128 + chn * 8); }
#pragma unroll
        for (int i = 0; i < 4; ++i) vr[i] = *(const u32x4*)(Z1 + (size_t)(t0 + q) * DZ1 + 1024 + cg0 + qc * 32 + i * 8);
#pragma unroll
        for (int j = 0; j < 8; ++j) sp[j] = *(const f32x4*)(vst + (size_t)(t0 + q) * 32 + 4 * j);
        const int pr = 16 * wid + fr, row = t0 + pr;
        u32x2 uu[8];
#pragma unroll
        for (int cb = 0; cb < 8; ++cb) uu[cb] = *(const u32x2*)(Z1 + (size_t)row * DZ1 + cg0 + 16 * cb + 4 * fq);
        const float bias = bs[g * 128 + pr];
        __builtin_amdgcn_sched_barrier(0);
        __syncthreads();
#pragma unroll
        for (int i = 0; i < 4; ++i) { const int idx = tid + 512 * i, p = idx >> 4, chn = idx & 15; *(LAS u32x4*)(Wl + p * RS + chn * 16) = wt[i]; }
        { float s1 = 0.f, s2 = 0.f;
#pragma unroll
          for (int j = 0; j < 8; ++j) { s1 += sp[j][0] + sp[j][2]; s2 += sp[j][1] + sp[j][3]; }
          const float mean = s1 * (1.0f / 1024.0f), var = s2 * (1.0f / 1024.0f) - mean * mean, rstd = rsqrtf(var + LN_EPS);
#pragma unroll
          for (int i = 0; i < 4; ++i) { const int c0 = qc * 32 + i * 8; float v[8]; unpack8(vr[i], v);
              const f32x4 g0 = *(const f32x4*)(lg + cg0 + c0), g1 = *(const f32x4*)(lg + cg0 + c0 + 4), b0 = *(const f32x4*)(lb + cg0 + c0), b1 = *(const f32x4*)(lb + cg0 + c0 + 4);
#pragma unroll
              for (int j = 0; j < 8; ++j) { const float gg = j < 4 ? g0[j & 3] : g1[j & 3], bbv = j < 4 ? b0[j & 3] : b1[j & 3];
                  *(LAS bf16_t*)(Vl + (c0 + j) * RS + q * 2) = f2bf((v[j] - mean) * rstd * gg + bbv); } } }
        __syncthreads();
        bf16x8 wf[4];
#pragma unroll
        for (int ks = 0; ks < 4; ++ks) wf[ks] = *(const LAS bf16x8*)(Wl + (16 * wid + fr) * RS + (32 * ks + 8 * fq) * 2);
        f32x4 acc[8];
#pragma unroll
        for (int cb = 0; cb < 8; ++cb) { acc[cb] = (f32x4){0.f, 0.f, 0.f, 0.f};
#pragma unroll
            for (int ks = 0; ks < 4; ++ks) { const bf16x8 vf = *(const LAS bf16x8*)(Vl + (16 * cb + fr) * RS + (32 * ks + 8 * fq) * 2);
                acc[cb] = __builtin_amdgcn_mfma_f32_16x16x32_bf16(vf, wf[ks], acc[cb], 0, 0, 0); } }
#pragma unroll
        for (int cb = 0; cb < 8; ++cb) { const int cc = cg0 + 16 * cb + 4 * fq;
            u32x2 o; o.x = cvt_pk_bf16(bflo(uu[cb].x) * (acc[cb][0] + bias), bfhi(uu[cb].x) * (acc[cb][1] + bias)); o.y = cvt_pk_bf16(bflo(uu[cb].y) * (acc[cb][2] + bias), bfhi(uu[cb].y) * (acc[cb][3] + bias));
            *(u32x2*)(Y + (size_t)row * D + cc) = o; }
    }
}

__device__ __forceinline__ void attn_phase(LAS unsigned char* lds, const bf16_t* Q, const bf16_t* Kb, const bf16_t* Vt, bf16_t* O, int G, int c) {
    constexpr int RS = 528;
    int tid_ = threadIdx.x; asm volatile("" : "+v"(tid_)); asm volatile("" : "+s"(c), "+s"(G));
    const int tid = tid_, lane = tid & 63, wid = tid >> 6, fr = lane & 15, fq = lane >> 4;
    for (int u = c; u < 512; u += G) {
        const int qb = u >> 2, h = u & 3, b = qb >> 6, q0 = qb * 128;
        const bf16_t* qrow = Q + (size_t)(q0 + 16 * wid + fr) * D + h * 256 + 8 * fq;
        bf16x8 qf[8];
#pragma unroll
        for (int ks = 0; ks < 8; ++ks) qf[ks] = *(const bf16x8*)(qrow + 32 * ks);
        __syncthreads();
        { u32x4 tv[16];
#pragma unroll
          for (int i = 0; i < 16; ++i) { const int idx = tid + 512 * i, key = idx >> 5, ch = idx & 31; tv[i] = *(const u32x4*)(Kb + (size_t)(b * 256 + key) * D + h * 256 + ch * 8); }
          __builtin_amdgcn_sched_barrier(0);
#pragma unroll
          for (int i = 0; i < 16; ++i) { const int idx = tid + 512 * i, key = idx >> 5, ch = idx & 31; *(LAS u32x4*)(lds + key * RS + ch * 16) = tv[i]; } }
        __syncthreads();
        f32x4 S[16];
#pragma unroll
        for (int kb = 0; kb < 16; ++kb) { S[kb] = (f32x4){0.f, 0.f, 0.f, 0.f};
#pragma unroll
            for (int ks = 0; ks < 8; ++ks) { const bf16x8 kf = *(const LAS bf16x8*)(lds + (16 * kb + fr) * RS + (32 * ks + 8 * fq) * 2);
                S[kb] = __builtin_amdgcn_mfma_f32_16x16x32_bf16(kf, qf[ks], S[kb], 0, 0, 0); } }
        float mx = -3.0e38f;
#pragma unroll
        for (int kb = 0; kb < 16; ++kb) mx = fmaxf(mx, fmaxf(fmaxf(S[kb][0], S[kb][1]), fmaxf(S[kb][2], S[kb][3])));
        mx = fmaxf(mx, __shfl_xor(mx, 16)); mx = fmaxf(mx, __shfl_xor(mx, 32));
        float l = 0.f;
#pragma unroll
        for (int kb = 0; kb < 16; ++kb)
#pragma unroll
            for (int j = 0; j < 4; ++j) { const float p = __builtin_amdgcn_exp2f(S[kb][j] - mx); S[kb][j] = p; l += p; }
        l += __shfl_xor(l, 16); l += __shfl_xor(l, 32);
        bf16x8 pf[8];
#pragma unroll
        for (int cc = 0; cc < 8; ++cc) { const u32x4 w = pack8(S[2 * cc], S[2 * cc + 1]); pf[cc] = __builtin_bit_cast(bf16x8, w); }
        __syncthreads();
        { u32x4 tv[16];
#pragma unroll
          for (int i = 0; i < 16; ++i) { const int idx = tid + 512 * i, d = idx >> 5, ch = idx & 31; tv[i] = *(const u32x4*)(Vt + ((size_t)b * D + h * 256 + d) * NMEM + ch * 8); }
          __builtin_amdgcn_sched_barrier(0);
#pragma unroll
          for (int i = 0; i < 16; ++i) { const int idx = tid + 512 * i, d = idx >> 5, ch = idx & 31; *(LAS u32x4*)(lds + d * RS + ch * 16) = tv[i]; } }
        __syncthreads();
        const float inv = 1.0f / l;
        bf16_t* orow = O + (size_t)(q0 + 16 * wid + fr) * D + h * 256 + 4 * fq;
#pragma unroll
        for (int db = 0; db < 16; ++db) { f32x4 oa = (f32x4){0.f, 0.f, 0.f, 0.f};
#pragma unroll
            for (int cc = 0; cc < 8; ++cc) { const bf16x8 vf = *(const LAS bf16x8*)(lds + (16 * db + fr) * RS + (32 * cc + 8 * fq) * 2);
                oa = __builtin_amdgcn_mfma_f32_16x16x32_bf16(vf, pf[cc], oa, 0, 0, 0); }
            u32x2 o; o.x = cvt_pk_bf16(oa[0] * inv, oa[1] * inv); o.y = cvt_pk_bf16(oa[2] * inv, oa[3] * inv);
            *(u32x2*)(orow + 16 * db) = o; }
    }
}

#ifndef REP_P0
#define REP_P0 1
#endif
#ifndef REP_CONV
#define REP_CONV 1
#endif
#ifndef REP_SGU
#define REP_SGU 1
#endif
#ifndef REP_ATTN
#define REP_ATTN 1
#endif
#ifndef LSTART
#define LSTART 0
#endif
#ifndef LEND
#define LEND 2
#endif
__global__ void __launch_bounds__(NTHR, 2) fwd_kernel(Args a) {
    extern __shared__ __attribute__((aligned(16))) unsigned char lds_raw[];
    LAS unsigned char* lds = (LAS unsigned char*)lds_raw;
    volatile LAS unsigned* MISC = (volatile LAS unsigned*)(lds + MISC_OFF);
    const int tid = threadIdx.x, lane = tid & 63, wave = __builtin_amdgcn_readfirstlane(tid >> 6);
    const int G = gridDim.x, bx = blockIdx.x, vcu = (G % 8 == 0) ? (bx % 8) * (G / 8) + bx / 8 : bx;
    unsigned char* ws = a.ws;
    if (tid < 32) MISC[tid] = 0u;
    __syncthreads();
    XcdBarrier bar = xcd_barrier_post((unsigned*)(ws + WS_CTL), MISC + 8);
    const int gw = vcu * NWAVES + wave, NGW = G * NWAVES;
    float* out = a.out; float* ssq = (float*)(ws + WS_SSQ); float* vst = (float*)(ws + WS_VST);
    bf16_t* HB = (bf16_t*)(ws + WS_HB); bf16_t* MB = (bf16_t*)(ws + WS_MB); bf16_t* BIG = (bf16_t*)(ws + WS_BIG);
    bf16_t* MEMN = (bf16_t*)(ws + WS_MEMN); bf16_t* KB = (bf16_t*)(ws + WS_KB); bf16_t* VT = (bf16_t*)(ws + WS_VT);
#define GRID_BAR() xcd_barrier(bar)
#ifdef NO_GEMM
#define GEMM(EpiT, E, Ap, Bp, M_, N_, K_, cc) do {} while (0)
#else
#define GEMM(EpiT, E, Ap, Bp, M_, N_, K_, cc) do { Gemm g{(const bf16_t*)(Ap), (const bf16_t*)(Bp), (M_), (N_), (K_)}; int cc_ = (cc); asm volatile("" : "+s"(cc_)); StaticOrder S; S.init((M_), (N_), G, cc_); gemm_phase<EpiT, StaticOrder, true, true>(lds, g, S, (E)); } while (0)
#endif

    _Pragma("unroll 1") for (int rep = 0; rep < REP_P0; ++rep) { if (rep) GRID_BAR(); p0_prologue(a, lds, gw, NGW, wave, lane); }
    if (a.ws == nullptr) cg::this_grid().sync();
    GRID_BAR();

#pragma unroll
    for (int l = LSTART; l < LEND; ++l) {
        unsigned char* wl = ws + WS_W + (size_t)l * W_LAYER;
        if (l == 0) {
            { EpiScale E{BIG, DZ0, ssq}; GEMM(EpiScale, E, HB, wl + W_IN, T, DZ0, D, bx); }
#pragma unroll 1
            for (int l2 = 0; l2 < 2; ++l2) { EpiKV E{KB + (size_t)l2 * 512 * D, VT + (size_t)l2 * 2 * D * NMEM};
                const int c2 = (G - 1 - bx + (l2 ? G - 16 : 0)) % G;
                GEMM(EpiKV, E, MEMN + (size_t)l2 * 512 * D, ws + WS_W + (size_t)l2 * W_LAYER + W_KV, 512, 2 * D, D, c2); }
            GRID_BAR();
            _Pragma("unroll 1") for (int rep = 0; rep < REP_CONV; ++rep) { if (rep) GRID_BAR();
            conv_phase(lds, BIG, MB, a.in[8], a.in[9], a.in[10], a.in[11], a.in[12], a.in[13], G, bx); }
            GRID_BAR();
            { EpiRes E{HB, ssq}; GEMM(EpiRes, E, MB, wl + W_OUT, T, D, D, bx); }
        } else {
            { EpiZ1 E{BIG, ssq, vst}; GEMM(EpiZ1, E, HB, wl + W_IN, T, DZ1, D, bx); }
            GRID_BAR();
            _Pragma("unroll 1") for (int rep = 0; rep < REP_SGU; ++rep) { if (rep) GRID_BAR(); sgu_phase(lds, BIG, vst, (const bf16_t*)(ws + WS_WSB), a.in[19], a.in[16], a.in[17], MB, G, bx); }
            GRID_BAR();
            { EpiRes E{HB, ssq}; GEMM(EpiRes, E, MB, wl + W_OUT, T, D, D, bx); }
        }
        GRID_BAR();
        { EpiScale E{BIG, D, ssq}; GEMM(EpiScale, E, HB, wl + W_Q, T, D, D, bx); }
        GRID_BAR();
        _Pragma("unroll 1") for (int rep = 0; rep < REP_ATTN; ++rep) { if (rep) GRID_BAR(); attn_phase(lds, BIG, KB + (size_t)l * 512 * D, VT + (size_t)l * 2 * D * NMEM, MB, G, bx); }
        GRID_BAR();
        { EpiRes E{HB, ssq}; GEMM(EpiRes, E, MB, wl + W_O, T, D, D, bx); }
        GRID_BAR();
        { EpiGU E{BIG, ssq}; GEMM(EpiGU, E, HB, wl + W_GU, T, NGU, D, bx); }
        GRID_BAR();
        { EpiRes E{HB, ssq}; GEMM(EpiRes, E, BIG, wl + W_DN, T, D, DFF, bx); }
        GRID_BAR();
    }
    { int t2 = threadIdx.x; asm volatile("" : "+v"(t2)); const int lane = t2 & 63, gw = vcu * NWAVES + __builtin_amdgcn_readfirstlane(t2 >> 6);
      const f32x4 g0 = *(const f32x4*)(a.in[6] + 8 * lane), g1 = *(const f32x4*)(a.in[6] + 8 * lane + 4), g2 = *(const f32x4*)(a.in[6] + 512 + 8 * lane), g3 = *(const f32x4*)(a.in[6] + 512 + 8 * lane + 4);
      for (int m0 = gw * 4; m0 < T; m0 += NGW * 4) {
          u32x4 r0[4], r1[4];
#pragma unroll
          for (int r = 0; r < 4; ++r) { const bf16_t* p = HB + (size_t)(m0 + r) * D + 8 * lane; r0[r] = *(const u32x4*)p; r1[r] = *(const u32x4*)(p + 512); }
          __builtin_amdgcn_sched_barrier(0);
#pragma unroll
          for (int r = 0; r < 4; ++r) { float v[8], w[8]; unpack8(r0[r], v); unpack8(r1[r], w); float sq = 0.f;
#pragma unroll
              for (int j = 0; j < 8; ++j) sq += v[j] * v[j] + w[j] * w[j];
              const float rs = rsqrtf(wave_sum(sq) * (1.0f / 1024.0f) + RMS_EPS);
              float* o = out + (size_t)(m0 + r) * D + 8 * lane;
              *(f32x4*)o = (f32x4){v[0], v[1], v[2], v[3]} * rs * g0; *(f32x4*)(o + 4) = (f32x4){v[4], v[5], v[6], v[7]} * rs * g1;
              *(f32x4*)(o + 512) = (f32x4){w[0], w[1], w[2], w[3]} * rs * g2; *(f32x4*)(o + 516) = (f32x4){w[4], w[5], w[6], w[7]} * rs * g3; } } }
}

extern "C" void kernel_launch(void* const* d_in, const int* in_sizes, int n_in, void* d_out, int out_size, void* d_ws, size_t ws_size, hipStream_t stream) {
    static int grid = 0;
    if (grid == 0) {
        if (n_in != 28 || out_size != T * D || ws_size < WS_END) { fprintf(stderr, "kernel_launch: unexpected shapes (n_in %d out %d ws %zu)\n", n_in, out_size, ws_size); grid = -1; return; }
        int dev = 0, cus = 0, per_cu = 0;
        (void)hipGetDevice(&dev); (void)hipDeviceGetAttribute(&cus, hipDeviceAttributeMultiprocessorCount, dev);
        (void)hipFuncSetAttribute((const void*)fwd_kernel, hipFuncAttributeMaxDynamicSharedMemorySize, LDS_BYTES);
        (void)hipOccupancyMaxActiveBlocksPerMultiprocessor(&per_cu, (const void*)fwd_kernel, NTHR, LDS_BYTES);
        if (per_cu < 1) per_cu = 1;
        (void)hipGetLastError();
        grid = cus;
        if (grid % 8 != 0 || grid < 64) fprintf(stderr, "kernel_launch: unusual CU count %d\n", grid);
    }
    if (grid < 0) return;
    (void)hipMemsetAsync((char*)d_ws + WS_CTL, 0, CTL_ZERO_BYTES, stream);
    Args a{};
    for (int i = 0; i < 28; ++i) a.in[i] = (const float*)d_in[i];
    a.out = (float*)d_out; a.ws = (unsigned char*)d_ws;
    void* args[] = {&a};
    hipError_t e = hipLaunchCooperativeKernel((const void*)fwd_kernel, dim3(grid), dim3(NTHR), args, LDS_BYTES, stream);
    if (e != hipSuccess) fprintf(stderr, "cooperative launch failed: %s (grid %d)\n", hipGetErrorString(e), grid);
}
```

```cpp
#include <hip/hip_runtime.h>
#include <hip/hip_cooperative_groups.h>
#include <cstdio>
#include <cstdint>
namespace cg = cooperative_groups;
namespace pg8 {
#define PG8_LAS __attribute__((address_space(3)))
typedef unsigned short bf16_t;
typedef short bf16x8 __attribute__((ext_vector_type(8)));
typedef float f32x4 __attribute__((ext_vector_type(4)));
typedef unsigned u32x4 __attribute__((ext_vector_type(4)));
constexpr int BM = 256, BK = 64, HALF = 128, HTB = HALF * BK * 2  , STAGE_BYTES = 8 * HTB, NXCD = 8, WGM = 8;

__host__ __device__ __forceinline__ int lds_byte(int r, int c) { const int st = (r >> 4) * 2 + (c >> 5), rr = r & 15, cc = c & 31, ob = rr * 64 + cc * 2; return st * 1024 + (ob ^ (((ob >> 9) & 1) << 5)); }
__host__ __device__ __forceinline__ void stage_rc(int b, int& R, int& C) { const int st = b / 1024, sb = b % 1024, swz = sb ^ (((sb >> 9) & 1) << 5); R = (st >> 1) * 16 + swz / 64; C = (st & 1) * 32 + (swz % 64) / 2; }
__host__ __device__ __forceinline__ int perm32(int rho) { const int n = rho >> 4, i = rho & 15; return 8 * (i >> 2) + 4 * n + (i & 3); }

struct Unit { int pm, pn; };
struct Gemm { const bf16_t* A; const bf16_t* Bt; int M, N, K; };

struct StaticOrder {
    int nM, nN, nwg, G, c;
    __host__ __device__ void init(int M, int N, int G_, int c_) { nM = M / BM; nN = N / BM; nwg = nM * nN; G = G_; c = c_; }
    __host__ __device__ bool next(int i, Unit& u) const {
        const long L = (long)i * G + c; if (L >= nwg) return false;
        int wgid = (int)L; { const int q = nwg / NXCD, r = nwg % NXCD, xcd = wgid % NXCD, off = wgid / NXCD; wgid = (xcd < r ? xcd * (q + 1) : r * (q + 1) + (xcd - r) * q) + off; }
        const int nig = WGM * nN, gid = wgid / nig, fm = gid * WGM, gsz = (nM - fm) < WGM ? (nM - fm) : WGM;
        u.pm = fm + ((wgid % nig) % gsz); u.pn = (wgid % nig) / gsz; return true;
    }
    __device__ __forceinline__ void a_ready(const Unit&) const {}
    __device__ __forceinline__ void done(const Unit&) const {}
};

__device__ __forceinline__ unsigned cvt_pk_bf16(float lo, float hi) { unsigned r; asm volatile("v_cvt_pk_bf16_f32 %0, %1, %2" : "=v"(r) : "v"(lo), "v"(hi)); return r; }
typedef float f32x2 __attribute__((ext_vector_type(2)));
template <class Epi, class Sched, bool ALIGN_EPI = false, bool SP2 = false>
__device__ __forceinline__ void gemm_phase(PG8_LAS unsigned char* lds, const Gemm g, const Sched& S, const Epi& E, int tid_in) {
    int tid_ = tid_in; asm volatile("" : "+v"(tid_));
    const int tid = tid_, wid = __builtin_amdgcn_readfirstlane(tid >> 6), lane = tid & 63, wr = wid >> 2, wc = wid & 3, fr = lane & 15, fq = lane >> 4;
    const int K = g.K, nt = K / BK;
    unsigned voffA[2], voffB[2];
#pragma unroll
    for (int i = 0; i < 2; ++i) { int R, C; stage_rc(tid * 16 + i * 8192, R, C); const int Rb = Epi::PERM ? ((R & ~31) + perm32(R & 31)) : R;
        voffA[i] = (unsigned)(R * K + C) * 2u; voffB[i] = (unsigned)(Rb * K + C) * 2u; }
    const size_t kstep = (size_t)(BK * 2);
    const size_t hstep = (size_t)HALF * K * 2;
    const size_t tstep = 2 * hstep;
    const unsigned ldsw = (unsigned)wid * 1024u;
    const int aoff = lds_byte(wr * 64 + fr, fq * 8), boff = lds_byte(wc * 32 + fr, fq * 8);
#define PG8_SA(b, h) (((b) * 2 + (h)) * HTB)
#define PG8_SB(b, h) ((4 + (b) * 2 + (h)) * HTB)
#define PG8_STAGE(bufoff, gbase, voff) do { _Pragma("unroll") for (int _i = 0; _i < 2; ++_i) \
        __builtin_amdgcn_global_load_lds((const unsigned*)((const char*)(gbase) + (voff)[_i]), (PG8_LAS unsigned*)(lds + (bufoff) + ldsw + _i * 8192), 16, 0, 0); } while (0)
#define PG8_LDA(dst, b, h) do { _Pragma("unroll") for (int m = 0; m < 4; ++m) _Pragma("unroll") for (int k = 0; k < 2; ++k) dst[m][k] = *(const PG8_LAS bf16x8*)(lds + PG8_SA(b, h) + aoff + m * 2048 + k * 1024); } while (0)
#define PG8_LDB(dst, b, h) do { _Pragma("unroll") for (int n = 0; n < 2; ++n) _Pragma("unroll") for (int k = 0; k < 2; ++k) dst[n][k] = *(const PG8_LAS bf16x8*)(lds + PG8_SB(b, h) + boff + n * 2048 + k * 1024); } while (0)
#define PG8_MMA(ai, bj, At, Bt) do { __builtin_amdgcn_s_setprio(1); _Pragma("unroll") for (int m = 0; m < 4; ++m) _Pragma("unroll") for (int n = 0; n < 2; ++n) _Pragma("unroll") for (int k = 0; k < 2; ++k) \
        acc[ai][bj][m][n] = __builtin_amdgcn_mfma_f32_16x16x32_bf16(Bt[n][k], At[m][k], acc[ai][bj][m][n], 0, 0, 0); __builtin_amdgcn_s_setprio(0); } while (0)
#define PG8_WAIT_V(n) asm volatile("s_waitcnt vmcnt(" #n ")" ::: "memory")
#define PG8_WAIT_L(n) asm volatile("s_waitcnt lgkmcnt(" #n ")" ::: "memory")
#define PG8_BAR __builtin_amdgcn_s_barrier()
#define PG8_SCHED __builtin_amdgcn_sched_barrier(0)
    Unit cur, nxt; int ui = 0;
    if (!S.next(0, cur)) return;
    f32x4 acc[2][2][4][2];
#pragma unroll
    for (int a = 0; a < 2; ++a)
#pragma unroll
        for (int b = 0; b < 2; ++b)
#pragma unroll
            for (int m = 0; m < 4; ++m)
#pragma unroll
                for (int n = 0; n < 2; ++n) acc[a][b][m][n] = (f32x4){0.f, 0.f, 0.f, 0.f};
    bf16x8 At[4][2], B0[2][2], B1[2][2];
    const char* cA = (const char*)g.A + (size_t)cur.pm * tstep; const char* cB = (const char*)g.Bt + (size_t)cur.pn * tstep;
    S.a_ready(cur);
    if constexpr (SP2) {
        PG8_STAGE(PG8_SB(0, 0), cB, voffB); PG8_STAGE(PG8_SB(0, 1), cB + hstep, voffB); PG8_STAGE(PG8_SA(0, 0), cA, voffA); PG8_STAGE(PG8_SA(0, 1), cA + hstep, voffA);
        if (wr == 1) PG8_BAR;
        PG8_WAIT_V(2); PG8_BAR;
        PG8_STAGE(PG8_SB(1, 0), cB + kstep, voffB); PG8_STAGE(PG8_SA(1, 0), cA + kstep, voffA); PG8_STAGE(PG8_SB(1, 1), cB + hstep + kstep, voffB);
        PG8_WAIT_V(6); PG8_BAR;
    } else {
        PG8_STAGE(PG8_SB(0, 0), cB, voffB); PG8_STAGE(PG8_SA(0, 0), cA, voffA); PG8_STAGE(PG8_SB(0, 1), cB + hstep, voffB); PG8_STAGE(PG8_SA(0, 1), cA + hstep, voffA);
        if (wr == 1) PG8_BAR;
        PG8_WAIT_V(4); PG8_BAR;
        PG8_STAGE(PG8_SB(1, 0), cB + kstep, voffB); PG8_STAGE(PG8_SA(1, 0), cA + kstep, voffA); PG8_STAGE(PG8_SB(1, 1), cB + hstep + kstep, voffB);
        PG8_WAIT_V(6); PG8_BAR;
    }
    for (;;) {
        const bool has_next = S.next(ui + 1, nxt);
        const char* nA = has_next ? (const char*)g.A + (size_t)nxt.pm * tstep : cA; const char* nB = has_next ? (const char*)g.Bt + (size_t)nxt.pn * tstep : cB;
        for (int t = 0; t < nt; t += 2) {
            const bool last = (t == nt - 2);
            const char* a1 = cA + (size_t)(t + 1) * kstep;
            const char* a2 = last ? nA : cA + (size_t)(t + 2) * kstep; const char* b2 = last ? nB : cB + (size_t)(t + 2) * kstep;
            const char* a3 = a2 + kstep; const char* b3 = b2 + kstep;
            if (last && has_next) S.a_ready(nxt);
            if constexpr (SP2) {
            PG8_LDB(B0, 0, 0); PG8_LDB(B1, 0, 1); PG8_SCHED; PG8_LDA(At, 0, 0); PG8_STAGE(PG8_SA(1, 1), a1 + hstep, voffA);
            PG8_WAIT_V(8); PG8_WAIT_L(0); PG8_BAR; PG8_MMA(0, 0, At, B0); PG8_MMA(0, 1, At, B1); PG8_BAR; PG8_SCHED;
            PG8_LDA(At, 0, 1); PG8_STAGE(PG8_SB(0, 0), b2, voffB); PG8_STAGE(PG8_SB(0, 1), b2 + hstep, voffB); PG8_STAGE(PG8_SA(0, 0), a2, voffA);
            PG8_WAIT_V(8); PG8_WAIT_L(0); PG8_BAR; PG8_MMA(1, 0, At, B0); PG8_MMA(1, 1, At, B1); PG8_BAR; PG8_SCHED;
            PG8_LDB(B0, 1, 0); PG8_LDB(B1, 1, 1); PG8_SCHED; PG8_LDA(At, 1, 0); PG8_STAGE(PG8_SA(0, 1), a2 + hstep, voffA);
            PG8_WAIT_V(8); PG8_WAIT_L(0); PG8_BAR; PG8_MMA(0, 0, At, B0); PG8_MMA(0, 1, At, B1); PG8_BAR; PG8_SCHED;
            PG8_LDA(At, 1, 1); PG8_STAGE(PG8_SB(1, 0), b3, voffB); PG8_STAGE(PG8_SB(1, 1), b3 + hstep, voffB); PG8_STAGE(PG8_SA(1, 0), a3, voffA);
            PG8_WAIT_V(8); PG8_WAIT_L(0); PG8_BAR; PG8_MMA(1, 0, At, B0); PG8_MMA(1, 1, At, B1); PG8_BAR; PG8_SCHED;
            } else {
            PG8_LDB(B0, 0, 0); PG8_SCHED; PG8_LDA(At, 0, 0); PG8_STAGE(PG8_SA(1, 1), a1 + hstep, voffA);
            PG8_WAIT_L(8); PG8_BAR; PG8_WAIT_L(0); PG8_MMA(0, 0, At, B0); PG8_BAR; PG8_SCHED;
            PG8_LDB(B1, 0, 1); PG8_STAGE(PG8_SB(0, 0), b2, voffB);
            PG8_BAR; PG8_WAIT_L(0); PG8_MMA(0, 1, At, B1); PG8_BAR;
            PG8_LDA(At, 0, 1); PG8_STAGE(PG8_SA(0, 0), a2, voffA);
            PG8_BAR; PG8_WAIT_L(0); PG8_MMA(1, 0, At, B0); PG8_BAR; PG8_SCHED;
            PG8_STAGE(PG8_SB(0, 1), b2 + hstep, voffB);
            PG8_WAIT_V(6); PG8_BAR; PG8_MMA(1, 1, At, B1); PG8_BAR;
            PG8_LDB(B0, 1, 0); PG8_SCHED; PG8_LDA(At, 1, 0); PG8_STAGE(PG8_SA(0, 1), a2 + hstep, voffA);
            PG8_WAIT_L(8); PG8_BAR; PG8_WAIT_L(0); PG8_MMA(0, 0, At, B0); PG8_BAR; PG8_SCHED;
            PG8_LDB(B1, 1, 1); PG8_STAGE(PG8_SB(1, 0), b3, voffB);
            PG8_BAR; PG8_WAIT_L(0); PG8_MMA(0, 1, At, B1); PG8_BAR;
            PG8_LDA(At, 1, 1); PG8_STAGE(PG8_SA(1, 0), a3, voffA);
            PG8_BAR; PG8_WAIT_L(0); PG8_MMA(1, 0, At, B0); PG8_BAR; PG8_SCHED;
            PG8_STAGE(PG8_SB(1, 1), b3 + hstep, voffB);
            PG8_WAIT_V(6); PG8_BAR; PG8_MMA(1, 1, At, B1); PG8_BAR;
            }
        }
        if constexpr (ALIGN_EPI) { if (wr == 0) PG8_BAR; }
        if constexpr (!Epi::AFTER_DRAIN) { E(acc, cur, wr, wc, fr, fq); S.done(cur); }
        if (!has_next) break;
#pragma unroll
        for (int a = 0; a < 2; ++a)
#pragma unroll
            for (int b = 0; b < 2; ++b)
#pragma unroll
                for (int m = 0; m < 4; ++m)
#pragma unroll
                    for (int n = 0; n < 2; ++n) acc[a][b][m][n] = (f32x4){0.f, 0.f, 0.f, 0.f};
        cur = nxt; cA = nA; cB = nB; ++ui;
        if constexpr (ALIGN_EPI) { if (wr == 1) PG8_BAR; }
    }
    PG8_WAIT_V(0);
    if constexpr (!ALIGN_EPI) { if (wr == 0) PG8_BAR; }
    PG8_BAR;
    if constexpr (Epi::AFTER_DRAIN) { E.fused(acc, cur, wr, wc, fr, fq, lds, wid, lane); S.done(cur); }
#undef PG8_SA
#undef PG8_SB
#undef PG8_STAGE
#undef PG8_LDA
#undef PG8_LDB
#undef PG8_MMA
#undef PG8_WAIT_V
#undef PG8_WAIT_L
#undef PG8_BAR
#undef PG8_SCHED
}
}
#define LAS __attribute__((address_space(3)))
#define XB_TMO      128
#define XB_XCNT(j)  (256  + 64 * (j))
#define XB_XSUB(j)  (1280 + 64 * (j))
#define XB_XGEN(j)  (2304 + 64 * (j))
#define XB_TOP      3328
#define XB_TOPGEN   3392
#define XCD_BAR_WORDS 3456
#define XB_SPIN_CAP (1u << 18)

__device__ __forceinline__ unsigned xb_ld(unsigned* p)              { return __hip_atomic_load(p, __ATOMIC_RELAXED, __HIP_MEMORY_SCOPE_AGENT); }
__device__ __forceinline__ unsigned xb_add(unsigned* p, unsigned v) { return __hip_atomic_fetch_add(p, v, __ATOMIC_RELAXED, __HIP_MEMORY_SCOPE_AGENT); }
__device__ __forceinline__ unsigned xb_xcc_id() { return (unsigned)__builtin_amdgcn_s_getreg((3 << 11) | 20) & 0xFu; }
#define XB_SPIN(cond, bar) do { unsigned _sp = 0; while (cond) { __builtin_amdgcn_s_sleep(1); \
    if ((++_sp & 255u) == 0u) { if (xb_ld(&(bar)[XB_TMO])) break; if (_sp > XB_SPIN_CAP) { atomicAdd(&(bar)[XB_TMO], 1u); break; } } } } while (0)

struct XcdBarrier {
    unsigned* bar; unsigned x;
    volatile LAS unsigned* st;
};

__device__ __forceinline__ XcdBarrier xcd_barrier_post(unsigned* bar, volatile LAS unsigned* st, int ktid) {
    XcdBarrier b; b.bar = bar; b.x = xb_xcc_id(); b.st = st;
    if (ktid == 0) (void)xb_add(&bar[XB_XCNT(b.x)], 1u);
    return b;
}
__device__ __forceinline__ void xcd_barrier_complete(unsigned* bar, unsigned x, unsigned& nloc, unsigned& nx) {
    const unsigned G = gridDim.x * gridDim.y * gridDim.z;
    unsigned sum, cnt, mine, sp = 0u;
    for (;;) {
        sum = 0u; cnt = 0u; mine = 0u;
#pragma unroll
        for (unsigned j = 0; j < 16; ++j) { const unsigned c = xb_ld(&bar[XB_XCNT(j)]); sum += c; cnt += (c > 0u) ? 1u : 0u; mine = (j == x) ? c : mine; }
        if (sum == G) break;
        __builtin_amdgcn_s_sleep(1);
        if ((++sp & 255u) == 0u) { if (xb_ld(&bar[XB_TMO])) break; if (sp > XB_SPIN_CAP) { atomicAdd(&bar[XB_TMO], 1u); break; } }
    }
    nloc = mine > 0u ? mine : 1u; nx = cnt > 0u ? cnt : 1u;
}

__device__ __forceinline__ void xcd_barrier(const XcdBarrier& b, int ktid) {
    asm volatile("s_waitcnt vmcnt(0)" ::: "memory");
    __syncthreads();
    if (ktid == 0) {
        unsigned* bar = b.bar; const unsigned bx_ = xb_xcc_id();
        __builtin_amdgcn_s_waitcnt(0);
        unsigned nloc = b.st[0], nx = b.st[1];
        if (nloc == 0u) { xcd_barrier_complete(bar, bx_, nloc, nx); b.st[0] = nloc; b.st[1] = nx; }
        const unsigned old = xb_add(&bar[XB_XSUB(bx_)], 1u);
        const unsigned gen = old / nloc;
        if (old + 1u == (gen + 1u) * nloc) {
            __builtin_amdgcn_fence(__ATOMIC_RELEASE, "agent");
            asm volatile("s_waitcnt vmcnt(0)" ::: "memory");
            const unsigned og = xb_add(&bar[XB_TOP], 1u);
            const unsigned tg = og / nx;
            if (og + 1u == (tg + 1u) * nx) xb_add(&bar[XB_TOPGEN], 1u);
            else XB_SPIN(xb_ld(&bar[XB_TOPGEN]) == tg, bar);
            __builtin_amdgcn_fence(__ATOMIC_ACQUIRE, "agent");
            xb_add(&bar[XB_XGEN(bx_)], 1u);
            asm volatile("s_waitcnt vmcnt(0)" ::: "memory");
        } else {
            XB_SPIN(xb_ld(&bar[XB_XGEN(bx_)]) == gen, bar);
            __builtin_amdgcn_fence(__ATOMIC_ACQUIRE, "agent");
            asm volatile("s_waitcnt vmcnt(0)" ::: "memory");
        }
    }
    __syncthreads();
}
#undef LAS
using namespace pg8;
#define LAS __attribute__((address_space(3)))
typedef unsigned u32x2 __attribute__((ext_vector_type(2)));

constexpr int NWAVES = 8, NTHR = 512;
constexpr int SEQ = 8192, NBATCH = 2, T = NBATCH * SEQ, D = 1024, DZ0 = 2560, DZ1 = 2048, DFF = 2816, NGU = 2 * DFF, NMEM = 256;
constexpr float RMS_EPS = 1e-6f, LN_EPS = 1e-5f;
constexpr size_t MiB = 1u << 20;
constexpr size_t WS_CTL = 0, CTL_ZERO_BYTES = 64 * 1024;
constexpr size_t WS_W = 2 * MiB, W_LAYER = 32 * MiB;
constexpr size_t W_IN = 0, W_OUT = 5 * MiB, W_Q = 7 * MiB, W_KV = 9 * MiB, W_O = 13 * MiB, W_GU = 15 * MiB, W_DN = 26 * MiB;
constexpr size_t WS_WSB = 66 * MiB;
constexpr size_t WS_SSQ = 67 * MiB;
constexpr size_t WS_VST = 68 * MiB;
constexpr size_t WS_MEMN = 70 * MiB;
constexpr size_t WS_KB = 72 * MiB;
constexpr size_t WS_VT = 74 * MiB;
constexpr size_t WS_HB = 76 * MiB;
constexpr size_t WS_MB = 108 * MiB;
constexpr size_t WS_BIG = 140 * MiB;
constexpr size_t WS_END = 228 * MiB;
constexpr int LDS_BYTES = 147456, MISC_OFF = 139264;

__device__ __forceinline__ float wave_sum(float v) {
#pragma unroll
    for (int o = 1; o < 64; o <<= 1) v += __shfl_xor(v, o);
    return v;
}
__device__ __forceinline__ float bf2f(unsigned short b) { return __uint_as_float((unsigned)b << 16); }
__device__ __forceinline__ float bflo(unsigned w) { return __uint_as_float(w << 16); }
__device__ __forceinline__ float bfhi(unsigned w) { return __uint_as_float(w & 0xffff0000u); }
__device__ __forceinline__ unsigned short f2bf(float f) { return (unsigned short)(cvt_pk_bf16(f, 0.f) & 0xffffu); }
__device__ __forceinline__ float sigm(float x) { return __builtin_amdgcn_rcpf(1.f + __builtin_amdgcn_exp2f(-1.44269504f * x)); }
__device__ __forceinline__ float gelu_tanh(float x) { const float y = 1.5957691216f * (x + 0.044715f * x * x * x); return x * sigm(y); }

__device__ __forceinline__ float row_rstd(const float* ssq, int row, int fq) {
    const f32x4 a = *(const f32x4*)(ssq + (size_t)row * 16 + 4 * fq);
    float s = (a[0] + a[1]) + (a[2] + a[3]);
    s += __shfl_xor(s, 16); s += __shfl_xor(s, 32);
    return rsqrtf(s * (1.0f / 1024.0f) + RMS_EPS);
}
__device__ __forceinline__ u32x4 pack8(const f32x4 v0, const f32x4 v1) { u32x4 w; w.x = cvt_pk_bf16(v0[0], v0[1]); w.y = cvt_pk_bf16(v0[2], v0[3]); w.z = cvt_pk_bf16(v1[0], v1[1]); w.w = cvt_pk_bf16(v1[2], v1[3]); return w; }

struct EpiScale {
    static constexpr bool PERM = true, AFTER_DRAIN = false;
    bf16_t* O; int ldc; const float* ssq;
    __device__ __forceinline__ void operator()(const f32x4 (&acc)[2][2][4][2], const Unit& u, int wr, int wc, int fr, int fq) const {
        const int row0 = u.pm * BM + wr * 64 + fr, col0 = u.pn * BM + wc * 32 + 8 * fq;
#pragma unroll
        for (int ai = 0; ai < 2; ++ai)
#pragma unroll
            for (int m = 0; m < 4; ++m) { const int row = row0 + ai * HALF + m * 16; const float rs = ssq ? row_rstd(ssq, row, fq) : 1.f; bf16_t* rowp = O + (size_t)row * ldc + col0;
#pragma unroll
                for (int bj = 0; bj < 2; ++bj) *(u32x4*)(rowp + bj * HALF) = pack8(acc[ai][bj][m][0] * rs, acc[ai][bj][m][1] * rs); }
    }
};
struct EpiRes {
    static constexpr bool PERM = true, AFTER_DRAIN = false;
    bf16_t* hb; float* ssq;
    __device__ __forceinline__ void operator()(const f32x4 (&acc)[2][2][4][2], const Unit& u, int wr, int wc, int fr, int fq) const {
        const int row0 = u.pm * BM + wr * 64 + fr, col0 = u.pn * BM + wc * 32 + 8 * fq;
#pragma unroll
        for (int ai = 0; ai < 2; ++ai)
#pragma unroll
            for (int m = 0; m < 4; ++m) { const int row = row0 + ai * HALF + m * 16; const size_t off = (size_t)row * D + col0; float q = 0.f;
#pragma unroll
                for (int bj = 0; bj < 2; ++bj) { const u32x4 bb = *(const u32x4*)(hb + off + bj * HALF);
                    const f32x4 b0 = (f32x4){bflo(bb.x), bfhi(bb.x), bflo(bb.y), bfhi(bb.y)}, b1 = (f32x4){bflo(bb.z), bfhi(bb.z), bflo(bb.w), bfhi(bb.w)};
                    const f32x4 v0 = b0 + acc[ai][bj][m][0], v1 = b1 + acc[ai][bj][m][1];
                    *(u32x4*)(hb + off + bj * HALF) = pack8(v0, v1);
                    q += ((v0[0] * v0[0] + v0[1] * v0[1]) + (v0[2] * v0[2] + v0[3] * v0[3])) + ((v1[0] * v1[0] + v1[1] * v1[1]) + (v1[2] * v1[2] + v1[3] * v1[3])); }
                q += __shfl_xor(q, 16); q += __shfl_xor(q, 32);
                if (fq == 0) ssq[(size_t)row * 16 + u.pn * 4 + wc] = q; }
    }
};
struct EpiGU {
    static constexpr bool PERM = true, AFTER_DRAIN = false;
    bf16_t* O; const float* ssq;
    __device__ __forceinline__ void operator()(const f32x4 (&acc)[2][2][4][2], const Unit& u, int wr, int wc, int fr, int fq) const {
        const int row0 = u.pm * BM + wr * 64 + fr, col0 = u.pn * HALF + wc * 32 + 8 * fq;
#pragma unroll
        for (int ai = 0; ai < 2; ++ai)
#pragma unroll
            for (int m = 0; m < 4; ++m) { const int row = row0 + ai * HALF + m * 16; const float rs = row_rstd(ssq, row, fq);
                f32x4 h[2];
#pragma unroll
                for (int n = 0; n < 2; ++n)
#pragma unroll
                    for (int j = 0; j < 4; ++j) { const float g = acc[ai][0][m][n][j] * rs, up = acc[ai][1][m][n][j] * rs; h[n][j] = g * sigm(g) * up; }
                *(u32x4*)(O + (size_t)row * DFF + col0) = pack8(h[0], h[1]); }
    }
};
struct EpiZ1 {
    static constexpr bool PERM = true, AFTER_DRAIN = false;
    bf16_t* O; const float* ssq; float* vst;
    __device__ __forceinline__ void operator()(const f32x4 (&acc)[2][2][4][2], const Unit& u, int wr, int wc, int fr, int fq) const {
        const int row0 = u.pm * BM + wr * 64 + fr, col0 = u.pn * BM + wc * 32 + 8 * fq;
#pragma unroll
        for (int ai = 0; ai < 2; ++ai)
#pragma unroll
            for (int m = 0; m < 4; ++m) { const int row = row0 + ai * HALF + m * 16; const float rs = row_rstd(ssq, row, fq); bf16_t* rowp = O + (size_t)row * DZ1 + col0; float s = 0.f, q = 0.f;
#pragma unroll
                for (int bj = 0; bj < 2; ++bj) { f32x4 v[2];
#pragma unroll
                    for (int n = 0; n < 2; ++n)
#pragma unroll
                        for (int j = 0; j < 4; ++j) { const float g = gelu_tanh(acc[ai][bj][m][n][j] * rs); v[n][j] = g; s += g; q += g * g; }
                    *(u32x4*)(rowp + bj * HALF) = pack8(v[0], v[1]); }
                if (u.pn >= 4) { s += __shfl_xor(s, 16); s += __shfl_xor(s, 32); q += __shfl_xor(q, 16); q += __shfl_xor(q, 32);
                    if (fq == 0) { float* p = vst + ((size_t)row * 16 + (u.pn - 4) * 4 + wc) * 2; p[0] = s; p[1] = q; } } }
    }
};
struct EpiKV {
    static constexpr bool PERM = true, AFTER_DRAIN = false;
    bf16_t* Kb; bf16_t* Vt;
    __device__ __forceinline__ void operator()(const f32x4 (&acc)[2][2][4][2], const Unit& u, int wr, int wc, int fr, int fq) const {
        const int col0 = (u.pn & 3) * BM + wc * 32 + 8 * fq;
#pragma unroll
        for (int ai = 0; ai < 2; ++ai)
#pragma unroll
            for (int m = 0; m < 4; ++m) { const int key = ai * HALF + wr * 64 + m * 16 + fr;
                if (u.pn < 4) { bf16_t* rowp = Kb + (size_t)(u.pm * BM + key) * D + col0;
#pragma unroll
                    for (int bj = 0; bj < 2; ++bj) *(u32x4*)(rowp + bj * HALF) = pack8(acc[ai][bj][m][0], acc[ai][bj][m][1]);
                } else { const int kp = (key & ~31) + 8 * ((key >> 2) & 3) + 4 * ((key >> 4) & 1) + (key & 3);
#pragma unroll
                    for (int bj = 0; bj < 2; ++bj)
#pragma unroll
                        for (int n = 0; n < 2; ++n)
#pragma unroll
                            for (int j = 0; j < 4; ++j) Vt[((size_t)u.pm * D + col0 + bj * HALF + 4 * n + j) * NMEM + kp] = f2bf(acc[ai][bj][m][n][j]); } }
    }
};

__device__ __forceinline__ void tr_item(const float* W, int K, int N, bf16_t* WT, const float* g, float cs, int mode, LAS float* scr, int item, int lane) {
    const int nblk = N / 64, kb = item / nblk, nb = item % nblk, k0 = 64 * kb, n0 = 64 * nb;
    const int orow = mode == 0 ? n0 : ((n0 >> 7) * 256 + (n0 & 127) + (mode == 2 ? 128 : 0));
    const int kq = lane >> 4, n4 = (lane & 15) * 4;
    f32x4 v[16]; float sc[16];
#pragma unroll
    for (int i = 0; i < 16; ++i) { const int kk = 4 * i + kq; v[i] = *(const f32x4*)(W + (size_t)(k0 + kk) * N + n0 + n4); sc[i] = g ? g[k0 + kk] * cs : cs; }
    __builtin_amdgcn_sched_barrier(0);
#pragma unroll
    for (int i = 0; i < 16; ++i) { const int kk = 4 * i + kq; LAS float* d = scr + kk * 65 + n4; d[0] = v[i][0] * sc[i]; d[1] = v[i][1] * sc[i]; d[2] = v[i][2] * sc[i]; d[3] = v[i][3] * sc[i]; }
    asm volatile("s_waitcnt lgkmcnt(0)" ::: "memory");
    const int c = lane & 7;
#pragma unroll
    for (int j = 0; j < 8; ++j) { const int n = (lane >> 3) + 8 * j; const LAS float* p = scr + (8 * c) * 65 + n;
        u32x4 o; o.x = cvt_pk_bf16(p[0 * 65], p[1 * 65]); o.y = cvt_pk_bf16(p[2 * 65], p[3 * 65]); o.z = cvt_pk_bf16(p[4 * 65], p[5 * 65]); o.w = cvt_pk_bf16(p[6 * 65], p[7 * 65]);
        *(u32x4*)(WT + (size_t)(orow + n) * K + k0 + 8 * c) = o; }
    asm volatile("s_waitcnt lgkmcnt(0)" ::: "memory");
}

struct Args { const float* in[28]; float* out; unsigned char* ws; };

__device__ __forceinline__ void p0_prologue(const Args& a, LAS unsigned char* lds, int gw, int NGW, int wave, int lane) {
    unsigned char* ws = a.ws;
    LAS float* scr = (LAS float*)(lds + wave * 16640);
    const float QS = 0.0625f * 1.44269504f;
    constexpr int I_IN0 = 16 * (DZ0 / 64), I_IN1 = 16 * (DZ1 / 64), I_SQ = 16 * 16, I_GU = 16 * (DFF / 64), I_DN = (DFF / 64) * 16;
    constexpr int NITEMS = I_IN0 + I_IN1 + 2 * 5 * I_SQ + 2 * 2 * I_GU + 2 * I_DN;
    for (int it = gw; it < NITEMS; it += NGW) {
        int r = it; bool found = false; const float* W = nullptr; int K = 0, N = 0, mode = 0; bf16_t* WT = nullptr; const float* gv = nullptr; float cs = 1.f;
#define SEL(NI, Wp, K_, N_, WTp, g_, cs_, mode_) if (!found) { if (r < (NI)) { W = (Wp); K = (K_); N = (N_); WT = (bf16_t*)(WTp); gv = (g_); cs = (cs_); mode = (mode_); found = true; } else r -= (NI); }
        SEL(I_IN0, a.in[7], D, DZ0, ws + WS_W + W_IN, a.in[2], 1.f, 0)
        SEL(I_IN1, a.in[15], D, DZ1, ws + WS_W + W_LAYER + W_IN, a.in[2] + D, 1.f, 0)
        SEL(I_SQ, a.in[14], D, D, ws + WS_W + W_OUT, nullptr, 1.f, 0)
        SEL(I_SQ, a.in[20], D, D, ws + WS_W + W_LAYER + W_OUT, nullptr, 1.f, 0)
#pragma unroll
        for (int l = 0; l < 2; ++l) {
            unsigned char* wl = ws + WS_W + l * W_LAYER;
            SEL(I_SQ, a.in[21] + (size_t)l * D * D, D, D, wl + W_Q, a.in[3] + l * D, QS, 0)
            SEL(I_SQ, a.in[22] + (size_t)l * D * D, D, D, wl + W_KV, nullptr, 1.f, 0)
            SEL(I_SQ, a.in[23] + (size_t)l * D * D, D, D, wl + W_KV + (size_t)D * D * 2, nullptr, 1.f, 0)
            SEL(I_SQ, a.in[24] + (size_t)l * D * D, D, D, wl + W_O, nullptr, 1.f, 0)
            SEL(I_GU, a.in[25] + (size_t)l * D * DFF, D, DFF, wl + W_GU, a.in[5] + l * D, 1.f, 1)
            SEL(I_GU, a.in[26] + (size_t)l * D * DFF, D, DFF, wl + W_GU, a.in[5] + l * D, 1.f, 2)
            SEL(I_DN, a.in[27] + (size_t)l * D * DFF, DFF, D, wl + W_DN, nullptr, 1.f, 0)
        }
#undef SEL
        tr_item(W, K, N, WT, gv, cs, mode, scr, r, lane);
    }
    { const f32x4* src = (const f32x4*)a.in[18]; u32x2* dst = (u32x2*)(ws + WS_WSB);
      for (int i = gw * 64 + lane; i < 8 * 128 * 128 / 4; i += NGW * 64) { const f32x4 v = src[i]; u32x2 o; o.x = cvt_pk_bf16(v[0], v[1]); o.y = cvt_pk_bf16(v[2], v[3]); dst[i] = o; } }
    { float* ssq = (float*)(ws + WS_SSQ); bf16_t* HB = (bf16_t*)(ws + WS_HB);
      for (int m0 = gw * 4; m0 < T; m0 += NGW * 4) {
          f32x4 v[4][4];
#pragma unroll
          for (int r = 0; r < 4; ++r) { const f32x4* xr = (const f32x4*)(a.in[0] + (size_t)(m0 + r) * D) + lane;
#pragma unroll
              for (int j = 0; j < 4; ++j) v[r][j] = xr[64 * j]; }
          __builtin_amdgcn_sched_barrier(0);
#pragma unroll
          for (int r = 0; r < 4; ++r) { float s = 0.f;
#pragma unroll
              for (int j = 0; j < 4; ++j) s += (v[r][j][0] * v[r][j][0] + v[r][j][1] * v[r][j][1]) + (v[r][j][2] * v[r][j][2] + v[r][j][3] * v[r][j][3]);
              s = wave_sum(s);
              u32x2* o = (u32x2*)(HB + (size_t)(m0 + r) * D) + lane;
#pragma unroll
              for (int j = 0; j < 4; ++j) { u32x2 w; w.x = cvt_pk_bf16(v[r][j][0], v[r][j][1]); w.y = cvt_pk_bf16(v[r][j][2], v[r][j][3]); o[64 * j] = w; }
              if (lane < 16) ssq[(size_t)(m0 + r) * 16 + lane] = lane == 0 ? s : 0.f; }
      } }
    { bf16_t* MN = (bf16_t*)(ws + WS_MEMN);
      for (int m = gw; m < 2 * 512; m += NGW) { const int l = m >> 9, row = m & 511;
          const f32x4* xr = (const f32x4*)(a.in[1] + (size_t)row * D) + lane; const f32x4* gr = (const f32x4*)(a.in[4] + l * D) + lane; f32x4 v[4]; float s = 0.f;
#pragma unroll
          for (int j = 0; j < 4; ++j) { v[j] = xr[64 * j]; s += (v[j][0] * v[j][0] + v[j][1] * v[j][1]) + (v[j][2] * v[j][2] + v[j][3] * v[j][3]); }
          const float rs = rsqrtf(wave_sum(s) * (1.0f / 1024.0f) + RMS_EPS);
          u32x2* o = (u32x2*)(MN + ((size_t)l * 512 + row) * D) + lane;
#pragma unroll
          for (int j = 0; j < 4; ++j) { const f32x4 g = gr[64 * j]; u32x2 w; w.x = cvt_pk_bf16(v[j][0] * rs * g[0], v[j][1] * rs * g[1]); w.y = cvt_pk_bf16(v[j][2] * rs * g[2], v[j][3] * rs * g[3]); o[64 * j] = w; }
      } }
}

__device__ __forceinline__ void unpack8(const u32x4 r, float (&v)[8]) { v[0] = bflo(r.x); v[1] = bfhi(r.x); v[2] = bflo(r.y); v[3] = bfhi(r.y); v[4] = bflo(r.z); v[5] = bfhi(r.z); v[6] = bflo(r.w); v[7] = bfhi(r.w); }
__device__ __forceinline__ void conv_phase(LAS unsigned char* lds, const bf16_t* Z, bf16_t* Mo, const float* cw, const float* cb, const float* lg, const float* lb,
                                           const float* bw, const float* bb, int G, int c, int tid_in) {
    constexpr int TT = 32, RR = TT + 30;
    int tid_ = tid_in; asm volatile("" : "+v"(tid_)); asm volatile("" : "+s"(c), "+s"(G));
    const int tid = tid_, lane = tid & 63, wid = tid >> 6;
    LAS float* as = (LAS float*)lds;
    LAS float* os = (LAS float*)lds;
    for (int u = c; u < T / TT; u += G) {
        const int t0 = u * TT, b = t0 / SEQ, s0 = t0 % SEQ;
        const bf16_t* zb = Z + (size_t)b * SEQ * DZ0;
        __syncthreads();
        { u32x4 rv[8], rg[8];
#pragma unroll
          for (int i = 0; i < 8; ++i) { const int idx = tid + 512 * i, r = idx >> 6, cc = idx & 63, sq = s0 - 15 + r; const bool ok = (idx < RR * 64) && (sq >= 0) && (sq < SEQ);
              const bf16_t* p = zb + (size_t)(ok ? sq : s0) * DZ0 + cc * 8; rv[i] = *(const u32x4*)p; rg[i] = *(const u32x4*)(p + 512);
              if (!ok) rv[i] = (u32x4){0u, 0u, 0u, 0u}; }
          __builtin_amdgcn_sched_barrier(0);
#pragma unroll
          for (int i = 0; i < 8; ++i) { const int idx = tid + 512 * i, r = idx >> 6, cc = idx & 63; float v[8], gt[8]; unpack8(rv[i], v); unpack8(rg[i], gt);
              f32x4 a0, a1;
#pragma unroll
              for (int j = 0; j < 4; ++j) { a0[j] = v[j] * sigm(gt[j]); a1[j] = v[4 + j] * sigm(gt[4 + j]); }
              if (idx < RR * 64) { *(LAS f32x4*)(as + r * 512 + cc * 8) = a0; *(LAS f32x4*)(as + r * 512 + cc * 8 + 4) = a1; } } }
        __syncthreads();
        float o[TT];
        { float w[31]; const float* cw_ = cw; const float* cb_ = cb; asm volatile("" : "+s"(cw_), "+s"(cb_));
#pragma unroll
          for (int k = 0; k < 31; ++k) w[k] = cw_[k * 512 + tid];
          const float cbias = cb_[tid];
          float av[RR];
#pragma unroll
          for (int r = 0; r < RR; ++r) av[r] = as[r * 512 + tid];
#pragma unroll
          for (int t = 0; t < TT; ++t) { float acc = cbias;
#pragma unroll
              for (int k = 0; k < 31; ++k) acc += w[k] * av[t + k];
              o[t] = acc; } }
        __syncthreads();
#pragma unroll
        for (int t = 0; t < TT; ++t) os[t * 512 + tid] = o[t];
        __syncthreads();
        { const float* lg_ = lg; const float* lb_ = lb; asm volatile("" : "+s"(lg_), "+s"(lb_));
          const f32x4 g0 = *(const f32x4*)(lg_ + 8 * lane), g1 = *(const f32x4*)(lg_ + 8 * lane + 4), b0 = *(const f32x4*)(lb_ + 8 * lane), b1 = *(const f32x4*)(lb_ + 8 * lane + 4);
#pragma unroll
          for (int i = 0; i < TT / 8; ++i) { const int t = (TT / 8) * wid + i;
              const f32x4 v0 = *(const LAS f32x4*)(os + t * 512 + 8 * lane), v1 = *(const LAS f32x4*)(os + t * 512 + 8 * lane + 4);
              const float mean = wave_sum(((v0[0] + v0[1]) + (v0[2] + v0[3])) + ((v1[0] + v1[1]) + (v1[2] + v1[3]))) * (1.0f / 512.0f);
              const f32x4 d0 = v0 - mean, d1 = v1 - mean;
              const float var = wave_sum(((d0[0] * d0[0] + d0[1] * d0[1]) + (d0[2] * d0[2] + d0[3] * d0[3])) + ((d1[0] * d1[0] + d1[1] * d1[1]) + (d1[2] * d1[2] + d1[3] * d1[3]))) * (1.0f / 512.0f);
              const float rstd = rsqrtf(var + LN_EPS);
              f32x4 y0 = d0 * rstd * g0 + b0, y1 = d1 * rstd * g1 + b1;
#pragma unroll
              for (int j = 0; j < 4; ++j) { y0[j] = y0[j] * sigm(y0[j]); y1[j] = y1[j] * sigm(y1[j]); }
              *(u32x4*)(Mo + (size_t)(t0 + t) * D + 8 * lane) = pack8(y0, y1); } }
        { const int cc = tid & 63, rgp = tid >> 6, sb = s0 + 4 * rgp;
          u32x4 hh[6], gc[6], gb[4];
#pragma unroll
          for (int r = 0; r < 6; ++r) { const int sq = sb - 1 + r; const bool ok = (sq >= 0) && (sq < SEQ); const bf16_t* p = zb + (size_t)(ok ? sq : s0) * DZ0 + cc * 8;
              hh[r] = *(const u32x4*)(p + 1024); gc[r] = *(const u32x4*)(p + 2048); if (!ok) hh[r] = (u32x4){0u, 0u, 0u, 0u};
              if (r >= 1 && r <= 4) gb[r - 1] = *(const u32x4*)(p + 1536); }
          const float* bw_ = bw; const float* bb_ = bb; asm volatile("" : "+s"(bw_), "+s"(bb_));
          const f32x4 w0a = *(const f32x4*)(bw_ + cc * 8), w0b = *(const f32x4*)(bw_ + cc * 8 + 4), w1a = *(const f32x4*)(bw_ + 512 + cc * 8), w1b = *(const f32x4*)(bw_ + 512 + cc * 8 + 4),
                      w2a = *(const f32x4*)(bw_ + 1024 + cc * 8), w2b = *(const f32x4*)(bw_ + 1024 + cc * 8 + 4), bba = *(const f32x4*)(bb_ + cc * 8), bbb = *(const f32x4*)(bb_ + cc * 8 + 4);
          __builtin_amdgcn_sched_barrier(0);
          float x[6][8];
#pragma unroll
          for (int r = 0; r < 6; ++r) { float hv[8], gv[8]; unpack8(hh[r], hv); unpack8(gc[r], gv);
#pragma unroll
              for (int j = 0; j < 8; ++j) x[r][j] = hv[j] * gv[j]; }
#pragma unroll
          for (int t = 0; t < 4; ++t) { float gbv[8]; unpack8(gb[t], gbv); f32x4 y0, y1;
#pragma unroll
              for (int j = 0; j < 4; ++j) { y0[j] = gbv[j] * (w0a[j] * x[t][j] + w1a[j] * x[t + 1][j] + w2a[j] * x[t + 2][j] + bba[j]);
                  y1[j] = gbv[4 + j] * (w0b[j] * x[t][4 + j] + w1b[j] * x[t + 1][4 + j] + w2b[j] * x[t + 2][4 + j] + bbb[j]); }
              *(u32x4*)(Mo + (size_t)(t0 + 4 * rgp + t) * D + 512 + cc * 8) = pack8(y0, y1); } }
    }
}

__device__ __forceinline__ void sgu_phase(LAS unsigned char* lds, const bf16_t* Z1, const float* vst, const bf16_t* Wsb, const float* bs, const float* lg, const float* lb, bf16_t* Y, int G, int c, int tid_in) {
    constexpr int RS = 272;
    int tid_ = tid_in; asm volatile("" : "+v"(tid_)); asm volatile("" : "+s"(c), "+s"(G));
    const int tid = tid_, lane = tid & 63, wid = tid >> 6, fr = lane & 15, fq = lane >> 4;
    LAS unsigned char* Wl = lds; LAS unsigned char* Vl = lds + 128 * RS;
    for (int u = c; u < 1024; u += G) {
        const int n = u >> 3, g = u & 7, t0 = n * 128, cg0 = g * 128;
        const int q = tid & 127, qc = tid >> 7;
        u32x4 wt[4], vr[4]; f32x4 sp[8];
#pragma unroll
        for (int i = 0; i < 4; ++i) { const int idx = tid + 512 * i, p = idx >> 4, chn = idx & 15; wt[i] = *(const u32x4*)(Wsb + ((size_t)g * 128 + p) * 128 + chn * 8); }
#pragma unroll
        for (int i = 0; i < 4; ++i) vr[i] = *(const u32x4*)(Z1 + (size_t)(t0 + q) * DZ1 + 1024 + cg0 + qc * 32 + i * 8);
#pragma unroll
        for (int j = 0; j < 8; ++j) sp[j] = *(const f32x4*)(vst + (size_t)(t0 + q) * 32 + 4 * j);
        const int pr = 16 * wid + fr, row = t0 + pr;
        u32x2 uu[8];
#pragma unroll
        for (int cb = 0; cb < 8; ++cb) uu[cb] = *(const u32x2*)(Z1 + (size_t)row * DZ1 + cg0 + 16 * cb + 4 * fq);
        const float bias = bs[g * 128 + pr];
        __builtin_amdgcn_sched_barrier(0);
        __syncthreads();
#pragma unroll
        for (int i = 0; i < 4; ++i) { const int idx = tid + 512 * i, p = idx >> 4, chn = idx & 15; *(LAS u32x4*)(Wl + p * RS + chn * 16) = wt[i]; }
        { float s1 = 0.f, s2 = 0.f;
#pragma unroll
          for (int j = 0; j < 8; ++j) { s1 += sp[j][0] + sp[j][2]; s2 += sp[j][1] + sp[j][3]; }
          const float mean = s1 * (1.0f / 1024.0f), var = s2 * (1.0f / 1024.0f) - mean * mean, rstd = rsqrtf(var + LN_EPS);
#pragma unroll
          for (int i = 0; i < 4; ++i) { const int c0 = qc * 32 + i * 8; float v[8]; unpack8(vr[i], v);
              const f32x4 g0 = *(const f32x4*)(lg + cg0 + c0), g1 = *(const f32x4*)(lg + cg0 + c0 + 4), b0 = *(const f32x4*)(lb + cg0 + c0), b1 = *(const f32x4*)(lb + cg0 + c0 + 4);
#pragma unroll
              for (int j = 0; j < 8; ++j) { const float gg = j < 4 ? g0[j & 3] : g1[j & 3], bbv = j < 4 ? b0[j & 3] : b1[j & 3];
                  *(LAS bf16_t*)(Vl + (c0 + j) * RS + q * 2) = f2bf((v[j] - mean) * rstd * gg + bbv); } } }
        __syncthreads();
        bf16x8 wf[4];
#pragma unroll
        for (int ks = 0; ks < 4; ++ks) wf[ks] = *(const LAS bf16x8*)(Wl + (16 * wid + fr) * RS + (32 * ks + 8 * fq) * 2);
        f32x4 acc[8];
#pragma unroll
        for (int cb = 0; cb < 8; ++cb) { acc[cb] = (f32x4){0.f, 0.f, 0.f, 0.f};
#pragma unroll
            for (int ks = 0; ks < 4; ++ks) { const bf16x8 vf = *(const LAS bf16x8*)(Vl + (16 * cb + fr) * RS + (32 * ks + 8 * fq) * 2);
                acc[cb] = __builtin_amdgcn_mfma_f32_16x16x32_bf16(vf, wf[ks], acc[cb], 0, 0, 0); } }
#pragma unroll
        for (int cb = 0; cb < 8; ++cb) { const int cc = cg0 + 16 * cb + 4 * fq;
            u32x2 o; o.x = cvt_pk_bf16(bflo(uu[cb].x) * (acc[cb][0] + bias), bfhi(uu[cb].x) * (acc[cb][1] + bias)); o.y = cvt_pk_bf16(bflo(uu[cb].y) * (acc[cb][2] + bias), bfhi(uu[cb].y) * (acc[cb][3] + bias));
            *(u32x2*)(Y + (size_t)row * D + cc) = o; }
    }
}

__device__ __forceinline__ void attn_phase(LAS unsigned char* lds, const bf16_t* Q, const bf16_t* Kb, const bf16_t* Vt, bf16_t* O, int G, int c, int tid_in) {
    constexpr int RS = 528;
    int tid_ = tid_in; asm volatile("" : "+v"(tid_)); asm volatile("" : "+s"(c), "+s"(G));
    const int tid = tid_, lane = tid & 63, wid = tid >> 6, fr = lane & 15, fq = lane >> 4;
    for (int u = c; u < 512; u += G) {
        const int qb = u >> 2, h = u & 3, b = qb >> 6, q0 = qb * 128;
        const bf16_t* qrow = Q + (size_t)(q0 + 16 * wid + fr) * D + h * 256 + 8 * fq;
        bf16x8 qf[8];
#pragma unroll
        for (int ks = 0; ks < 8; ++ks) qf[ks] = *(const bf16x8*)(qrow + 32 * ks);
        __syncthreads();
        { u32x4 tv[16];
#pragma unroll
          for (int i = 0; i < 16; ++i) { const int idx = tid + 512 * i, key = idx >> 5, ch = idx & 31; tv[i] = *(const u32x4*)(Kb + (size_t)(b * 256 + key) * D + h * 256 + ch * 8); }
          __builtin_amdgcn_sched_barrier(0);
#pragma unroll
          for (int i = 0; i < 16; ++i) { const int idx = tid + 512 * i, key = idx >> 5, ch = idx & 31; *(LAS u32x4*)(lds + key * RS + ch * 16) = tv[i]; } }
        __syncthreads();
        f32x4 S[16];
#pragma unroll
        for (int kb = 0; kb < 16; ++kb) { S[kb] = (f32x4){0.f, 0.f, 0.f, 0.f};
#pragma unroll
            for (int ks = 0; ks < 8; ++ks) { const bf16x8 kf = *(const LAS bf16x8*)(lds + (16 * kb + fr) * RS + (32 * ks + 8 * fq) * 2);
                S[kb] = __builtin_amdgcn_mfma_f32_16x16x32_bf16(kf, qf[ks], S[kb], 0, 0, 0); } }
        float mx = -3.0e38f;
#pragma unroll
        for (int kb = 0; kb < 16; ++kb) mx = fmaxf(mx, fmaxf(fmaxf(S[kb][0], S[kb][1]), fmaxf(S[kb][2], S[kb][3])));
        mx = fmaxf(mx, __shfl_xor(mx, 16)); mx = fmaxf(mx, __shfl_xor(mx, 32));
        float l = 0.f;
#pragma unroll
        for (int kb = 0; kb < 16; ++kb)
#pragma unroll
            for (int j = 0; j < 4; ++j) { const float p = __builtin_amdgcn_exp2f(S[kb][j] - mx); S[kb][j] = p; l += p; }
        l += __shfl_xor(l, 16); l += __shfl_xor(l, 32);
        bf16x8 pf[8];
#pragma unroll
        for (int cc = 0; cc < 8; ++cc) { const u32x4 w = pack8(S[2 * cc], S[2 * cc + 1]); pf[cc] = __builtin_bit_cast(bf16x8, w); }
        __syncthreads();
        { u32x4 tv[16];
#pragma unroll
          for (int i = 0; i < 16; ++i) { const int idx = tid + 512 * i, d = idx >> 5, ch = idx & 31; tv[i] = *(const u32x4*)(Vt + ((size_t)b * D + h * 256 + d) * NMEM + ch * 8); }
          __builtin_amdgcn_sched_barrier(0);
#pragma unroll
          for (int i = 0; i < 16; ++i) { const int idx = tid + 512 * i, d = idx >> 5, ch = idx & 31; *(LAS u32x4*)(lds + d * RS + ch * 16) = tv[i]; } }
        __syncthreads();
        const float inv = 1.0f / l;
        bf16_t* orow = O + (size_t)(q0 + 16 * wid + fr) * D + h * 256 + 4 * fq;
#pragma unroll
        for (int db = 0; db < 16; ++db) { f32x4 oa = (f32x4){0.f, 0.f, 0.f, 0.f};
#pragma unroll
            for (int cc = 0; cc < 8; ++cc) { const bf16x8 vf = *(const LAS bf16x8*)(lds + (16 * db + fr) * RS + (32 * cc + 8 * fq) * 2);
                oa = __builtin_amdgcn_mfma_f32_16x16x32_bf16(vf, pf[cc], oa, 0, 0, 0); }
            u32x2 o; o.x = cvt_pk_bf16(oa[0] * inv, oa[1] * inv); o.y = cvt_pk_bf16(oa[2] * inv, oa[3] * inv);
            *(u32x2*)(orow + 16 * db) = o; }
    }
}

struct EpiQAttn {
    static constexpr bool PERM = true, AFTER_DRAIN = true;
    const float* ssq; const bf16_t* Kb; const bf16_t* Vt; bf16_t* O;
    __device__ __forceinline__ void operator()(const f32x4 (&)[2][2][4][2], const Unit&, int, int, int, int) const {}
    __device__ __forceinline__ void fused(f32x4 (&acc)[2][2][4][2], const Unit& u, int wr, int wc, int fr, int fq, PG8_LAS unsigned char* lds, int wid, int lane) const {
        constexpr int RS = 528;
        const int tid = wid * 64 + lane, h = u.pn, b = u.pm >> 5;
        const unsigned r0 = (unsigned)tid >> 5, ch = (unsigned)tid & 31u;
        const bf16_t* kbase = Kb + (size_t)(b * 256) * D + h * 256; const bf16_t* vbase = Vt + ((size_t)b * D + h * 256) * NMEM;
        const unsigned goffk = r0 * (unsigned)(D * 2) + ch * 16u, goffv = r0 * (unsigned)(NMEM * 2) + ch * 16u, loff = r0 * (unsigned)RS + ch * 16u;
        unsigned loffa = loff, loffb = loff + 7 * 16 * RS; asm volatile("" : "+v"(loffa), "+v"(loffb));
#pragma unroll
        for (int ai = 0; ai < 2; ++ai)
#pragma unroll
            for (int m = 0; m < 4; ++m) { const int lr = ai * HALF + wr * 64 + m * 16 + fr; const float rs = row_rstd(ssq, u.pm * BM + lr, fq);
#pragma unroll
                for (int bj = 0; bj < 2; ++bj) *(PG8_LAS u32x4*)(lds + lr * RS + (bj * HALF + wc * 32 + 8 * fq) * 2) = pack8(acc[ai][bj][m][0] * rs, acc[ai][bj][m][1] * rs); }
        __syncthreads();
        bf16x8 qf[2][8];
#pragma unroll
        for (int qb = 0; qb < 2; ++qb)
#pragma unroll
            for (int ks = 0; ks < 8; ++ks) qf[qb][ks] = *(const PG8_LAS bf16x8*)(lds + (32 * wid + 16 * qb + fr) * RS + (32 * ks + 8 * fq) * 2);
        __builtin_amdgcn_sched_barrier(0);
        u32x4 tv[16];
#pragma unroll
        for (int i = 0; i < 16; ++i) tv[i] = *(const u32x4*)((const char*)kbase + (goffk + (unsigned)(i * 16 * D * 2)));
        __builtin_amdgcn_sched_barrier(0);
        __syncthreads();
#pragma unroll
        for (int i = 0; i < 16; ++i) *(PG8_LAS u32x4*)(lds + (i < 7 ? loffa : loffb) + (i < 7 ? i : i - 7) * 16 * RS) = tv[i];
        __syncthreads();
        unsigned fb0 = (unsigned)(fr * RS + fq * 16), fb1 = fb0 + 8 * 16 * RS; asm volatile("" : "+v"(fb0), "+v"(fb1));
        f32x4 S[2][16];
#pragma unroll
        for (int kb = 0; kb < 16; ++kb) { S[0][kb] = (f32x4){0.f, 0.f, 0.f, 0.f}; S[1][kb] = (f32x4){0.f, 0.f, 0.f, 0.f};
#pragma unroll
            for (int ks = 0; ks < 8; ++ks) { const bf16x8 kf = *(const PG8_LAS bf16x8*)(lds + (kb < 8 ? fb0 : fb1) + ((kb & 7) * 16 * RS + ks * 64));
                S[0][kb] = __builtin_amdgcn_mfma_f32_16x16x32_bf16(kf, qf[0][ks], S[0][kb], 0, 0, 0);
                S[1][kb] = __builtin_amdgcn_mfma_f32_16x16x32_bf16(kf, qf[1][ks], S[1][kb], 0, 0, 0); } }
        __builtin_amdgcn_sched_barrier(0);
        bf16x8 pf[2][8]; float inv[2];
#pragma unroll
        for (int qb = 0; qb < 2; ++qb) {
            float mx = -3.0e38f;
#pragma unroll
            for (int kb = 0; kb < 16; ++kb) mx = fmaxf(mx, fmaxf(fmaxf(S[qb][kb][0], S[qb][kb][1]), fmaxf(S[qb][kb][2], S[qb][kb][3])));
            mx = fmaxf(mx, __shfl_xor(mx, 16)); mx = fmaxf(mx, __shfl_xor(mx, 32));
            float l = 0.f;
#pragma unroll
            for (int kb = 0; kb < 16; ++kb)
#pragma unroll
                for (int j = 0; j < 4; ++j) { const float p = __builtin_amdgcn_exp2f(S[qb][kb][j] - mx); S[qb][kb][j] = p; l += p; }
            l += __shfl_xor(l, 16); l += __shfl_xor(l, 32); inv[qb] = 1.0f / l;
#pragma unroll
            for (int cc = 0; cc < 8; ++cc) { const u32x4 w = pack8(S[qb][2 * cc], S[qb][2 * cc + 1]); pf[qb][cc] = __builtin_bit_cast(bf16x8, w); }
        }
        __builtin_amdgcn_sched_barrier(0);
        unsigned loff2a = loff, loff2b = loff + 7 * 16 * RS; asm volatile("" : "+v"(loff2a), "+v"(loff2b));
#pragma unroll
        for (int i = 0; i < 16; ++i) tv[i] = *(const u32x4*)((const char*)vbase + (goffv + (unsigned)(i * 16 * NMEM * 2)));
        __builtin_amdgcn_sched_barrier(0);
        __syncthreads();
#pragma unroll
        for (int i = 0; i < 16; ++i) *(PG8_LAS u32x4*)(lds + (i < 7 ? loff2a : loff2b) + (i < 7 ? i : i - 7) * 16 * RS) = tv[i];
        __syncthreads();
        unsigned vb0 = (unsigned)(fr * RS + fq * 16), vb1 = vb0 + 8 * 16 * RS; asm volatile("" : "+v"(vb0), "+v"(vb1));
        bf16_t* orow = O + (size_t)(u.pm * BM + 32 * wid + fr) * D + h * 256 + 4 * fq;
#pragma unroll
        for (int db = 0; db < 16; ++db) { f32x4 o0 = (f32x4){0.f, 0.f, 0.f, 0.f}, o1 = (f32x4){0.f, 0.f, 0.f, 0.f};
#pragma unroll
            for (int cc = 0; cc < 8; ++cc) { const bf16x8 vf = *(const PG8_LAS bf16x8*)(lds + (db < 8 ? vb0 : vb1) + ((db & 7) * 16 * RS + cc * 64));
                o0 = __builtin_amdgcn_mfma_f32_16x16x32_bf16(vf, pf[0][cc], o0, 0, 0, 0); o1 = __builtin_amdgcn_mfma_f32_16x16x32_bf16(vf, pf[1][cc], o1, 0, 0, 0); }
            u32x2 w0, w1; w0.x = cvt_pk_bf16(o0[0] * inv[0], o0[1] * inv[0]); w0.y = cvt_pk_bf16(o0[2] * inv[0], o0[3] * inv[0]);
            w1.x = cvt_pk_bf16(o1[0] * inv[1], o1[1] * inv[1]); w1.y = cvt_pk_bf16(o1[2] * inv[1], o1[3] * inv[1]);
            *(u32x2*)(orow + 16 * db) = w0; *(u32x2*)(orow + (size_t)16 * D + 16 * db) = w1; }
        __syncthreads();
    }
};

__device__ __forceinline__ int lane_id_volatile() { int l; asm volatile("v_mbcnt_lo_u32_b32 %0, -1, 0\n\tv_mbcnt_hi_u32_b32 %0, -1, %0" : "=v"(l)); return l; }
#ifndef REP_P0
#define REP_P0 1
#endif
#ifndef REP_CONV
#define REP_CONV 1
#endif
#ifndef REP_SGU
#define REP_SGU 1
#endif
#ifndef REP_ATTN
#define REP_ATTN 1
#endif
#ifndef LSTART
#define LSTART 0
#endif
#ifndef LEND
#define LEND 2
#endif
__global__ void __launch_bounds__(NTHR, 2) fwd_kernel(Args a) {
    extern __shared__ __attribute__((aligned(16))) unsigned char lds_raw[];
    LAS unsigned char* lds = (LAS unsigned char*)lds_raw;
    volatile LAS unsigned* MISC = (volatile LAS unsigned*)(lds + MISC_OFF);
    const int wave = __builtin_amdgcn_readfirstlane((int)threadIdx.x >> 6);
#define TID() (wave * 64 + lane_id_volatile())
    const int tid = TID(), lane = tid & 63;
    const int G = gridDim.x, bx = blockIdx.x, vcu = (G % 8 == 0) ? (bx % 8) * (G / 8) + bx / 8 : bx;
    unsigned char* ws = a.ws;
    if (tid < 32) MISC[tid] = 0u;
    __syncthreads();
    XcdBarrier bar = xcd_barrier_post((unsigned*)(ws + WS_CTL), MISC + 8, tid);
    const int gw = vcu * NWAVES + wave, NGW = G * NWAVES;
    float* out = a.out; float* ssq = (float*)(ws + WS_SSQ); float* vst = (float*)(ws + WS_VST);
    bf16_t* HB = (bf16_t*)(ws + WS_HB); bf16_t* MB = (bf16_t*)(ws + WS_MB); bf16_t* BIG = (bf16_t*)(ws + WS_BIG);
    bf16_t* MEMN = (bf16_t*)(ws + WS_MEMN); bf16_t* KB = (bf16_t*)(ws + WS_KB); bf16_t* VT = (bf16_t*)(ws + WS_VT);
#define GRID_BAR() xcd_barrier(bar, TID())
#ifdef NO_GEMM
#define GEMM(EpiT, E, Ap, Bp, M_, N_, K_, cc) do {} while (0)
#else
#define GEMM(EpiT, E, Ap, Bp, M_, N_, K_, cc) do { Gemm g{(const bf16_t*)(Ap), (const bf16_t*)(Bp), (M_), (N_), (K_)}; int cc_ = (cc); asm volatile("" : "+s"(cc_)); StaticOrder S; S.init((M_), (N_), G, cc_); gemm_phase<EpiT, StaticOrder, true, true>(lds, g, S, (E), TID()); } while (0)
#endif

    _Pragma("unroll 1") for (int rep = 0; rep < REP_P0; ++rep) { if (rep) GRID_BAR(); p0_prologue(a, lds, gw, NGW, wave, lane); }
    if (a.ws == nullptr) cg::this_grid().sync();
    GRID_BAR();

#pragma unroll
    for (int l = LSTART; l < LEND; ++l) {
        unsigned char* wl = ws + WS_W + (size_t)l * W_LAYER;
        if (l == 0) {
            { EpiScale E{BIG, DZ0, ssq}; GEMM(EpiScale, E, HB, wl + W_IN, T, DZ0, D, bx); }
#pragma unroll 1
            for (int l2 = 0; l2 < 2; ++l2) { EpiKV E{KB + (size_t)l2 * 512 * D, VT + (size_t)l2 * 2 * D * NMEM};
                const int c2 = (G - 1 - bx + (l2 ? G - 16 : 0)) % G;
                GEMM(EpiKV, E, MEMN + (size_t)l2 * 512 * D, ws + WS_W + (size_t)l2 * W_LAYER + W_KV, 512, 2 * D, D, c2); }
            GRID_BAR();
            _Pragma("unroll 1") for (int rep = 0; rep < REP_CONV; ++rep) { if (rep) GRID_BAR();
            conv_phase(lds, BIG, MB, a.in[8], a.in[9], a.in[10], a.in[11], a.in[12], a.in[13], G, bx, TID()); }
            GRID_BAR();
            { EpiRes E{HB, ssq}; GEMM(EpiRes, E, MB, wl + W_OUT, T, D, D, bx); }
        } else {
            { EpiZ1 E{BIG, ssq, vst}; GEMM(EpiZ1, E, HB, wl + W_IN, T, DZ1, D, bx); }
            GRID_BAR();
            _Pragma("unroll 1") for (int rep = 0; rep < REP_SGU; ++rep) { if (rep) GRID_BAR(); sgu_phase(lds, BIG, vst, (const bf16_t*)(ws + WS_WSB), a.in[19], a.in[16], a.in[17], MB, G, bx, TID()); }
            GRID_BAR();
            { EpiRes E{HB, ssq}; GEMM(EpiRes, E, MB, wl + W_OUT, T, D, D, bx); }
        }
        GRID_BAR();
        if (G == 256) {
            EpiQAttn E{ssq, KB + (size_t)l * 512 * D, VT + (size_t)l * 2 * D * NMEM, MB};
            Gemm g{HB, (const bf16_t*)(wl + W_Q), T, D, D}; int cc_ = bx; asm volatile("" : "+s"(cc_)); StaticOrder S; S.init(T, D, G, cc_); gemm_phase<EpiQAttn, StaticOrder, false, true>(lds, g, S, E, TID());
        } else {
        { EpiScale E{BIG, D, ssq}; GEMM(EpiScale, E, HB, wl + W_Q, T, D, D, bx); }
        GRID_BAR();
        _Pragma("unroll 1") for (int rep = 0; rep < REP_ATTN; ++rep) { if (rep) GRID_BAR(); attn_phase(lds, BIG, KB + (size_t)l * 512 * D, VT + (size_t)l * 2 * D * NMEM, MB, G, bx, TID()); }
        }
        GRID_BAR();
        { EpiRes E{HB, ssq}; GEMM(EpiRes, E, MB, wl + W_O, T, D, D, bx); }
        GRID_BAR();
        { EpiGU E{BIG, ssq}; GEMM(EpiGU, E, HB, wl + W_GU, T, NGU, D, bx); }
        GRID_BAR();
        { EpiRes E{HB, ssq}; GEMM(EpiRes, E, BIG, wl + W_DN, T, D, DFF, bx); }
        GRID_BAR();
    }
    { int t2 = TID(); asm volatile("" : "+v"(t2)); const int lane = t2 & 63, gw = vcu * NWAVES + __builtin_amdgcn_readfirstlane(t2 >> 6);
      const f32x4 g0 = *(const f32x4*)(a.in[6] + 8 * lane), g1 = *(const f32x4*)(a.in[6] + 8 * lane + 4), g2 = *(const f32x4*)(a.in[6] + 512 + 8 * lane), g3 = *(const f32x4*)(a.in[6] + 512 + 8 * lane + 4);
      for (int m0 = gw * 4; m0 < T; m0 += NGW * 4) {
          u32x4 r0[4], r1[4];
#pragma unroll
          for (int r = 0; r < 4; ++r) { const bf16_t* p = HB + (size_t)(m0 + r) * D + 8 * lane; r0[r] = *(const u32x4*)p; r1[r] = *(const u32x4*)(p + 512); }
          __builtin_amdgcn_sched_barrier(0);
#pragma unroll
          for (int r = 0; r < 4; ++r) { float v[8], w[8]; unpack8(r0[r], v); unpack8(r1[r], w); float sq = 0.f;
#pragma unroll
              for (int j = 0; j < 8; ++j) sq += v[j] * v[j] + w[j] * w[j];
              const float rs = rsqrtf(wave_sum(sq) * (1.0f / 1024.0f) + RMS_EPS);
              float* o = out + (size_t)(m0 + r) * D + 8 * lane;
              *(f32x4*)o = (f32x4){v[0], v[1], v[2], v[3]} * rs * g0; *(f32x4*)(o + 4) = (f32x4){v[4], v[5], v[6], v[7]} * rs * g1;
              *(f32x4*)(o + 512) = (f32x4){w[0], w[1], w[2], w[3]} * rs * g2; *(f32x4*)(o + 516) = (f32x4){w[4], w[5], w[6], w[7]} * rs * g3; } } }
}

extern "C" void kernel_launch(void* const* d_in, const int* in_sizes, int n_in, void* d_out, int out_size, void* d_ws, size_t ws_size, hipStream_t stream) {
    static int grid = 0;
    if (grid == 0) {
        if (n_in != 28 || out_size != T * D || ws_size < WS_END) { fprintf(stderr, "kernel_launch: unexpected shapes (n_in %d out %d ws %zu)\n", n_in, out_size, ws_size); grid = -1; return; }
        int dev = 0, cus = 0, per_cu = 0;
        (void)hipGetDevice(&dev); (void)hipDeviceGetAttribute(&cus, hipDeviceAttributeMultiprocessorCount, dev);
        (void)hipFuncSetAttribute((const void*)fwd_kernel, hipFuncAttributeMaxDynamicSharedMemorySize, LDS_BYTES);
        (void)hipOccupancyMaxActiveBlocksPerMultiprocessor(&per_cu, (const void*)fwd_kernel, NTHR, LDS_BYTES);
        if (per_cu < 1) per_cu = 1;
        (void)hipGetLastError();
        grid = cus;
        if (grid % 8 != 0 || grid < 64) fprintf(stderr, "kernel_launch: unusual CU count %d\n", grid);
    }
    if (grid < 0) return;
    (void)hipMemsetAsync((char*)d_ws + WS_CTL, 0, CTL_ZERO_BYTES, stream);
    Args a{};
    for (int i = 0; i < 28; ++i) a.in[i] = (const float*)d_in[i];
    a.out = (float*)d_out; a.ws = (unsigned char*)d_ws;
    void* args[] = {&a};
    hipError_t e = hipLaunchCooperativeKernel((const void*)fwd_kernel, dim3(grid), dim3(NTHR), args, LDS_BYTES, stream);
    if (e != hipSuccess) fprintf(stderr, "cooperative launch failed: %s (grid %d)\n", hipGetErrorString(e), grid);
}
```

```cpp
#include <hip/hip_runtime.h>
#include <hip/hip_cooperative_groups.h>
#include <cstdio>
#include <cstdint>
namespace cg = cooperative_groups;
namespace pg8 {
#define PG8_LAS __attribute__((address_space(3)))
typedef unsigned short bf16_t;
typedef short bf16x8 __attribute__((ext_vector_type(8)));
typedef float f32x4 __attribute__((ext_vector_type(4)));
typedef unsigned u32x4 __attribute__((ext_vector_type(4)));
constexpr int BM = 256, BK = 64, HALF = 128, HTB = HALF * BK * 2  , STAGE_BYTES = 8 * HTB, NXCD = 8, WGM = 8;

__host__ __device__ __forceinline__ int lds_byte(int r, int c) { const int st = (r >> 4) * 2 + (c >> 5), rr = r & 15, cc = c & 31, ob = rr * 64 + cc * 2; return st * 1024 + (ob ^ (((ob >> 9) & 1) << 5)); }
__host__ __device__ __forceinline__ void stage_rc(int b, int& R, int& C) { const int st = b / 1024, sb = b % 1024, swz = sb ^ (((sb >> 9) & 1) << 5); R = (st >> 1) * 16 + swz / 64; C = (st & 1) * 32 + (swz % 64) / 2; }
__host__ __device__ __forceinline__ int perm32(int rho) { const int n = rho >> 4, i = rho & 15; return 8 * (i >> 2) + 4 * n + (i & 3); }

struct Unit { int pm, pn; };
struct Gemm { const bf16_t* A; const bf16_t* Bt; int M, N, K; };

struct StaticOrder {
    int nM, nN, nwg, G, c;
    __host__ __device__ void init(int M, int N, int G_, int c_) { nM = M / BM; nN = N / BM; nwg = nM * nN; G = G_; c = c_; }
    __host__ __device__ bool next(int i, Unit& u) const {
        const long L = (long)i * G + c; if (L >= nwg) return false;
        int wgid = (int)L; { const int q = nwg / NXCD, r = nwg % NXCD, xcd = wgid % NXCD, off = wgid / NXCD; wgid = (xcd < r ? xcd * (q + 1) : r * (q + 1) + (xcd - r) * q) + off; }
        const int nig = WGM * nN, gid = wgid / nig, fm = gid * WGM, gsz = (nM - fm) < WGM ? (nM - fm) : WGM;
        u.pm = fm + ((wgid % nig) % gsz); u.pn = (wgid % nig) / gsz; return true;
    }
    __device__ __forceinline__ void a_ready(const Unit&) const {}
    __device__ __forceinline__ void done(const Unit&) const {}
};

__device__ __forceinline__ unsigned cvt_pk_bf16(float lo, float hi) { unsigned r; asm volatile("v_cvt_pk_bf16_f32 %0, %1, %2" : "=v"(r) : "v"(lo), "v"(hi)); return r; }
typedef float f32x2 __attribute__((ext_vector_type(2)));
template <class Epi, class Sched, bool ALIGN_EPI = false, bool SP2 = false>
__device__ __forceinline__ void gemm_phase(PG8_LAS unsigned char* lds, const Gemm g, const Sched& S, const Epi& E, int tid_in) {
    int tid_ = tid_in; asm volatile("" : "+v"(tid_));
    const int tid = tid_, wid = __builtin_amdgcn_readfirstlane(tid >> 6), lane = tid & 63, wr = wid >> 2, wc = wid & 3, fr = lane & 15, fq = lane >> 4;
    const int K = g.K, nt = K / BK;
    unsigned voffA[2], voffB[2];
#pragma unroll
    for (int i = 0; i < 2; ++i) { int R, C; stage_rc(tid * 16 + i * 8192, R, C); const int Rb = Epi::PERM ? ((R & ~31) + perm32(R & 31)) : R;
        voffA[i] = (unsigned)(R * K + C) * 2u; voffB[i] = (unsigned)(Rb * K + C) * 2u; }
    const size_t kstep = (size_t)(BK * 2);
    const size_t hstep = (size_t)HALF * K * 2;
    const size_t tstep = 2 * hstep;
    const unsigned ldsw = (unsigned)wid * 1024u;
    const int aoff = lds_byte(wr * 64 + fr, fq * 8), boff = lds_byte(wc * 32 + fr, fq * 8);
#define PG8_SA(b, h) (((b) * 2 + (h)) * HTB)
#define PG8_SB(b, h) ((4 + (b) * 2 + (h)) * HTB)
#define PG8_STAGE(bufoff, gbase, voff) do { _Pragma("unroll") for (int _i = 0; _i < 2; ++_i) \
        __builtin_amdgcn_global_load_lds((const unsigned*)((const char*)(gbase) + (voff)[_i]), (PG8_LAS unsigned*)(lds + (bufoff) + ldsw + _i * 8192), 16, 0, 0); } while (0)
#define PG8_LDA(dst, b, h) do { _Pragma("unroll") for (int m = 0; m < 4; ++m) _Pragma("unroll") for (int k = 0; k < 2; ++k) dst[m][k] = *(const PG8_LAS bf16x8*)(lds + PG8_SA(b, h) + aoff + m * 2048 + k * 1024); } while (0)
#define PG8_LDB(dst, b, h) do { _Pragma("unroll") for (int n = 0; n < 2; ++n) _Pragma("unroll") for (int k = 0; k < 2; ++k) dst[n][k] = *(const PG8_LAS bf16x8*)(lds + PG8_SB(b, h) + boff + n * 2048 + k * 1024); } while (0)
#define PG8_MMA(ai, bj, At, Bt) do { __builtin_amdgcn_s_setprio(1); _Pragma("unroll") for (int m = 0; m < 4; ++m) _Pragma("unroll") for (int n = 0; n < 2; ++n) _Pragma("unroll") for (int k = 0; k < 2; ++k) \
        acc[ai][bj][m][n] = __builtin_amdgcn_mfma_f32_16x16x32_bf16(Bt[n][k], At[m][k], acc[ai][bj][m][n], 0, 0, 0); __builtin_amdgcn_s_setprio(0); } while (0)
#define PG8_WAIT_V(n) asm volatile("s_waitcnt vmcnt(" #n ")" ::: "memory")
#define PG8_WAIT_L(n) asm volatile("s_waitcnt lgkmcnt(" #n ")" ::: "memory")
#define PG8_BAR __builtin_amdgcn_s_barrier()
#define PG8_SCHED __builtin_amdgcn_sched_barrier(0)
    Unit cur, nxt; int ui = 0;
    if (!S.next(0, cur)) return;
    f32x4 acc[2][2][4][2];
#pragma unroll
    for (int a = 0; a < 2; ++a)
#pragma unroll
        for (int b = 0; b < 2; ++b)
#pragma unroll
            for (int m = 0; m < 4; ++m)
#pragma unroll
                for (int n = 0; n < 2; ++n) acc[a][b][m][n] = (f32x4){0.f, 0.f, 0.f, 0.f};
    bf16x8 At[4][2], B0[2][2], B1[2][2];
    const char* cA = (const char*)g.A + (size_t)cur.pm * tstep; const char* cB = (const char*)g.Bt + (size_t)cur.pn * tstep;
    S.a_ready(cur);
    if constexpr (SP2) {
        PG8_STAGE(PG8_SB(0, 0), cB, voffB); PG8_STAGE(PG8_SB(0, 1), cB + hstep, voffB); PG8_STAGE(PG8_SA(0, 0), cA, voffA); PG8_STAGE(PG8_SA(0, 1), cA + hstep, voffA);
        if (wr == 1) PG8_BAR;
        PG8_WAIT_V(2); PG8_BAR;
        PG8_STAGE(PG8_SB(1, 0), cB + kstep, voffB); PG8_STAGE(PG8_SA(1, 0), cA + kstep, voffA); PG8_STAGE(PG8_SB(1, 1), cB + hstep + kstep, voffB);
        PG8_WAIT_V(6); PG8_BAR;
    } else {
        PG8_STAGE(PG8_SB(0, 0), cB, voffB); PG8_STAGE(PG8_SA(0, 0), cA, voffA); PG8_STAGE(PG8_SB(0, 1), cB + hstep, voffB); PG8_STAGE(PG8_SA(0, 1), cA + hstep, voffA);
        if (wr == 1) PG8_BAR;
        PG8_WAIT_V(4); PG8_BAR;
        PG8_STAGE(PG8_SB(1, 0), cB + kstep, voffB); PG8_STAGE(PG8_SA(1, 0), cA + kstep, voffA); PG8_STAGE(PG8_SB(1, 1), cB + hstep + kstep, voffB);
        PG8_WAIT_V(6); PG8_BAR;
    }
    for (;;) {
        const bool has_next = S.next(ui + 1, nxt);
        const char* nA = has_next ? (const char*)g.A + (size_t)nxt.pm * tstep : cA; const char* nB = has_next ? (const char*)g.Bt + (size_t)nxt.pn * tstep : cB;
        for (int t = 0; t < nt; t += 2) {
            const bool last = (t == nt - 2);
            const char* a1 = cA + (size_t)(t + 1) * kstep;
            const char* a2 = last ? nA : cA + (size_t)(t + 2) * kstep; const char* b2 = last ? nB : cB + (size_t)(t + 2) * kstep;
            const char* a3 = a2 + kstep; const char* b3 = b2 + kstep;
            if (last && has_next) S.a_ready(nxt);
            if constexpr (SP2) {
            PG8_LDB(B0, 0, 0); PG8_LDB(B1, 0, 1); PG8_SCHED; PG8_LDA(At, 0, 0); PG8_STAGE(PG8_SA(1, 1), a1 + hstep, voffA);
            PG8_WAIT_V(8); PG8_WAIT_L(0); PG8_BAR; PG8_MMA(0, 0, At, B0); PG8_MMA(0, 1, At, B1); PG8_BAR; PG8_SCHED;
            PG8_LDA(At, 0, 1); PG8_STAGE(PG8_SB(0, 0), b2, voffB); PG8_STAGE(PG8_SB(0, 1), b2 + hstep, voffB); PG8_STAGE(PG8_SA(0, 0), a2, voffA);
            PG8_WAIT_V(8); PG8_WAIT_L(0); PG8_BAR; PG8_MMA(1, 0, At, B0); PG8_MMA(1, 1, At, B1); PG8_BAR; PG8_SCHED;
            PG8_LDB(B0, 1, 0); PG8_LDB(B1, 1, 1); PG8_SCHED; PG8_LDA(At, 1, 0); PG8_STAGE(PG8_SA(0, 1), a2 + hstep, voffA);
            PG8_WAIT_V(8); PG8_WAIT_L(0); PG8_BAR; PG8_MMA(0, 0, At, B0); PG8_MMA(0, 1, At, B1); PG8_BAR; PG8_SCHED;
            PG8_LDA(At, 1, 1); PG8_STAGE(PG8_SB(1, 0), b3, voffB); PG8_STAGE(PG8_SB(1, 1), b3 + hstep, voffB); PG8_STAGE(PG8_SA(1, 0), a3, voffA);
            PG8_WAIT_V(8); PG8_WAIT_L(0); PG8_BAR; PG8_MMA(1, 0, At, B0); PG8_MMA(1, 1, At, B1); PG8_BAR; PG8_SCHED;
            } else {
            PG8_LDB(B0, 0, 0); PG8_SCHED; PG8_LDA(At, 0, 0); PG8_STAGE(PG8_SA(1, 1), a1 + hstep, voffA);
            PG8_WAIT_L(8); PG8_BAR; PG8_WAIT_L(0); PG8_MMA(0, 0, At, B0); PG8_BAR; PG8_SCHED;
            PG8_LDB(B1, 0, 1); PG8_STAGE(PG8_SB(0, 0), b2, voffB);
            PG8_BAR; PG8_WAIT_L(0); PG8_MMA(0, 1, At, B1); PG8_BAR;
            PG8_LDA(At, 0, 1); PG8_STAGE(PG8_SA(0, 0), a2, voffA);
            PG8_BAR; PG8_WAIT_L(0); PG8_MMA(1, 0, At, B0); PG8_BAR; PG8_SCHED;
            PG8_STAGE(PG8_SB(0, 1), b2 + hstep, voffB);
            PG8_WAIT_V(6); PG8_BAR; PG8_MMA(1, 1, At, B1); PG8_BAR;
            PG8_LDB(B0, 1, 0); PG8_SCHED; PG8_LDA(At, 1, 0); PG8_STAGE(PG8_SA(0, 1), a2 + hstep, voffA);
            PG8_WAIT_L(8); PG8_BAR; PG8_WAIT_L(0); PG8_MMA(0, 0, At, B0); PG8_BAR; PG8_SCHED;
            PG8_LDB(B1, 1, 1); PG8_STAGE(PG8_SB(1, 0), b3, voffB);
            PG8_BAR; PG8_WAIT_L(0); PG8_MMA(0, 1, At, B1); PG8_BAR;
            PG8_LDA(At, 1, 1); PG8_STAGE(PG8_SA(1, 0), a3, voffA);
            PG8_BAR; PG8_WAIT_L(0); PG8_MMA(1, 0, At, B0); PG8_BAR; PG8_SCHED;
            PG8_STAGE(PG8_SB(1, 1), b3 + hstep, voffB);
            PG8_WAIT_V(6); PG8_BAR; PG8_MMA(1, 1, At, B1); PG8_BAR;
            }
        }
        if constexpr (ALIGN_EPI) { if (wr == 0) PG8_BAR; }
        if constexpr (!Epi::AFTER_DRAIN) { E(acc, cur, wr, wc, fr, fq); S.done(cur); }
        if (!has_next) break;
#pragma unroll
        for (int a = 0; a < 2; ++a)
#pragma unroll
            for (int b = 0; b < 2; ++b)
#pragma unroll
                for (int m = 0; m < 4; ++m)
#pragma unroll
                    for (int n = 0; n < 2; ++n) acc[a][b][m][n] = (f32x4){0.f, 0.f, 0.f, 0.f};
        cur = nxt; cA = nA; cB = nB; ++ui;
        if constexpr (ALIGN_EPI) { if (wr == 1) PG8_BAR; }
    }
    PG8_WAIT_V(0);
    if constexpr (!ALIGN_EPI) { if (wr == 0) PG8_BAR; }
    PG8_BAR;
    if constexpr (Epi::AFTER_DRAIN) { E.fused(acc, cur, wr, wc, fr, fq, lds, wid, lane); S.done(cur); }
#undef PG8_SA
#undef PG8_SB
#undef PG8_STAGE
#undef PG8_LDA
#undef PG8_LDB
#undef PG8_MMA
#undef PG8_WAIT_V
#undef PG8_WAIT_L
#undef PG8_BAR
#undef PG8_SCHED
}
}
#define LAS __attribute__((address_space(3)))
#define XB_TMO      128
#define XB_XCNT(j)  (256  + 64 * (j))
#define XB_XSUB(j)  (1280 + 64 * (j))
#define XB_XGEN(j)  (2304 + 64 * (j))
#define XB_TOP      3328
#define XB_TOPGEN   3392
#define XCD_BAR_WORDS 3456
#define XB_SPIN_CAP (1u << 18)

__device__ __forceinline__ unsigned xb_ld(unsigned* p)              { return __hip_atomic_load(p, __ATOMIC_RELAXED, __HIP_MEMORY_SCOPE_AGENT); }
__device__ __forceinline__ unsigned xb_add(unsigned* p, unsigned v) { return __hip_atomic_fetch_add(p, v, __ATOMIC_RELAXED, __HIP_MEMORY_SCOPE_AGENT); }
__device__ __forceinline__ unsigned xb_xcc_id() { return (unsigned)__builtin_amdgcn_s_getreg((3 << 11) | 20) & 0xFu; }
#define XB_SPIN(cond, bar) do { unsigned _sp = 0; while (cond) { __builtin_amdgcn_s_sleep(1); \
    if ((++_sp & 255u) == 0u) { if (xb_ld(&(bar)[XB_TMO])) break; if (_sp > XB_SPIN_CAP) { atomicAdd(&(bar)[XB_TMO], 1u); break; } } } } while (0)

struct XcdBarrier {
    unsigned* bar; unsigned x;
    volatile LAS unsigned* st;
};

__device__ __forceinline__ XcdBarrier xcd_barrier_post(unsigned* bar, volatile LAS unsigned* st, int ktid) {
    XcdBarrier b; b.bar = bar; b.x = xb_xcc_id(); b.st = st;
    if (ktid == 0) (void)xb_add(&bar[XB_XCNT(b.x)], 1u);
    return b;
}
__device__ __forceinline__ void xcd_barrier_complete(unsigned* bar, unsigned x, unsigned& nloc, unsigned& nx) {
    const unsigned G = gridDim.x * gridDim.y * gridDim.z;
    unsigned sum, cnt, mine, sp = 0u;
    for (;;) {
        sum = 0u; cnt = 0u; mine = 0u;
#pragma unroll
        for (unsigned j = 0; j < 16; ++j) { const unsigned c = xb_ld(&bar[XB_XCNT(j)]); sum += c; cnt += (c > 0u) ? 1u : 0u; mine = (j == x) ? c : mine; }
        if (sum == G) break;
        __builtin_amdgcn_s_sleep(1);
        if ((++sp & 255u) == 0u) { if (xb_ld(&bar[XB_TMO])) break; if (sp > XB_SPIN_CAP) { atomicAdd(&bar[XB_TMO], 1u); break; } }
    }
    nloc = mine > 0u ? mine : 1u; nx = cnt > 0u ? cnt : 1u;
}

__device__ __forceinline__ void xcd_barrier(const XcdBarrier& b, int ktid) {
    asm volatile("s_waitcnt vmcnt(0)" ::: "memory");
    __syncthreads();
    if (ktid == 0) {
        unsigned* bar = b.bar; const unsigned bx_ = xb_xcc_id();
        __builtin_amdgcn_s_waitcnt(0);
        unsigned nloc = b.st[0], nx = b.st[1];
        if (nloc == 0u) { xcd_barrier_complete(bar, bx_, nloc, nx); b.st[0] = nloc; b.st[1] = nx; }
        const unsigned old = xb_add(&bar[XB_XSUB(bx_)], 1u);
        const unsigned gen = old / nloc;
        if (old + 1u == (gen + 1u) * nloc) {
            __builtin_amdgcn_fence(__ATOMIC_RELEASE, "agent");
            asm volatile("s_waitcnt vmcnt(0)" ::: "memory");
            const unsigned og = xb_add(&bar[XB_TOP], 1u);
            const unsigned tg = og / nx;
            if (og + 1u == (tg + 1u) * nx) xb_add(&bar[XB_TOPGEN], 1u);
            else XB_SPIN(xb_ld(&bar[XB_TOPGEN]) == tg, bar);
            __builtin_amdgcn_fence(__ATOMIC_ACQUIRE, "agent");
            xb_add(&bar[XB_XGEN(bx_)], 1u);
            asm volatile("s_waitcnt vmcnt(0)" ::: "memory");
        } else {
            XB_SPIN(xb_ld(&bar[XB_XGEN(bx_)]) == gen, bar);
            __builtin_amdgcn_fence(__ATOMIC_ACQUIRE, "agent");
            asm volatile("s_waitcnt vmcnt(0)" ::: "memory");
        }
    }
    __syncthreads();
}
#undef LAS
using namespace pg8;
#define LAS __attribute__((address_space(3)))
typedef unsigned u32x2 __attribute__((ext_vector_type(2)));

constexpr int NWAVES = 8, NTHR = 512;
constexpr int SEQ = 8192, NBATCH = 2, T = NBATCH * SEQ, D = 1024, DZ0 = 2560, DZ1 = 2048, DFF = 2816, NGU = 2 * DFF, NMEM = 256;
constexpr float RMS_EPS = 1e-6f, LN_EPS = 1e-5f;
constexpr size_t MiB = 1u << 20;
constexpr size_t WS_CTL = 0, CTL_ZERO_BYTES = 64 * 1024;
constexpr size_t WS_W = 2 * MiB, W_LAYER = 32 * MiB;
constexpr size_t W_IN = 0, W_OUT = 5 * MiB, W_Q = 7 * MiB, W_KV = 9 * MiB, W_O = 13 * MiB, W_GU = 15 * MiB, W_DN = 26 * MiB;
constexpr size_t WS_WSB = 66 * MiB;
constexpr size_t WS_SSQ = 67 * MiB;
constexpr size_t WS_VST = 68 * MiB;
constexpr size_t WS_MEMN = 70 * MiB;
constexpr size_t WS_KB = 72 * MiB;
constexpr size_t WS_VT = 74 * MiB;
constexpr size_t WS_HB = 76 * MiB;
constexpr size_t WS_MB = 108 * MiB;
constexpr size_t WS_BIG = 140 * MiB;
constexpr size_t WS_END = 228 * MiB;
constexpr int LDS_BYTES = 147456, MISC_OFF = 139264;

__device__ __forceinline__ float wave_sum(float v) {
#pragma unroll
    for (int o = 1; o < 64; o <<= 1) v += __shfl_xor(v, o);
    return v;
}
__device__ __forceinline__ float bf2f(unsigned short b) { return __uint_as_float((unsigned)b << 16); }
__device__ __forceinline__ float bflo(unsigned w) { return __uint_as_float(w << 16); }
__device__ __forceinline__ float bfhi(unsigned w) { return __uint_as_float(w & 0xffff0000u); }
__device__ __forceinline__ unsigned short f2bf(float f) { return (unsigned short)(cvt_pk_bf16(f, 0.f) & 0xffffu); }
__device__ __forceinline__ float sigm(float x) { return __builtin_amdgcn_rcpf(1.f + __builtin_amdgcn_exp2f(-1.44269504f * x)); }
__device__ __forceinline__ float gelu_tanh(float x) { const float y = 1.5957691216f * (x + 0.044715f * x * x * x); return x * sigm(y); }

__device__ __forceinline__ float row_rstd(const float* ssq, int row, int fq) {
    const f32x4 a = *(const f32x4*)(ssq + (size_t)row * 16 + 4 * fq);
    float s = (a[0] + a[1]) + (a[2] + a[3]);
    s += __shfl_xor(s, 16); s += __shfl_xor(s, 32);
    return rsqrtf(s * (1.0f / 1024.0f) + RMS_EPS);
}
__device__ __forceinline__ u32x4 pack8(const f32x4 v0, const f32x4 v1) { u32x4 w; w.x = cvt_pk_bf16(v0[0], v0[1]); w.y = cvt_pk_bf16(v0[2], v0[3]); w.z = cvt_pk_bf16(v1[0], v1[1]); w.w = cvt_pk_bf16(v1[2], v1[3]); return w; }

struct EpiScale {
    static constexpr bool PERM = true, AFTER_DRAIN = false;
    bf16_t* O; int ldc; const float* ssq;
    __device__ __forceinline__ void operator()(const f32x4 (&acc)[2][2][4][2], const Unit& u, int wr, int wc, int fr, int fq) const {
        const int row0 = u.pm * BM + wr * 64 + fr, col0 = u.pn * BM + wc * 32 + 8 * fq;
#pragma unroll
        for (int ai = 0; ai < 2; ++ai)
#pragma unroll
            for (int m = 0; m < 4; ++m) { const int row = row0 + ai * HALF + m * 16; const float rs = ssq ? row_rstd(ssq, row, fq) : 1.f; bf16_t* rowp = O + (size_t)row * ldc + col0;
#pragma unroll
                for (int bj = 0; bj < 2; ++bj) *(u32x4*)(rowp + bj * HALF) = pack8(acc[ai][bj][m][0] * rs, acc[ai][bj][m][1] * rs); }
    }
};
struct EpiRes {
    static constexpr bool PERM = true, AFTER_DRAIN = false;
    bf16_t* hb; float* ssq;
    __device__ __forceinline__ void operator()(const f32x4 (&acc)[2][2][4][2], const Unit& u, int wr, int wc, int fr, int fq) const {
        const int row0 = u.pm * BM + wr * 64 + fr, col0 = u.pn * BM + wc * 32 + 8 * fq;
#pragma unroll
        for (int ai = 0; ai < 2; ++ai)
#pragma unroll
            for (int m = 0; m < 4; ++m) { const int row = row0 + ai * HALF + m * 16; const size_t off = (size_t)row * D + col0; float q = 0.f;
#pragma unroll
                for (int bj = 0; bj < 2; ++bj) { const u32x4 bb = *(const u32x4*)(hb + off + bj * HALF);
                    const f32x4 b0 = (f32x4){bflo(bb.x), bfhi(bb.x), bflo(bb.y), bfhi(bb.y)}, b1 = (f32x4){bflo(bb.z), bfhi(bb.z), bflo(bb.w), bfhi(bb.w)};
                    const f32x4 v0 = b0 + acc[ai][bj][m][0], v1 = b1 + acc[ai][bj][m][1];
                    *(u32x4*)(hb + off + bj * HALF) = pack8(v0, v1);
                    q += ((v0[0] * v0[0] + v0[1] * v0[1]) + (v0[2] * v0[2] + v0[3] * v0[3])) + ((v1[0] * v1[0] + v1[1] * v1[1]) + (v1[2] * v1[2] + v1[3] * v1[3])); }
                q += __shfl_xor(q, 16); q += __shfl_xor(q, 32);
                if (fq == 0) ssq[(size_t)row * 16 + u.pn * 4 + wc] = q; }
    }
};
struct EpiGU {
    static constexpr bool PERM = true, AFTER_DRAIN = false;
    bf16_t* O; const float* ssq;
    __device__ __forceinline__ void operator()(const f32x4 (&acc)[2][2][4][2], const Unit& u, int wr, int wc, int fr, int fq) const {
        const int row0 = u.pm * BM + wr * 64 + fr, col0 = u.pn * HALF + wc * 32 + 8 * fq;
#pragma unroll
        for (int ai = 0; ai < 2; ++ai)
#pragma unroll
            for (int m = 0; m < 4; ++m) { const int row = row0 + ai * HALF + m * 16; const float rs = row_rstd(ssq, row, fq);
                f32x4 h[2];
#pragma unroll
                for (int n = 0; n < 2; ++n)
#pragma unroll
                    for (int j = 0; j < 4; ++j) { const float g = acc[ai][0][m][n][j] * rs, up = acc[ai][1][m][n][j] * rs; h[n][j] = g * sigm(g) * up; }
                *(u32x4*)(O + (size_t)row * DFF + col0) = pack8(h[0], h[1]); }
    }
};
struct EpiZ1 {
    static constexpr bool PERM = true, AFTER_DRAIN = false;
    bf16_t* O; const float* ssq; float* vst;
    __device__ __forceinline__ void operator()(const f32x4 (&acc)[2][2][4][2], const Unit& u, int wr, int wc, int fr, int fq) const {
        const int row0 = u.pm * BM + wr * 64 + fr, col0 = u.pn * BM + wc * 32 + 8 * fq;
#pragma unroll
        for (int ai = 0; ai < 2; ++ai)
#pragma unroll
            for (int m = 0; m < 4; ++m) { const int row = row0 + ai * HALF + m * 16; const float rs = row_rstd(ssq, row, fq); bf16_t* rowp = O + (size_t)row * DZ1 + col0; float s = 0.f, q = 0.f;
#pragma unroll
                for (int bj = 0; bj < 2; ++bj) { f32x4 v[2];
#pragma unroll
                    for (int n = 0; n < 2; ++n)
#pragma unroll
                        for (int j = 0; j < 4; ++j) { const float g = gelu_tanh(acc[ai][bj][m][n][j] * rs); v[n][j] = g; s += g; q += g * g; }
                    *(u32x4*)(rowp + bj * HALF) = pack8(v[0], v[1]); }
                if (u.pn >= 4) { s += __shfl_xor(s, 16); s += __shfl_xor(s, 32); q += __shfl_xor(q, 16); q += __shfl_xor(q, 32);
                    if (fq == 0) { float* p = vst + ((size_t)row * 16 + (u.pn - 4) * 4 + wc) * 2; p[0] = s; p[1] = q; } } }
    }
};
struct EpiKV {
    static constexpr bool PERM = true, AFTER_DRAIN = false;
    bf16_t* Kb; bf16_t* Vt;
    __device__ __forceinline__ void operator()(const f32x4 (&acc)[2][2][4][2], const Unit& u, int wr, int wc, int fr, int fq) const {
        const int col0 = (u.pn & 3) * BM + wc * 32 + 8 * fq;
#pragma unroll
        for (int ai = 0; ai < 2; ++ai)
#pragma unroll
            for (int m = 0; m < 4; ++m) { const int key = ai * HALF + wr * 64 + m * 16 + fr;
                if (u.pn < 4) { bf16_t* rowp = Kb + (size_t)(u.pm * BM + key) * D + col0;
#pragma unroll
                    for (int bj = 0; bj < 2; ++bj) *(u32x4*)(rowp + bj * HALF) = pack8(acc[ai][bj][m][0], acc[ai][bj][m][1]);
                } else { const int kp = (key & ~31) + 8 * ((key >> 2) & 3) + 4 * ((key >> 4) & 1) + (key & 3);
#pragma unroll
                    for (int bj = 0; bj < 2; ++bj)
#pragma unroll
                        for (int n = 0; n < 2; ++n)
#pragma unroll
                            for (int j = 0; j < 4; ++j) Vt[((size_t)u.pm * D + col0 + bj * HALF + 4 * n + j) * NMEM + kp] = f2bf(acc[ai][bj][m][n][j]); } }
    }
};

__device__ __forceinline__ void tr_item(const float* W, int K, int N, bf16_t* WT, const float* g, float cs, int mode, LAS float* scr, int item, int lane) {
    const int nblk = N / 64, kb = item / nblk, nb = item % nblk, k0 = 64 * kb, n0 = 64 * nb;
    const int orow = mode == 0 ? n0 : ((n0 >> 7) * 256 + (n0 & 127) + (mode == 2 ? 128 : 0));
    const int kq = lane >> 4, n4 = (lane & 15) * 4;
    f32x4 v[16]; float sc[16];
#pragma unroll
    for (int i = 0; i < 16; ++i) { const int kk = 4 * i + kq; v[i] = *(const f32x4*)(W + (size_t)(k0 + kk) * N + n0 + n4); sc[i] = g ? g[k0 + kk] * cs : cs; }
    __builtin_amdgcn_sched_barrier(0);
#pragma unroll
    for (int i = 0; i < 16; ++i) { const int kk = 4 * i + kq; LAS float* d = scr + kk * 65 + n4; d[0] = v[i][0] * sc[i]; d[1] = v[i][1] * sc[i]; d[2] = v[i][2] * sc[i]; d[3] = v[i][3] * sc[i]; }
    asm volatile("s_waitcnt lgkmcnt(0)" ::: "memory");
    const int c = lane & 7;
#pragma unroll
    for (int j = 0; j < 8; ++j) { const int n = (lane >> 3) + 8 * j; const LAS float* p = scr + (8 * c) * 65 + n;
        u32x4 o; o.x = cvt_pk_bf16(p[0 * 65], p[1 * 65]); o.y = cvt_pk_bf16(p[2 * 65], p[3 * 65]); o.z = cvt_pk_bf16(p[4 * 65], p[5 * 65]); o.w = cvt_pk_bf16(p[6 * 65], p[7 * 65]);
        *(u32x4*)(WT + (size_t)(orow + n) * K + k0 + 8 * c) = o; }
    asm volatile("s_waitcnt lgkmcnt(0)" ::: "memory");
}

struct Args { const float* in[28]; float* out; unsigned char* ws; };

__device__ __forceinline__ void p0_weights(const Args& a, int l, int part, LAS unsigned char* lds, int gw, int NGW, int wave, int lane) {
    unsigned char* ws = a.ws;
    LAS float* scr = (LAS float*)(lds + wave * 16640);
    const float QS = 0.0625f * 1.44269504f;
    const int NIN = l ? DZ1 : DZ0, I_IN = 16 * (NIN / 64);
    constexpr int I_SQ = 16 * 16, I_GU = 16 * (DFF / 64), I_DN = (DFF / 64) * 16;
    const int I_KV = (part == 0 || part == 1) ? I_SQ : 0, I_A = (part == 0 || part == 3) ? I_IN : 0, I_S = (part == 0 || part == 3) ? I_SQ : 0, I_G = (part == 0 || part == 4) ? I_GU : 0, I_D = (part == 0 || part == 4) ? I_DN : 0;
    const int NITEMS = I_A + 3 * I_S + 2 * I_KV + 2 * I_G + I_D;
    unsigned char* wl = ws + WS_W + (size_t)l * W_LAYER;
    for (int it = gw; it < NITEMS; it += NGW) {
        int r = it; bool found = false; const float* W = nullptr; int K = 0, N = 0, mode = 0; bf16_t* WT = nullptr; const float* gv = nullptr; float cs = 1.f;
#define SEL(NI, Wp, K_, N_, WTp, g_, cs_, mode_) if (!found) { if (r < (NI)) { W = (Wp); K = (K_); N = (N_); WT = (bf16_t*)(WTp); gv = (g_); cs = (cs_); mode = (mode_); found = true; } else r -= (NI); }
        SEL(I_A, l ? a.in[15] : a.in[7], D, NIN, wl + W_IN, a.in[2] + l * D, 1.f, 0)
        SEL(I_S, l ? a.in[20] : a.in[14], D, D, wl + W_OUT, nullptr, 1.f, 0)
        SEL(I_S, a.in[21] + (size_t)l * D * D, D, D, wl + W_Q, a.in[3] + l * D, QS, 0)
        SEL(I_KV, a.in[22] + (size_t)l * D * D, D, D, wl + W_KV, nullptr, 1.f, 0)
        SEL(I_KV, a.in[23] + (size_t)l * D * D, D, D, wl + W_KV + (size_t)D * D * 2, nullptr, 1.f, 0)
        SEL(I_S, a.in[24] + (size_t)l * D * D, D, D, wl + W_O, nullptr, 1.f, 0)
        SEL(I_G, a.in[25] + (size_t)l * D * DFF, D, DFF, wl + W_GU, a.in[5] + l * D, 1.f, 1)
        SEL(I_G, a.in[26] + (size_t)l * D * DFF, D, DFF, wl + W_GU, a.in[5] + l * D, 1.f, 2)
        SEL(I_D, a.in[27] + (size_t)l * D * DFF, DFF, D, wl + W_DN, nullptr, 1.f, 0)
#undef SEL
        tr_item(W, K, N, WT, gv, cs, mode, scr, r, lane);
    }
}
__device__ __forceinline__ void p0_prologue(const Args& a, LAS unsigned char* lds, int gw, int NGW, int wave, int lane) {
    unsigned char* ws = a.ws;
    { const f32x4* src = (const f32x4*)a.in[18]; u32x2* dst = (u32x2*)(ws + WS_WSB);
      for (int i = gw * 64 + lane; i < 8 * 128 * 128 / 4; i += NGW * 64) { const f32x4 v = src[i]; u32x2 o; o.x = cvt_pk_bf16(v[0], v[1]); o.y = cvt_pk_bf16(v[2], v[3]); dst[i] = o; } }
    { float* ssq = (float*)(ws + WS_SSQ); bf16_t* HB = (bf16_t*)(ws + WS_HB);
      for (int m0 = gw * 4; m0 < T; m0 += NGW * 4) {
          f32x4 v[4][4];
#pragma unroll
          for (int r = 0; r < 4; ++r) { const f32x4* xr = (const f32x4*)(a.in[0] + (size_t)(m0 + r) * D) + lane;
#pragma unroll
              for (int j = 0; j < 4; ++j) v[r][j] = xr[64 * j]; }
          __builtin_amdgcn_sched_barrier(0);
#pragma unroll
          for (int r = 0; r < 4; ++r) { float s = 0.f;
#pragma unroll
              for (int j = 0; j < 4; ++j) s += (v[r][j][0] * v[r][j][0] + v[r][j][1] * v[r][j][1]) + (v[r][j][2] * v[r][j][2] + v[r][j][3] * v[r][j][3]);
              s = wave_sum(s);
              u32x2* o = (u32x2*)(HB + (size_t)(m0 + r) * D) + lane;
#pragma unroll
              for (int j = 0; j < 4; ++j) { u32x2 w; w.x = cvt_pk_bf16(v[r][j][0], v[r][j][1]); w.y = cvt_pk_bf16(v[r][j][2], v[r][j][3]); o[64 * j] = w; }
              if (lane < 16) ssq[(size_t)(m0 + r) * 16 + lane] = lane == 0 ? s : 0.f; }
      } }
    { bf16_t* MN = (bf16_t*)(ws + WS_MEMN);
      for (int m = gw; m < 2 * 512; m += NGW) { const int l = m >> 9, row = m & 511;
          const f32x4* xr = (const f32x4*)(a.in[1] + (size_t)row * D) + lane; const f32x4* gr = (const f32x4*)(a.in[4] + l * D) + lane; f32x4 v[4]; float s = 0.f;
#pragma unroll
          for (int j = 0; j < 4; ++j) { v[j] = xr[64 * j]; s += (v[j][0] * v[j][0] + v[j][1] * v[j][1]) + (v[j][2] * v[j][2] + v[j][3] * v[j][3]); }
          const float rs = rsqrtf(wave_sum(s) * (1.0f / 1024.0f) + RMS_EPS);
          u32x2* o = (u32x2*)(MN + ((size_t)l * 512 + row) * D) + lane;
#pragma unroll
          for (int j = 0; j < 4; ++j) { const f32x4 g = gr[64 * j]; u32x2 w; w.x = cvt_pk_bf16(v[j][0] * rs * g[0], v[j][1] * rs * g[1]); w.y = cvt_pk_bf16(v[j][2] * rs * g[2], v[j][3] * rs * g[3]); o[64 * j] = w; }
      } }
}

__device__ __forceinline__ void unpack8(const u32x4 r, float (&v)[8]) { v[0] = bflo(r.x); v[1] = bfhi(r.x); v[2] = bflo(r.y); v[3] = bfhi(r.y); v[4] = bflo(r.z); v[5] = bfhi(r.z); v[6] = bflo(r.w); v[7] = bfhi(r.w); }
__device__ __forceinline__ void conv_phase(LAS unsigned char* lds, const bf16_t* Z, bf16_t* Mo, const float* cw, const float* cb, const float* lg, const float* lb,
                                           const float* bw, const float* bb, int G, int c, int tid_in) {
    constexpr int TT = 32, RR = TT + 30;
    int tid_ = tid_in; asm volatile("" : "+v"(tid_)); asm volatile("" : "+s"(c), "+s"(G));
    const int tid = tid_, lane = tid & 63, wid = tid >> 6;
    LAS float* as = (LAS float*)lds;
    LAS float* os = (LAS float*)lds;
    for (int u = c; u < T / TT; u += G) {
        const int t0 = u * TT, b = t0 / SEQ, s0 = t0 % SEQ;
        const bf16_t* zb = Z + (size_t)b * SEQ * DZ0;
        __syncthreads();
        { u32x4 rv[8], rg[8];
#pragma unroll
          for (int i = 0; i < 8; ++i) { const int idx = tid + 512 * i, r = idx >> 6, cc = idx & 63, sq = s0 - 15 + r; const bool ok = (idx < RR * 64) && (sq >= 0) && (sq < SEQ);
              const bf16_t* p = zb + (size_t)(ok ? sq : s0) * DZ0 + cc * 8; rv[i] = *(const u32x4*)p; rg[i] = *(const u32x4*)(p + 512);
              if (!ok) rv[i] = (u32x4){0u, 0u, 0u, 0u}; }
          __builtin_amdgcn_sched_barrier(0);
#pragma unroll
          for (int i = 0; i < 8; ++i) { const int idx = tid + 512 * i, r = idx >> 6, cc = idx & 63; float v[8], gt[8]; unpack8(rv[i], v); unpack8(rg[i], gt);
              f32x4 a0, a1;
#pragma unroll
              for (int j = 0; j < 4; ++j) { a0[j] = v[j] * sigm(gt[j]); a1[j] = v[4 + j] * sigm(gt[4 + j]); }
              if (idx < RR * 64) { *(LAS f32x4*)(as + r * 512 + cc * 8) = a0; *(LAS f32x4*)(as + r * 512 + cc * 8 + 4) = a1; } } }
        __syncthreads();
        float o[TT];
        { float w[31]; const float* cw_ = cw; const float* cb_ = cb; asm volatile("" : "+s"(cw_), "+s"(cb_));
#pragma unroll
          for (int k = 0; k < 31; ++k) w[k] = cw_[k * 512 + tid];
          const float cbias = cb_[tid];
          float av[RR];
#pragma unroll
          for (int r = 0; r < RR; ++r) av[r] = as[r * 512 + tid];
#pragma unroll
          for (int t = 0; t < TT; ++t) { float acc = cbias;
#pragma unroll
              for (int k = 0; k < 31; ++k) acc += w[k] * av[t + k];
              o[t] = acc; } }
        __syncthreads();
#pragma unroll
        for (int t = 0; t < TT; ++t) os[t * 512 + tid] = o[t];
        __syncthreads();
        { const float* lg_ = lg; const float* lb_ = lb; asm volatile("" : "+s"(lg_), "+s"(lb_));
          const f32x4 g0 = *(const f32x4*)(lg_ + 8 * lane), g1 = *(const f32x4*)(lg_ + 8 * lane + 4), b0 = *(const f32x4*)(lb_ + 8 * lane), b1 = *(const f32x4*)(lb_ + 8 * lane + 4);
#pragma unroll
          for (int i = 0; i < TT / 8; ++i) { const int t = (TT / 8) * wid + i;
              const f32x4 v0 = *(const LAS f32x4*)(os + t * 512 + 8 * lane), v1 = *(const LAS f32x4*)(os + t * 512 + 8 * lane + 4);
              const float mean = wave_sum(((v0[0] + v0[1]) + (v0[2] + v0[3])) + ((v1[0] + v1[1]) + (v1[2] + v1[3]))) * (1.0f / 512.0f);
              const f32x4 d0 = v0 - mean, d1 = v1 - mean;
              const float var = wave_sum(((d0[0] * d0[0] + d0[1] * d0[1]) + (d0[2] * d0[2] + d0[3] * d0[3])) + ((d1[0] * d1[0] + d1[1] * d1[1]) + (d1[2] * d1[2] + d1[3] * d1[3]))) * (1.0f / 512.0f);
              const float rstd = rsqrtf(var + LN_EPS);
              f32x4 y0 = d0 * rstd * g0 + b0, y1 = d1 * rstd * g1 + b1;
#pragma unroll
              for (int j = 0; j < 4; ++j) { y0[j] = y0[j] * sigm(y0[j]); y1[j] = y1[j] * sigm(y1[j]); }
              *(u32x4*)(Mo + (size_t)(t0 + t) * D + 8 * lane) = pack8(y0, y1); } }
        { const int cc = tid & 63, rgp = tid >> 6, sb = s0 + 4 * rgp;
          u32x4 hh[6], gc[6], gb[4];
#pragma unroll
          for (int r = 0; r < 6; ++r) { const int sq = sb - 1 + r; const bool ok = (sq >= 0) && (sq < SEQ); const bf16_t* p = zb + (size_t)(ok ? sq : s0) * DZ0 + cc * 8;
              hh[r] = *(const u32x4*)(p + 1024); gc[r] = *(const u32x4*)(p + 2048); if (!ok) hh[r] = (u32x4){0u, 0u, 0u, 0u};
              if (r >= 1 && r <= 4) gb[r - 1] = *(const u32x4*)(p + 1536); }
          const float* bw_ = bw; const float* bb_ = bb; asm volatile("" : "+s"(bw_), "+s"(bb_));
          const f32x4 w0a = *(const f32x4*)(bw_ + cc * 8), w0b = *(const f32x4*)(bw_ + cc * 8 + 4), w1a = *(const f32x4*)(bw_ + 512 + cc * 8), w1b = *(const f32x4*)(bw_ + 512 + cc * 8 + 4),
                      w2a = *(const f32x4*)(bw_ + 1024 + cc * 8), w2b = *(const f32x4*)(bw_ + 1024 + cc * 8 + 4), bba = *(const f32x4*)(bb_ + cc * 8), bbb = *(const f32x4*)(bb_ + cc * 8 + 4);
          __builtin_amdgcn_sched_barrier(0);
          float x[6][8];
#pragma unroll
          for (int r = 0; r < 6; ++r) { float hv[8], gv[8]; unpack8(hh[r], hv); unpack8(gc[r], gv);
#pragma unroll
              for (int j = 0; j < 8; ++j) x[r][j] = hv[j] * gv[j]; }
#pragma unroll
          for (int t = 0; t < 4; ++t) { float gbv[8]; unpack8(gb[t], gbv); f32x4 y0, y1;
#pragma unroll
              for (int j = 0; j < 4; ++j) { y0[j] = gbv[j] * (w0a[j] * x[t][j] + w1a[j] * x[t + 1][j] + w2a[j] * x[t + 2][j] + bba[j]);
                  y1[j] = gbv[4 + j] * (w0b[j] * x[t][4 + j] + w1b[j] * x[t + 1][4 + j] + w2b[j] * x[t + 2][4 + j] + bbb[j]); }
              *(u32x4*)(Mo + (size_t)(t0 + 4 * rgp + t) * D + 512 + cc * 8) = pack8(y0, y1); } }
    }
}

__device__ __forceinline__ void sgu_phase(LAS unsigned char* lds, const bf16_t* Z1, const float* vst, const bf16_t* Wsb, const float* bs, const float* lg, const float* lb, bf16_t* Y, int G, int c, int tid_in) {
    constexpr int RS = 272;
    int tid_ = tid_in; asm volatile("" : "+v"(tid_)); asm volatile("" : "+s"(c), "+s"(G));
    const int tid = tid_, lane = tid & 63, wid = tid >> 6, fr = lane & 15, fq = lane >> 4;
    LAS unsigned char* Wl = lds; LAS unsigned char* Vl = lds + 128 * RS;
    for (int u = c; u < 1024; u += G) {
        const int n = u >> 3, g = u & 7, t0 = n * 128, cg0 = g * 128;
        const int q = tid & 127, qc = tid >> 7;
        u32x4 wt[4], vr[4]; f32x4 sp[8];
#pragma unroll
        for (int i = 0; i < 4; ++i) { const int idx = tid + 512 * i, p = idx >> 4, chn = idx & 15; wt[i] = *(const u32x4*)(Wsb + ((size_t)g * 128 + p) * 128 + chn * 8); }
#pragma unroll
        for (int i = 0; i < 4; ++i) vr[i] = *(const u32x4*)(Z1 + (size_t)(t0 + q) * DZ1 + 1024 + cg0 + qc * 32 + i * 8);
#pragma unroll
        for (int j = 0; j < 8; ++j) sp[j] = *(const f32x4*)(vst + (size_t)(t0 + q) * 32 + 4 * j);
        const int pr = 16 * wid + fr, row = t0 + pr;
        u32x2 uu[8];
#pragma unroll
        for (int cb = 0; cb < 8; ++cb) uu[cb] = *(const u32x2*)(Z1 + (size_t)row * DZ1 + cg0 + 16 * cb + 4 * fq);
        const float bias = bs[g * 128 + pr];
        __builtin_amdgcn_sched_barrier(0);
        __syncthreads();
#pragma unroll
        for (int i = 0; i < 4; ++i) { const int idx = tid + 512 * i, p = idx >> 4, chn = idx & 15; *(LAS u32x4*)(Wl + p * RS + chn * 16) = wt[i]; }
        { float s1 = 0.f, s2 = 0.f;
#pragma unroll
          for (int j = 0; j < 8; ++j) { s1 += sp[j][0] + sp[j][2]; s2 += sp[j][1] + sp[j][3]; }
          const float mean = s1 * (1.0f / 1024.0f), var = s2 * (1.0f / 1024.0f) - mean * mean, rstd = rsqrtf(var + LN_EPS);
#pragma unroll
          for (int i = 0; i < 4; ++i) { const int c0 = qc * 32 + i * 8; float v[8]; unpack8(vr[i], v);
              const f32x4 g0 = *(const f32x4*)(lg + cg0 + c0), g1 = *(const f32x4*)(lg + cg0 + c0 + 4), b0 = *(const f32x4*)(lb + cg0 + c0), b1 = *(const f32x4*)(lb + cg0 + c0 + 4);
#pragma unroll
              for (int j = 0; j < 8; ++j) { const float gg = j < 4 ? g0[j & 3] : g1[j & 3], bbv = j < 4 ? b0[j & 3] : b1[j & 3];
                  *(LAS bf16_t*)(Vl + (c0 + j) * RS + q * 2) = f2bf((v[j] - mean) * rstd * gg + bbv); } } }
        __syncthreads();
        bf16x8 wf[4];
#pragma unroll
        for (int ks = 0; ks < 4; ++ks) wf[ks] = *(const LAS bf16x8*)(Wl + (16 * wid + fr) * RS + (32 * ks + 8 * fq) * 2);
        f32x4 acc[8];
#pragma unroll
        for (int cb = 0; cb < 8; ++cb) { acc[cb] = (f32x4){0.f, 0.f, 0.f, 0.f};
#pragma unroll
            for (int ks = 0; ks < 4; ++ks) { const bf16x8 vf = *(const LAS bf16x8*)(Vl + (16 * cb + fr) * RS + (32 * ks + 8 * fq) * 2);
                acc[cb] = __builtin_amdgcn_mfma_f32_16x16x32_bf16(vf, wf[ks], acc[cb], 0, 0, 0); } }
#pragma unroll
        for (int cb = 0; cb < 8; ++cb) { const int cc = cg0 + 16 * cb + 4 * fq;
            u32x2 o; o.x = cvt_pk_bf16(bflo(uu[cb].x) * (acc[cb][0] + bias), bfhi(uu[cb].x) * (acc[cb][1] + bias)); o.y = cvt_pk_bf16(bflo(uu[cb].y) * (acc[cb][2] + bias), bfhi(uu[cb].y) * (acc[cb][3] + bias));
            *(u32x2*)(Y + (size_t)row * D + cc) = o; }
    }
}

__device__ __forceinline__ void attn_phase(LAS unsigned char* lds, const bf16_t* Q, const bf16_t* Kb, const bf16_t* Vt, bf16_t* O, int G, int c, int tid_in) {
    constexpr int RS = 528;
    int tid_ = tid_in; asm volatile("" : "+v"(tid_)); asm volatile("" : "+s"(c), "+s"(G));
    const int tid = tid_, lane = tid & 63, wid = tid >> 6, fr = lane & 15, fq = lane >> 4;
    for (int u = c; u < 512; u += G) {
        const int qb = u >> 2, h = u & 3, b = qb >> 6, q0 = qb * 128;
        const bf16_t* qrow = Q + (size_t)(q0 + 16 * wid + fr) * D + h * 256 + 8 * fq;
        bf16x8 qf[8];
#pragma unroll
        for (int ks = 0; ks < 8; ++ks) qf[ks] = *(const bf16x8*)(qrow + 32 * ks);
        __syncthreads();
        { u32x4 tv[16];
#pragma unroll
          for (int i = 0; i < 16; ++i) { const int idx = tid + 512 * i, key = idx >> 5, ch = idx & 31; tv[i] = *(const u32x4*)(Kb + (size_t)(b * 256 + key) * D + h * 256 + ch * 8); }
          __builtin_amdgcn_sched_barrier(0);
#pragma unroll
          for (int i = 0; i < 16; ++i) { const int idx = tid + 512 * i, key = idx >> 5, ch = idx & 31; *(LAS u32x4*)(lds + key * RS + ch * 16) = tv[i]; } }
        __syncthreads();
        f32x4 S[16];
#pragma unroll
        for (int kb = 0; kb < 16; ++kb) { S[kb] = (f32x4){0.f, 0.f, 0.f, 0.f};
#pragma unroll
            for (int ks = 0; ks < 8; ++ks) { const bf16x8 kf = *(const LAS bf16x8*)(lds + (16 * kb + fr) * RS + (32 * ks + 8 * fq) * 2);
                S[kb] = __builtin_amdgcn_mfma_f32_16x16x32_bf16(kf, qf[ks], S[kb], 0, 0, 0); } }
        float mx = -3.0e38f;
#pragma unroll
        for (int kb = 0; kb < 16; ++kb) mx = fmaxf(mx, fmaxf(fmaxf(S[kb][0], S[kb][1]), fmaxf(S[kb][2], S[kb][3])));
        mx = fmaxf(mx, __shfl_xor(mx, 16)); mx = fmaxf(mx, __shfl_xor(mx, 32));
        float l = 0.f;
#pragma unroll
        for (int kb = 0; kb < 16; ++kb)
#pragma unroll
            for (int j = 0; j < 4; ++j) { const float p = __builtin_amdgcn_exp2f(S[kb][j] - mx); S[kb][j] = p; l += p; }
        l += __shfl_xor(l, 16); l += __shfl_xor(l, 32);
        bf16x8 pf[8];
#pragma unroll
        for (int cc = 0; cc < 8; ++cc) { const u32x4 w = pack8(S[2 * cc], S[2 * cc + 1]); pf[cc] = __builtin_bit_cast(bf16x8, w); }
        __syncthreads();
        { u32x4 tv[16];
#pragma unroll
          for (int i = 0; i < 16; ++i) { const int idx = tid + 512 * i, d = idx >> 5, ch = idx & 31; tv[i] = *(const u32x4*)(Vt + ((size_t)b * D + h * 256 + d) * NMEM + ch * 8); }
          __builtin_amdgcn_sched_barrier(0);
#pragma unroll
          for (int i = 0; i < 16; ++i) { const int idx = tid + 512 * i, d = idx >> 5, ch = idx & 31; *(LAS u32x4*)(lds + d * RS + ch * 16) = tv[i]; } }
        __syncthreads();
        const float inv = 1.0f / l;
        bf16_t* orow = O + (size_t)(q0 + 16 * wid + fr) * D + h * 256 + 4 * fq;
#pragma unroll
        for (int db = 0; db < 16; ++db) { f32x4 oa = (f32x4){0.f, 0.f, 0.f, 0.f};
#pragma unroll
            for (int cc = 0; cc < 8; ++cc) { const bf16x8 vf = *(const LAS bf16x8*)(lds + (16 * db + fr) * RS + (32 * cc + 8 * fq) * 2);
                oa = __builtin_amdgcn_mfma_f32_16x16x32_bf16(vf, pf[cc], oa, 0, 0, 0); }
            u32x2 o; o.x = cvt_pk_bf16(oa[0] * inv, oa[1] * inv); o.y = cvt_pk_bf16(oa[2] * inv, oa[3] * inv);
            *(u32x2*)(orow + 16 * db) = o; }
    }
}

struct EpiQAttn {
    static constexpr bool PERM = true, AFTER_DRAIN = true;
    const float* ssq; const bf16_t* Kb; const bf16_t* Vt; bf16_t* O;
    __device__ __forceinline__ void operator()(const f32x4 (&)[2][2][4][2], const Unit&, int, int, int, int) const {}
    __device__ __forceinline__ void fused(f32x4 (&acc)[2][2][4][2], const Unit& u, int wr, int wc, int fr, int fq, PG8_LAS unsigned char* lds, int wid, int lane) const {
        constexpr int RS = 528;
        const int tid = wid * 64 + lane, h = u.pn, b = u.pm >> 5;
        const unsigned r0 = (unsigned)tid >> 5, ch = (unsigned)tid & 31u;
        const bf16_t* kbase = Kb + (size_t)(b * 256) * D + h * 256; const bf16_t* vbase = Vt + ((size_t)b * D + h * 256) * NMEM;
        const unsigned goffk = r0 * (unsigned)(D * 2) + ch * 16u, goffv = r0 * (unsigned)(NMEM * 2) + ch * 16u, loff = r0 * (unsigned)RS + ch * 16u;
        unsigned loffa = loff, loffb = loff + 7 * 16 * RS; asm volatile("" : "+v"(loffa), "+v"(loffb));
#pragma unroll
        for (int ai = 0; ai < 2; ++ai)
#pragma unroll
            for (int m = 0; m < 4; ++m) { const int lr = ai * HALF + wr * 64 + m * 16 + fr; const float rs = row_rstd(ssq, u.pm * BM + lr, fq);
#pragma unroll
                for (int bj = 0; bj < 2; ++bj) *(PG8_LAS u32x4*)(lds + lr * RS + (bj * HALF + wc * 32 + 8 * fq) * 2) = pack8(acc[ai][bj][m][0] * rs, acc[ai][bj][m][1] * rs); }
        __syncthreads();
        bf16x8 qf[2][8];
#pragma unroll
        for (int qb = 0; qb < 2; ++qb)
#pragma unroll
            for (int ks = 0; ks < 8; ++ks) qf[qb][ks] = *(const PG8_LAS bf16x8*)(lds + (32 * wid + 16 * qb + fr) * RS + (32 * ks + 8 * fq) * 2);
        __builtin_amdgcn_sched_barrier(0);
        u32x4 tv[16];
#pragma unroll
        for (int i = 0; i < 16; ++i) tv[i] = *(const u32x4*)((const char*)kbase + (goffk + (unsigned)(i * 16 * D * 2)));
        __builtin_amdgcn_sched_barrier(0);
        __syncthreads();
#pragma unroll
        for (int i = 0; i < 16; ++i) *(PG8_LAS u32x4*)(lds + (i < 7 ? loffa : loffb) + (i < 7 ? i : i - 7) * 16 * RS) = tv[i];
        __syncthreads();
        unsigned fb0 = (unsigned)(fr * RS + fq * 16), fb1 = fb0 + 8 * 16 * RS; asm volatile("" : "+v"(fb0), "+v"(fb1));
        f32x4 S[2][16];
#pragma unroll
        for (int kb = 0; kb < 16; ++kb) { S[0][kb] = (f32x4){0.f, 0.f, 0.f, 0.f}; S[1][kb] = (f32x4){0.f, 0.f, 0.f, 0.f};
#pragma unroll
            for (int ks = 0; ks < 8; ++ks) { const bf16x8 kf = *(const PG8_LAS bf16x8*)(lds + (kb < 8 ? fb0 : fb1) + ((kb & 7) * 16 * RS + ks * 64));
                S[0][kb] = __builtin_amdgcn_mfma_f32_16x16x32_bf16(kf, qf[0][ks], S[0][kb], 0, 0, 0);
                S[1][kb] = __builtin_amdgcn_mfma_f32_16x16x32_bf16(kf, qf[1][ks], S[1][kb], 0, 0, 0); } }
        __builtin_amdgcn_sched_barrier(0);
        bf16x8 pf[2][8]; float inv[2];
#pragma unroll
        for (int qb = 0; qb < 2; ++qb) {
            float mx = -3.0e38f;
#pragma unroll
            for (int kb = 0; kb < 16; ++kb) mx = fmaxf(mx, fmaxf(fmaxf(S[qb][kb][0], S[qb][kb][1]), fmaxf(S[qb][kb][2], S[qb][kb][3])));
            mx = fmaxf(mx, __shfl_xor(mx, 16)); mx = fmaxf(mx, __shfl_xor(mx, 32));
            float l = 0.f;
#pragma unroll
            for (int kb = 0; kb < 16; ++kb)
#pragma unroll
                for (int j = 0; j < 4; ++j) { const float p = __builtin_amdgcn_exp2f(S[qb][kb][j] - mx); S[qb][kb][j] = p; l += p; }
            l += __shfl_xor(l, 16); l += __shfl_xor(l, 32); inv[qb] = 1.0f / l;
#pragma unroll
            for (int cc = 0; cc < 8; ++cc) { const u32x4 w = pack8(S[qb][2 * cc], S[qb][2 * cc + 1]); pf[qb][cc] = __builtin_bit_cast(bf16x8, w); }
        }
        __builtin_amdgcn_sched_barrier(0);
        unsigned loff2a = loff, loff2b = loff + 7 * 16 * RS; asm volatile("" : "+v"(loff2a), "+v"(loff2b));
#pragma unroll
        for (int i = 0; i < 16; ++i) tv[i] = *(const u32x4*)((const char*)vbase + (goffv + (unsigned)(i * 16 * NMEM * 2)));
        __builtin_amdgcn_sched_barrier(0);
        __syncthreads();
#pragma unroll
        for (int i = 0; i < 16; ++i) *(PG8_LAS u32x4*)(lds + (i < 7 ? loff2a : loff2b) + (i < 7 ? i : i - 7) * 16 * RS) = tv[i];
        __syncthreads();
        unsigned vb0 = (unsigned)(fr * RS + fq * 16), vb1 = vb0 + 8 * 16 * RS; asm volatile("" : "+v"(vb0), "+v"(vb1));
        bf16_t* orow = O + (size_t)(u.pm * BM + 32 * wid + fr) * D + h * 256 + 4 * fq;
#pragma unroll
        for (int db = 0; db < 16; ++db) { f32x4 o0 = (f32x4){0.f, 0.f, 0.f, 0.f}, o1 = (f32x4){0.f, 0.f, 0.f, 0.f};
#pragma unroll
            for (int cc = 0; cc < 8; ++cc) { const bf16x8 vf = *(const PG8_LAS bf16x8*)(lds + (db < 8 ? vb0 : vb1) + ((db & 7) * 16 * RS + cc * 64));
                o0 = __builtin_amdgcn_mfma_f32_16x16x32_bf16(vf, pf[0][cc], o0, 0, 0, 0); o1 = __builtin_amdgcn_mfma_f32_16x16x32_bf16(vf, pf[1][cc], o1, 0, 0, 0); }
            u32x2 w0, w1; w0.x = cvt_pk_bf16(o0[0] * inv[0], o0[1] * inv[0]); w0.y = cvt_pk_bf16(o0[2] * inv[0], o0[3] * inv[0]);
            w1.x = cvt_pk_bf16(o1[0] * inv[1], o1[1] * inv[1]); w1.y = cvt_pk_bf16(o1[2] * inv[1], o1[3] * inv[1]);
            *(u32x2*)(orow + 16 * db) = w0; *(u32x2*)(orow + (size_t)16 * D + 16 * db) = w1; }
        __syncthreads();
    }
};

__device__ __forceinline__ int lane_id_volatile() { int l; asm volatile("v_mbcnt_lo_u32_b32 %0, -1, 0\n\tv_mbcnt_hi_u32_b32 %0, -1, %0" : "=v"(l)); return l; }
#ifndef REP_P0
#define REP_P0 1
#endif
#ifndef REP_CONV
#define REP_CONV 1
#endif
#ifndef REP_SGU
#define REP_SGU 1
#endif
#ifndef REP_ATTN
#define REP_ATTN 1
#endif
#ifndef LSTART
#define LSTART 0
#endif
#ifndef LEND
#define LEND 2
#endif
__global__ void __launch_bounds__(NTHR, 2) fwd_kernel(Args a) {
    extern __shared__ __attribute__((aligned(16))) unsigned char lds_raw[];
    LAS unsigned char* lds = (LAS unsigned char*)lds_raw;
    volatile LAS unsigned* MISC = (volatile LAS unsigned*)(lds + MISC_OFF);
    const int wave = __builtin_amdgcn_readfirstlane((int)threadIdx.x >> 6);
#define TID() (wave * 64 + lane_id_volatile())
    const int tid = TID(), lane = tid & 63;
    const int G = gridDim.x, bx = blockIdx.x, vcu = (G % 8 == 0) ? (bx % 8) * (G / 8) + bx / 8 : bx;
    unsigned char* ws = a.ws;
    if (tid < 32) MISC[tid] = 0u;
    __syncthreads();
    XcdBarrier bar = xcd_barrier_post((unsigned*)(ws + WS_CTL), MISC + 8, tid);
    const int gw = vcu * NWAVES + wave, NGW = G * NWAVES;
    float* out = a.out; float* ssq = (float*)(ws + WS_SSQ); float* vst = (float*)(ws + WS_VST);
    bf16_t* HB = (bf16_t*)(ws + WS_HB); bf16_t* MB = (bf16_t*)(ws + WS_MB); bf16_t* BIG = (bf16_t*)(ws + WS_BIG);
    bf16_t* MEMN = (bf16_t*)(ws + WS_MEMN); bf16_t* KB = (bf16_t*)(ws + WS_KB); bf16_t* VT = (bf16_t*)(ws + WS_VT);
#define GRID_BAR() xcd_barrier(bar, TID())
#ifdef NO_GEMM
#define GEMM(EpiT, E, Ap, Bp, M_, N_, K_, cc) do {} while (0)
#else
#define GEMM(EpiT, E, Ap, Bp, M_, N_, K_, cc) do { Gemm g{(const bf16_t*)(Ap), (const bf16_t*)(Bp), (M_), (N_), (K_)}; int cc_ = (cc); asm volatile("" : "+s"(cc_)); StaticOrder S; S.init((M_), (N_), G, cc_); gemm_phase<EpiT, StaticOrder, true, true>(lds, g, S, (E), TID()); } while (0)
#endif

    _Pragma("unroll 1") for (int rep = 0; rep < REP_P0; ++rep) { if (rep) GRID_BAR(); p0_weights(a, 0, 0, lds, gw, NGW, wave, lane); p0_weights(a, 1, G == 256 ? 1 : 0, lds, gw, NGW, wave, lane); p0_prologue(a, lds, gw, NGW, wave, lane); }
    if (a.ws == nullptr) cg::this_grid().sync();
    GRID_BAR();

#pragma unroll
    for (int l = LSTART; l < LEND; ++l) {
        unsigned char* wl = ws + WS_W + (size_t)l * W_LAYER;
        if (l == 0) {
            { EpiScale E{BIG, DZ0, ssq}; GEMM(EpiScale, E, HB, wl + W_IN, T, DZ0, D, bx); }
#pragma unroll 1
            for (int l2 = 0; l2 < 2; ++l2) { EpiKV E{KB + (size_t)l2 * 512 * D, VT + (size_t)l2 * 2 * D * NMEM};
                const int c2 = (G - 1 - bx + (l2 ? G - 16 : 0)) % G;
                GEMM(EpiKV, E, MEMN + (size_t)l2 * 512 * D, ws + WS_W + (size_t)l2 * W_LAYER + W_KV, 512, 2 * D, D, c2); }
            if (G == 256 && bx >= 128 && bx < 224) { const int t3 = TID(); p0_weights(a, 1, 3, lds, (bx - 128) * NWAVES + wave, 96 * NWAVES, wave, t3 & 63); }
            GRID_BAR();
            _Pragma("unroll 1") for (int rep = 0; rep < REP_CONV; ++rep) { if (rep) GRID_BAR();
            conv_phase(lds, BIG, MB, a.in[8], a.in[9], a.in[10], a.in[11], a.in[12], a.in[13], G, bx, TID()); }
            GRID_BAR();
            { EpiRes E{HB, ssq}; GEMM(EpiRes, E, MB, wl + W_OUT, T, D, D, bx); }
        } else {
            { EpiZ1 E{BIG, ssq, vst}; GEMM(EpiZ1, E, HB, wl + W_IN, T, DZ1, D, bx); }
            GRID_BAR();
            _Pragma("unroll 1") for (int rep = 0; rep < REP_SGU; ++rep) { if (rep) GRID_BAR(); sgu_phase(lds, BIG, vst, (const bf16_t*)(ws + WS_WSB), a.in[19], a.in[16], a.in[17], MB, G, bx, TID()); }
            GRID_BAR();
            { EpiRes E{HB, ssq}; GEMM(EpiRes, E, MB, wl + W_OUT, T, D, D, bx); }
        }
        GRID_BAR();
        if (G == 256) {
            EpiQAttn E{ssq, KB + (size_t)l * 512 * D, VT + (size_t)l * 2 * D * NMEM, MB};
            Gemm g{HB, (const bf16_t*)(wl + W_Q), T, D, D}; int cc_ = bx; asm volatile("" : "+s"(cc_)); StaticOrder S; S.init(T, D, G, cc_); gemm_phase<EpiQAttn, StaticOrder, false, true>(lds, g, S, E, TID());
        } else {
        { EpiScale E{BIG, D, ssq}; GEMM(EpiScale, E, HB, wl + W_Q, T, D, D, bx); }
        GRID_BAR();
        _Pragma("unroll 1") for (int rep = 0; rep < REP_ATTN; ++rep) { if (rep) GRID_BAR(); attn_phase(lds, BIG, KB + (size_t)l * 512 * D, VT + (size_t)l * 2 * D * NMEM, MB, G, bx, TID()); }
        }
        GRID_BAR();
        { EpiRes E{HB, ssq}; GEMM(EpiRes, E, MB, wl + W_O, T, D, D, bx); }
        GRID_BAR();
        { EpiGU E{BIG, ssq}; GEMM(EpiGU, E, HB, wl + W_GU, T, NGU, D, bx); }
        if (l == 0 && G == 256 && bx >= 128) { const int t3 = TID(); p0_weights(a, 1, 4, lds, (bx - 128) * NWAVES + wave, 128 * NWAVES, wave, t3 & 63); }
        GRID_BAR();
        { EpiRes E{HB, ssq}; GEMM(EpiRes, E, BIG, wl + W_DN, T, D, DFF, bx); }
        GRID_BAR();
    }
    { int t2 = TID(); asm volatile("" : "+v"(t2)); const int lane = t2 & 63, gw = vcu * NWAVES + __builtin_amdgcn_readfirstlane(t2 >> 6);
      const f32x4 g0 = *(const f32x4*)(a.in[6] + 8 * lane), g1 = *(const f32x4*)(a.in[6] + 8 * lane + 4), g2 = *(const f32x4*)(a.in[6] + 512 + 8 * lane), g3 = *(const f32x4*)(a.in[6] + 512 + 8 * lane + 4);
      for (int m0 = gw * 4; m0 < T; m0 += NGW * 4) {
          u32x4 r0[4], r1[4];
#pragma unroll
          for (int r = 0; r < 4; ++r) { const bf16_t* p = HB + (size_t)(m0 + r) * D + 8 * lane; r0[r] = *(const u32x4*)p; r1[r] = *(const u32x4*)(p + 512); }
          __builtin_amdgcn_sched_barrier(0);
#pragma unroll
          for (int r = 0; r < 4; ++r) { float v[8], w[8]; unpack8(r0[r], v); unpack8(r1[r], w); float sq = 0.f;
#pragma unroll
              for (int j = 0; j < 8; ++j) sq += v[j] * v[j] + w[j] * w[j];
              const float rs = rsqrtf(wave_sum(sq) * (1.0f / 1024.0f) + RMS_EPS);
              float* o = out + (size_t)(m0 + r) * D + 8 * lane;
              *(f32x4*)o = (f32x4){v[0], v[1], v[2], v[3]} * rs * g0; *(f32x4*)(o + 4) = (f32x4){v[4], v[5], v[6], v[7]} * rs * g1;
              *(f32x4*)(o + 512) = (f32x4){w[0], w[1], w[2], w[3]} * rs * g2; *(f32x4*)(o + 516) = (f32x4){w[4], w[5], w[6], w[7]} * rs * g3; } } }
}

extern "C" void kernel_launch(void* const* d_in, const int* in_sizes, int n_in, void* d_out, int out_size, void* d_ws, size_t ws_size, hipStream_t stream) {
    static int grid = 0;
    if (grid == 0) {
        if (n_in != 28 || out_size != T * D || ws_size < WS_END) { fprintf(stderr, "kernel_launch: unexpected shapes (n_in %d out %d ws %zu)\n", n_in, out_size, ws_size); grid = -1; return; }
        int dev = 0, cus = 0, per_cu = 0;
        (void)hipGetDevice(&dev); (void)hipDeviceGetAttribute(&cus, hipDeviceAttributeMultiprocessorCount, dev);
        (void)hipFuncSetAttribute((const void*)fwd_kernel, hipFuncAttributeMaxDynamicSharedMemorySize, LDS_BYTES);
        (void)hipOccupancyMaxActiveBlocksPerMultiprocessor(&per_cu, (const void*)fwd_kernel, NTHR, LDS_BYTES);
        if (per_cu < 1) per_cu = 1;
        (void)hipGetLastError();
        grid = cus;
        if (grid % 8 != 0 || grid < 64) fprintf(stderr, "kernel_launch: unusual CU count %d\n", grid);
    }
    if (grid < 0) return;
    (void)hipMemsetAsync((char*)d_ws + WS_CTL, 0, CTL_ZERO_BYTES, stream);
    Args a{};
    for (int i = 0; i < 28; ++i) a.in[i] = (const float*)d_in[i];
    a.out = (float*)d_out; a.ws = (unsigned char*)d_ws;
    void* args[] = {&a};
    hipError_t e = hipLaunchCooperativeKernel((const void*)fwd_kernel, dim3(grid), dim3(NTHR), args, LDS_BYTES, stream);
    if (e != hipSuccess) fprintf(stderr, "cooperative launch failed: %s (grid %d)\n", hipGetErrorString(e), grid);
}
```

```cpp
#include <hip/hip_runtime.h>
#include <hip/hip_cooperative_groups.h>
#include <cstdio>
#include <cstdint>
namespace cg = cooperative_groups;
namespace pg8 {
#define PG8_LAS __attribute__((address_space(3)))
typedef unsigned short bf16_t;
typedef short bf16x8 __attribute__((ext_vector_type(8)));
typedef float f32x4 __attribute__((ext_vector_type(4)));
typedef unsigned u32x4 __attribute__((ext_vector_type(4)));
constexpr int BM = 256, BK = 64, HALF = 128, HTB = HALF * BK * 2  , STAGE_BYTES = 8 * HTB, NXCD = 8, WGM = 8;

__host__ __device__ __forceinline__ int lds_byte(int r, int c) { const int st = (r >> 4) * 2 + (c >> 5), rr = r & 15, cc = c & 31, ob = rr * 64 + cc * 2; return st * 1024 + (ob ^ (((ob >> 9) & 1) << 5)); }
__host__ __device__ __forceinline__ void stage_rc(int b, int& R, int& C) { const int st = b / 1024, sb = b % 1024, swz = sb ^ (((sb >> 9) & 1) << 5); R = (st >> 1) * 16 + swz / 64; C = (st & 1) * 32 + (swz % 64) / 2; }
__host__ __device__ __forceinline__ int perm32(int rho) { const int n = rho >> 4, i = rho & 15; return 8 * (i >> 2) + 4 * n + (i & 3); }

struct Unit { int pm, pn; };
struct Gemm { const bf16_t* A; const bf16_t* Bt; int M, N, K; };

struct StaticOrder {
    int nM, nN, nwg, G, c;
    __host__ __device__ void init(int M, int N, int G_, int c_) { nM = M / BM; nN = N / BM; nwg = nM * nN; G = G_; c = c_; }
    __host__ __device__ bool next(int i, Unit& u) const {
        const long L = (long)i * G + c; if (L >= nwg) return false;
        int wgid = (int)L; { const int q = nwg / NXCD, r = nwg % NXCD, xcd = wgid % NXCD, off = wgid / NXCD; wgid = (xcd < r ? xcd * (q + 1) : r * (q + 1) + (xcd - r) * q) + off; }
        const int nig = WGM * nN, gid = wgid / nig, fm = gid * WGM, gsz = (nM - fm) < WGM ? (nM - fm) : WGM;
        u.pm = fm + ((wgid % nig) % gsz); u.pn = (wgid % nig) / gsz; return true;
    }
    __device__ __forceinline__ void a_ready(const Unit&) const {}
    __device__ __forceinline__ void done(const Unit&) const {}
};

__device__ __forceinline__ unsigned cvt_pk_bf16(float lo, float hi) { unsigned r; asm volatile("v_cvt_pk_bf16_f32 %0, %1, %2" : "=v"(r) : "v"(lo), "v"(hi)); return r; }
typedef float f32x2 __attribute__((ext_vector_type(2)));
template <class Epi, class Sched, bool ALIGN_EPI = false, bool SP2 = false>
__device__ __forceinline__ void gemm_phase(PG8_LAS unsigned char* lds, const Gemm g, const Sched& S, const Epi& E, int tid_in) {
    int tid_ = tid_in; asm volatile("" : "+v"(tid_));
    const int tid = tid_, wid = __builtin_amdgcn_readfirstlane(tid >> 6), lane = tid & 63, wr = wid >> 2, wc = wid & 3, fr = lane & 15, fq = lane >> 4;
    const int K = g.K, nt = K / BK;
    unsigned voffA[2], voffB[2];
#pragma unroll
    for (int i = 0; i < 2; ++i) { int R, C; stage_rc(tid * 16 + i * 8192, R, C); const int Rb = Epi::PERM ? ((R & ~31) + perm32(R & 31)) : R;
        voffA[i] = (unsigned)(R * K + C) * 2u; voffB[i] = (unsigned)(Rb * K + C) * 2u; }
    const size_t kstep = (size_t)(BK * 2);
    const size_t hstep = (size_t)HALF * K * 2;
    const size_t tstep = 2 * hstep;
    const unsigned ldsw = (unsigned)wid * 1024u;
    const int aoff = lds_byte(wr * 64 + fr, fq * 8), boff = lds_byte(wc * 32 + fr, fq * 8);
#define PG8_SA(b, h) (((b) * 2 + (h)) * HTB)
#define PG8_SB(b, h) ((4 + (b) * 2 + (h)) * HTB)
#define PG8_STAGE(bufoff, gbase, voff) do { _Pragma("unroll") for (int _i = 0; _i < 2; ++_i) \
        __builtin_amdgcn_global_load_lds((const unsigned*)((const char*)(gbase) + (voff)[_i]), (PG8_LAS unsigned*)(lds + (bufoff) + ldsw + _i * 8192), 16, 0, 0); } while (0)
#define PG8_LDA(dst, b, h) do { _Pragma("unroll") for (int m = 0; m < 4; ++m) _Pragma("unroll") for (int k = 0; k < 2; ++k) dst[m][k] = *(const PG8_LAS bf16x8*)(lds + PG8_SA(b, h) + aoff + m * 2048 + k * 1024); } while (0)
#define PG8_LDB(dst, b, h) do { _Pragma("unroll") for (int n = 0; n < 2; ++n) _Pragma("unroll") for (int k = 0; k < 2; ++k) dst[n][k] = *(const PG8_LAS bf16x8*)(lds + PG8_SB(b, h) + boff + n * 2048 + k * 1024); } while (0)
#define PG8_MMA(ai, bj, At, Bt) do { __builtin_amdgcn_s_setprio(1); _Pragma("unroll") for (int m = 0; m < 4; ++m) _Pragma("unroll") for (int n = 0; n < 2; ++n) _Pragma("unroll") for (int k = 0; k < 2; ++k) \
        acc[ai][bj][m][n] = __builtin_amdgcn_mfma_f32_16x16x32_bf16(Bt[n][k], At[m][k], acc[ai][bj][m][n], 0, 0, 0); __builtin_amdgcn_s_setprio(0); } while (0)
#define PG8_WAIT_V(n) asm volatile("s_waitcnt vmcnt(" #n ")" ::: "memory")
#define PG8_WAIT_L(n) asm volatile("s_waitcnt lgkmcnt(" #n ")" ::: "memory")
#define PG8_BAR __builtin_amdgcn_s_barrier()
#define PG8_SCHED __builtin_amdgcn_sched_barrier(0)
    Unit cur, nxt; int ui = 0;
    if (!S.next(0, cur)) return;
    f32x4 acc[2][2][4][2];
#pragma unroll
    for (int a = 0; a < 2; ++a)
#pragma unroll
        for (int b = 0; b < 2; ++b)
#pragma unroll
            for (int m = 0; m < 4; ++m)
#pragma unroll
                for (int n = 0; n < 2; ++n) acc[a][b][m][n] = (f32x4){0.f, 0.f, 0.f, 0.f};
    bf16x8 At[4][2], B0[2][2], B1[2][2];
    const char* cA = (const char*)g.A + (size_t)cur.pm * tstep; const char* cB = (const char*)g.Bt + (size_t)cur.pn * tstep;
    S.a_ready(cur);
    if constexpr (SP2) {
        PG8_STAGE(PG8_SB(0, 0), cB, voffB); PG8_STAGE(PG8_SB(0, 1), cB + hstep, voffB); PG8_STAGE(PG8_SA(0, 0), cA, voffA); PG8_STAGE(PG8_SA(0, 1), cA + hstep, voffA);
        if (wr == 1) PG8_BAR;
        PG8_WAIT_V(2); PG8_BAR;
        PG8_STAGE(PG8_SB(1, 0), cB + kstep, voffB); PG8_STAGE(PG8_SA(1, 0), cA + kstep, voffA); PG8_STAGE(PG8_SB(1, 1), cB + hstep + kstep, voffB);
        PG8_WAIT_V(6); PG8_BAR;
    } else {
        PG8_STAGE(PG8_SB(0, 0), cB, voffB); PG8_STAGE(PG8_SA(0, 0), cA, voffA); PG8_STAGE(PG8_SB(0, 1), cB + hstep, voffB); PG8_STAGE(PG8_SA(0, 1), cA + hstep, voffA);
        if (wr == 1) PG8_BAR;
        PG8_WAIT_V(4); PG8_BAR;
        PG8_STAGE(PG8_SB(1, 0), cB + kstep, voffB); PG8_STAGE(PG8_SA(1, 0), cA + kstep, voffA); PG8_STAGE(PG8_SB(1, 1), cB + hstep + kstep, voffB);
        PG8_WAIT_V(6); PG8_BAR;
    }
    for (;;) {
        const bool has_next = S.next(ui + 1, nxt);
        const char* nA = has_next ? (const char*)g.A + (size_t)nxt.pm * tstep : cA; const char* nB = has_next ? (const char*)g.Bt + (size_t)nxt.pn * tstep : cB;
        for (int t = 0; t < nt; t += 2) {
            const bool last = (t == nt - 2);
            const char* a1 = cA + (size_t)(t + 1) * kstep;
            const char* a2 = last ? nA : cA + (size_t)(t + 2) * kstep; const char* b2 = last ? nB : cB + (size_t)(t + 2) * kstep;
            const char* a3 = a2 + kstep; const char* b3 = b2 + kstep;
            if (last && has_next) S.a_ready(nxt);
            if constexpr (SP2) {
            PG8_LDB(B0, 0, 0); PG8_LDB(B1, 0, 1); PG8_SCHED; PG8_LDA(At, 0, 0); PG8_STAGE(PG8_SA(1, 1), a1 + hstep, voffA);
            PG8_WAIT_V(8); PG8_WAIT_L(0); PG8_BAR; PG8_MMA(0, 0, At, B0); PG8_MMA(0, 1, At, B1); PG8_BAR; PG8_SCHED;
            PG8_LDA(At, 0, 1); PG8_STAGE(PG8_SB(0, 0), b2, voffB); PG8_STAGE(PG8_SB(0, 1), b2 + hstep, voffB); PG8_STAGE(PG8_SA(0, 0), a2, voffA);
            PG8_WAIT_V(8); PG8_WAIT_L(0); PG8_BAR; PG8_MMA(1, 0, At, B0); PG8_MMA(1, 1, At, B1); PG8_BAR; PG8_SCHED;
            PG8_LDB(B0, 1, 0); PG8_LDB(B1, 1, 1); PG8_SCHED; PG8_LDA(At, 1, 0); PG8_STAGE(PG8_SA(0, 1), a2 + hstep, voffA);
            PG8_WAIT_V(8); PG8_WAIT_L(0); PG8_BAR; PG8_MMA(0, 0, At, B0); PG8_MMA(0, 1, At, B1); PG8_BAR; PG8_SCHED;
            PG8_LDA(At, 1, 1); PG8_STAGE(PG8_SB(1, 0), b3, voffB); PG8_STAGE(PG8_SB(1, 1), b3 + hstep, voffB); PG8_STAGE(PG8_SA(1, 0), a3, voffA);
            PG8_WAIT_V(8); PG8_WAIT_L(0); PG8_BAR; PG8_MMA(1, 0, At, B0); PG8_MMA(1, 1, At, B1); PG8_BAR; PG8_SCHED;
            } else {
            PG8_LDB(B0, 0, 0); PG8_SCHED; PG8_LDA(At, 0, 0); PG8_STAGE(PG8_SA(1, 1), a1 + hstep, voffA);
            PG8_WAIT_L(8); PG8_BAR; PG8_WAIT_L(0); PG8_MMA(0, 0, At, B0); PG8_BAR; PG8_SCHED;
            PG8_LDB(B1, 0, 1); PG8_STAGE(PG8_SB(0, 0), b2, voffB);
            PG8_BAR; PG8_WAIT_L(0); PG8_MMA(0, 1, At, B1); PG8_BAR;
            PG8_LDA(At, 0, 1); PG8_STAGE(PG8_SA(0, 0), a2, voffA);
            PG8_BAR; PG8_WAIT_L(0); PG8_MMA(1, 0, At, B0); PG8_BAR; PG8_SCHED;
            PG8_STAGE(PG8_SB(0, 1), b2 + hstep, voffB);
            PG8_WAIT_V(6); PG8_BAR; PG8_MMA(1, 1, At, B1); PG8_BAR;
            PG8_LDB(B0, 1, 0); PG8_SCHED; PG8_LDA(At, 1, 0); PG8_STAGE(PG8_SA(0, 1), a2 + hstep, voffA);
            PG8_WAIT_L(8); PG8_BAR; PG8_WAIT_L(0); PG8_MMA(0, 0, At, B0); PG8_BAR; PG8_SCHED;
            PG8_LDB(B1, 1, 1); PG8_STAGE(PG8_SB(1, 0), b3, voffB);
            PG8_BAR; PG8_WAIT_L(0); PG8_MMA(0, 1, At, B1); PG8_BAR;
            PG8_LDA(At, 1, 1); PG8_STAGE(PG8_SA(1, 0), a3, voffA);
            PG8_BAR; PG8_WAIT_L(0); PG8_MMA(1, 0, At, B0); PG8_BAR; PG8_SCHED;
            PG8_STAGE(PG8_SB(1, 1), b3 + hstep, voffB);
            PG8_WAIT_V(6); PG8_BAR; PG8_MMA(1, 1, At, B1); PG8_BAR;
            }
        }
        if constexpr (ALIGN_EPI) { if (wr == 0) PG8_BAR; }
        if constexpr (!Epi::AFTER_DRAIN) { E(acc, cur, wr, wc, fr, fq); S.done(cur); }
        if (!has_next) break;
#pragma unroll
        for (int a = 0; a < 2; ++a)
#pragma unroll
            for (int b = 0; b < 2; ++b)
#pragma unroll
                for (int m = 0; m < 4; ++m)
#pragma unroll
                    for (int n = 0; n < 2; ++n) acc[a][b][m][n] = (f32x4){0.f, 0.f, 0.f, 0.f};
        cur = nxt; cA = nA; cB = nB; ++ui;
        if constexpr (ALIGN_EPI) { if (wr == 1) PG8_BAR; }
    }
    PG8_WAIT_V(0);
    if constexpr (!ALIGN_EPI) { if (wr == 0) PG8_BAR; }
    PG8_BAR;
    if constexpr (Epi::AFTER_DRAIN) { E.fused(acc, cur, wr, wc, fr, fq, lds, wid, lane); S.done(cur); }
#undef PG8_SA
#undef PG8_SB
#undef PG8_STAGE
#undef PG8_LDA
#undef PG8_LDB
#undef PG8_MMA
#undef PG8_WAIT_V
#undef PG8_WAIT_L
#undef PG8_BAR
#undef PG8_SCHED
}
}
#define LAS __attribute__((address_space(3)))
#define XB_TMO      128
#define XB_XCNT(j)  (256  + 64 * (j))
#define XB_XSUB(j)  (1280 + 64 * (j))
#define XB_XGEN(j)  (2304 + 64 * (j))
#define XB_TOP      3328
#define XB_TOPGEN   3392
#define XCD_BAR_WORDS 3456
#define XB_SPIN_CAP (1u << 18)

__device__ __forceinline__ unsigned xb_ld(unsigned* p)              { return __hip_atomic_load(p, __ATOMIC_RELAXED, __HIP_MEMORY_SCOPE_AGENT); }
__device__ __forceinline__ unsigned xb_add(unsigned* p, unsigned v) { return __hip_atomic_fetch_add(p, v, __ATOMIC_RELAXED, __HIP_MEMORY_SCOPE_AGENT); }
__device__ __forceinline__ unsigned xb_xcc_id() { return (unsigned)__builtin_amdgcn_s_getreg((3 << 11) | 20) & 0xFu; }
#define XB_SPIN(cond, bar) do { unsigned _sp = 0; while (cond) { __builtin_amdgcn_s_sleep(1); \
    if ((++_sp & 255u) == 0u) { if (xb_ld(&(bar)[XB_TMO])) break; if (_sp > XB_SPIN_CAP) { atomicAdd(&(bar)[XB_TMO], 1u); break; } } } } while (0)

struct XcdBarrier {
    unsigned* bar; unsigned x;
    volatile LAS unsigned* st;
};

__device__ __forceinline__ XcdBarrier xcd_barrier_post(unsigned* bar, volatile LAS unsigned* st, int ktid) {
    XcdBarrier b; b.bar = bar; b.x = xb_xcc_id(); b.st = st;
    if (ktid == 0) (void)xb_add(&bar[XB_XCNT(b.x)], 1u);
    return b;
}
__device__ __forceinline__ void xcd_barrier_complete(unsigned* bar, unsigned x, unsigned& nloc, unsigned& nx) {
    const unsigned G = gridDim.x * gridDim.y * gridDim.z;
    unsigned sum, cnt, mine, sp = 0u;
    for (;;) {
        sum = 0u; cnt = 0u; mine = 0u;
#pragma unroll
        for (unsigned j = 0; j < 16; ++j) { const unsigned c = xb_ld(&bar[XB_XCNT(j)]); sum += c; cnt += (c > 0u) ? 1u : 0u; mine = (j == x) ? c : mine; }
        if (sum == G) break;
        __builtin_amdgcn_s_sleep(1);
        if ((++sp & 255u) == 0u) { if (xb_ld(&bar[XB_TMO])) break; if (sp > XB_SPIN_CAP) { atomicAdd(&bar[XB_TMO], 1u); break; } }
    }
    nloc = mine > 0u ? mine : 1u; nx = cnt > 0u ? cnt : 1u;
}

__device__ __forceinline__ void xcd_barrier(const XcdBarrier& b, int ktid) {
    asm volatile("s_waitcnt vmcnt(0)" ::: "memory");
    __syncthreads();
    if (ktid == 0) {
        unsigned* bar = b.bar; const unsigned bx_ = xb_xcc_id();
        __builtin_amdgcn_s_waitcnt(0);
        unsigned nloc = b.st[0], nx = b.st[1];
        if (nloc == 0u) { xcd_barrier_complete(bar, bx_, nloc, nx); b.st[0] = nloc; b.st[1] = nx; }
        const unsigned old = xb_add(&bar[XB_XSUB(bx_)], 1u);
        const unsigned gen = old / nloc;
        if (old + 1u == (gen + 1u) * nloc) {
            __builtin_amdgcn_fence(__ATOMIC_RELEASE, "agent");
            asm volatile("s_waitcnt vmcnt(0)" ::: "memory");
            const unsigned og = xb_add(&bar[XB_TOP], 1u);
            const unsigned tg = og / nx;
            if (og + 1u == (tg + 1u) * nx) xb_add(&bar[XB_TOPGEN], 1u);
            else XB_SPIN(xb_ld(&bar[XB_TOPGEN]) == tg, bar);
            __builtin_amdgcn_fence(__ATOMIC_ACQUIRE, "agent");
            xb_add(&bar[XB_XGEN(bx_)], 1u);
            asm volatile("s_waitcnt vmcnt(0)" ::: "memory");
        } else {
            XB_SPIN(xb_ld(&bar[XB_XGEN(bx_)]) == gen, bar);
            __builtin_amdgcn_fence(__ATOMIC_ACQUIRE, "agent");
            asm volatile("s_waitcnt vmcnt(0)" ::: "memory");
        }
    }
    __syncthreads();
}
#undef LAS
using namespace pg8;
#define LAS __attribute__((address_space(3)))
typedef unsigned u32x2 __attribute__((ext_vector_type(2)));

constexpr int NWAVES = 8, NTHR = 512;
constexpr int SEQ = 8192, NBATCH = 2, T = NBATCH * SEQ, D = 1024, DZ0 = 2560, DZ1 = 2048, DFF = 2816, NGU = 2 * DFF, NMEM = 256;
constexpr float RMS_EPS = 1e-6f, LN_EPS = 1e-5f;
constexpr size_t MiB = 1u << 20;
constexpr size_t WS_CTL = 0, CTL_ZERO_BYTES = 64 * 1024;
constexpr size_t WS_W = 2 * MiB, W_LAYER = 32 * MiB;
constexpr size_t W_IN = 0, W_OUT = 5 * MiB, W_Q = 7 * MiB, W_KV = 9 * MiB, W_O = 13 * MiB, W_GU = 15 * MiB, W_DN = 26 * MiB;
constexpr size_t WS_WSB = 66 * MiB;
constexpr size_t WS_SSQ = 67 * MiB;
constexpr size_t WS_VST = 68 * MiB;
constexpr size_t WS_MEMN = 70 * MiB;
constexpr size_t WS_KB = 72 * MiB;
constexpr size_t WS_VT = 74 * MiB;
constexpr size_t WS_HB = 76 * MiB;
constexpr size_t WS_MB = 108 * MiB;
constexpr size_t WS_BIG = 140 * MiB;
constexpr size_t WS_END = 228 * MiB;
constexpr int LDS_BYTES = 147456, MISC_OFF = 139264;

__device__ __forceinline__ float wave_sum(float v) {
#pragma unroll
    for (int o = 1; o < 64; o <<= 1) v += __shfl_xor(v, o);
    return v;
}
__device__ __forceinline__ float bf2f(unsigned short b) { return __uint_as_float((unsigned)b << 16); }
__device__ __forceinline__ float bflo(unsigned w) { return __uint_as_float(w << 16); }
__device__ __forceinline__ float bfhi(unsigned w) { return __uint_as_float(w & 0xffff0000u); }
__device__ __forceinline__ unsigned short f2bf(float f) { return (unsigned short)(cvt_pk_bf16(f, 0.f) & 0xffffu); }
__device__ __forceinline__ float sigm(float x) { return __builtin_amdgcn_rcpf(1.f + __builtin_amdgcn_exp2f(-1.44269504f * x)); }
__device__ __forceinline__ float gelu_tanh(float x) { const float y = 1.5957691216f * (x + 0.044715f * x * x * x); return x * sigm(y); }

__device__ __forceinline__ float row_rstd(const float* ssq, int row, int fq) {
    const f32x4 a = *(const f32x4*)(ssq + (size_t)row * 16 + 4 * fq);
    float s = (a[0] + a[1]) + (a[2] + a[3]);
    s += __shfl_xor(s, 16); s += __shfl_xor(s, 32);
    return rsqrtf(s * (1.0f / 1024.0f) + RMS_EPS);
}
__device__ __forceinline__ u32x4 pack8(const f32x4 v0, const f32x4 v1) { u32x4 w; w.x = cvt_pk_bf16(v0[0], v0[1]); w.y = cvt_pk_bf16(v0[2], v0[3]); w.z = cvt_pk_bf16(v1[0], v1[1]); w.w = cvt_pk_bf16(v1[2], v1[3]); return w; }

struct EpiScale {
    static constexpr bool PERM = true, AFTER_DRAIN = false;
    bf16_t* O; int ldc; const float* ssq;
    __device__ __forceinline__ void operator()(const f32x4 (&acc)[2][2][4][2], const Unit& u, int wr, int wc, int fr, int fq) const {
        const int row0 = u.pm * BM + wr * 64 + fr, col0 = u.pn * BM + wc * 32 + 8 * fq;
#pragma unroll
        for (int ai = 0; ai < 2; ++ai)
#pragma unroll
            for (int m = 0; m < 4; ++m) { const int row = row0 + ai * HALF + m * 16; const float rs = ssq ? row_rstd(ssq, row, fq) : 1.f; bf16_t* rowp = O + (size_t)row * ldc + col0;
#pragma unroll
                for (int bj = 0; bj < 2; ++bj) *(u32x4*)(rowp + bj * HALF) = pack8(acc[ai][bj][m][0] * rs, acc[ai][bj][m][1] * rs); }
    }
};
struct EpiRes {
    static constexpr bool PERM = true, AFTER_DRAIN = false;
    bf16_t* hb; float* ssq;
    __device__ __forceinline__ void operator()(const f32x4 (&acc)[2][2][4][2], const Unit& u, int wr, int wc, int fr, int fq) const {
        const int row0 = u.pm * BM + wr * 64 + fr, col0 = u.pn * BM + wc * 32 + 8 * fq;
#pragma unroll
        for (int ai = 0; ai < 2; ++ai)
#pragma unroll
            for (int m = 0; m < 4; ++m) { const int row = row0 + ai * HALF + m * 16; const size_t off = (size_t)row * D + col0; float q = 0.f;
#pragma unroll
                for (int bj = 0; bj < 2; ++bj) { const u32x4 bb = *(const u32x4*)(hb + off + bj * HALF);
                    const f32x4 b0 = (f32x4){bflo(bb.x), bfhi(bb.x), bflo(bb.y), bfhi(bb.y)}, b1 = (f32x4){bflo(bb.z), bfhi(bb.z), bflo(bb.w), bfhi(bb.w)};
                    const f32x4 v0 = b0 + acc[ai][bj][m][0], v1 = b1 + acc[ai][bj][m][1];
                    *(u32x4*)(hb + off + bj * HALF) = pack8(v0, v1);
                    q += ((v0[0] * v0[0] + v0[1] * v0[1]) + (v0[2] * v0[2] + v0[3] * v0[3])) + ((v1[0] * v1[0] + v1[1] * v1[1]) + (v1[2] * v1[2] + v1[3] * v1[3])); }
                q += __shfl_xor(q, 16); q += __shfl_xor(q, 32);
                if (fq == 0) ssq[(size_t)row * 16 + u.pn * 4 + wc] = q; }
    }
};
struct EpiGU {
    static constexpr bool PERM = true, AFTER_DRAIN = false;
    bf16_t* O; const float* ssq;
    __device__ __forceinline__ void operator()(const f32x4 (&acc)[2][2][4][2], const Unit& u, int wr, int wc, int fr, int fq) const {
        const int row0 = u.pm * BM + wr * 64 + fr, col0 = u.pn * HALF + wc * 32 + 8 * fq;
#pragma unroll
        for (int ai = 0; ai < 2; ++ai)
#pragma unroll
            for (int m = 0; m < 4; ++m) { const int row = row0 + ai * HALF + m * 16; const float rs = row_rstd(ssq, row, fq);
                f32x4 h[2];
#pragma unroll
                for (int n = 0; n < 2; ++n)
#pragma unroll
                    for (int j = 0; j < 4; ++j) { const float g = acc[ai][0][m][n][j] * rs, up = acc[ai][1][m][n][j] * rs; h[n][j] = g * sigm(g) * up; }
                *(u32x4*)(O + (size_t)row * DFF + col0) = pack8(h[0], h[1]); }
    }
};
struct EpiZ1 {
    static constexpr bool PERM = true, AFTER_DRAIN = false;
    bf16_t* O; const float* ssq; float* vst;
    __device__ __forceinline__ void operator()(const f32x4 (&acc)[2][2][4][2], const Unit& u, int wr, int wc, int fr, int fq) const {
        const int row0 = u.pm * BM + wr * 64 + fr, col0 = u.pn * BM + wc * 32 + 8 * fq;
#pragma unroll
        for (int ai = 0; ai < 2; ++ai)
#pragma unroll
            for (int m = 0; m < 4; ++m) { const int row = row0 + ai * HALF + m * 16; const float rs = row_rstd(ssq, row, fq); bf16_t* rowp = O + (size_t)row * DZ1 + col0; float s = 0.f, q = 0.f;
#pragma unroll
                for (int bj = 0; bj < 2; ++bj) { f32x4 v[2];
#pragma unroll
                    for (int n = 0; n < 2; ++n)
#pragma unroll
                        for (int j = 0; j < 4; ++j) { const float g = gelu_tanh(acc[ai][bj][m][n][j] * rs); v[n][j] = g; s += g; q += g * g; }
                    *(u32x4*)(rowp + bj * HALF) = pack8(v[0], v[1]); }
                if (u.pn >= 4) { s += __shfl_xor(s, 16); s += __shfl_xor(s, 32); q += __shfl_xor(q, 16); q += __shfl_xor(q, 32);
                    if (fq == 0) { float* p = vst + ((size_t)row * 16 + (u.pn - 4) * 4 + wc) * 2; p[0] = s; p[1] = q; } } }
    }
};
struct EpiKV {
    static constexpr bool PERM = true, AFTER_DRAIN = false;
    bf16_t* Kb; bf16_t* Vt;
    __device__ __forceinline__ void operator()(const f32x4 (&acc)[2][2][4][2], const Unit& u, int wr, int wc, int fr, int fq) const {
        const int col0 = (u.pn & 3) * BM + wc * 32 + 8 * fq;
#pragma unroll
        for (int ai = 0; ai < 2; ++ai)
#pragma unroll
            for (int m = 0; m < 4; ++m) { const int key = ai * HALF + wr * 64 + m * 16 + fr;
                if (u.pn < 4) { bf16_t* rowp = Kb + (size_t)(u.pm * BM + key) * D + col0;
#pragma unroll
                    for (int bj = 0; bj < 2; ++bj) *(u32x4*)(rowp + bj * HALF) = pack8(acc[ai][bj][m][0], acc[ai][bj][m][1]);
                } else { const int kp = (key & ~31) + 8 * ((key >> 2) & 3) + 4 * ((key >> 4) & 1) + (key & 3);
#pragma unroll
                    for (int bj = 0; bj < 2; ++bj)
#pragma unroll
                        for (int n = 0; n < 2; ++n)
#pragma unroll
                            for (int j = 0; j < 4; ++j) Vt[((size_t)u.pm * D + col0 + bj * HALF + 4 * n + j) * NMEM + kp] = f2bf(acc[ai][bj][m][n][j]); } }
    }
};

__device__ __forceinline__ void tr_item(const float* W, int K, int N, bf16_t* WT, const float* g, float cs, int mode, LAS float* scr, int item, int lane) {
    const int nblk = N / 64, kb = item / nblk, nb = item % nblk, k0 = 64 * kb, n0 = 64 * nb;
    const int orow = mode == 0 ? n0 : ((n0 >> 7) * 256 + (n0 & 127) + (mode == 2 ? 128 : 0));
    const int kq = lane >> 4, n4 = (lane & 15) * 4;
    f32x4 v[16]; float sc[16];
#pragma unroll
    for (int i = 0; i < 16; ++i) { const int kk = 4 * i + kq; v[i] = *(const f32x4*)(W + (size_t)(k0 + kk) * N + n0 + n4); sc[i] = g ? g[k0 + kk] * cs : cs; }
    __builtin_amdgcn_sched_barrier(0);
#pragma unroll
    for (int i = 0; i < 16; ++i) { const int kk = 4 * i + kq; LAS float* d = scr + kk * 65 + n4; d[0] = v[i][0] * sc[i]; d[1] = v[i][1] * sc[i]; d[2] = v[i][2] * sc[i]; d[3] = v[i][3] * sc[i]; }
    asm volatile("s_waitcnt lgkmcnt(0)" ::: "memory");
    const int c = lane & 7;
#pragma unroll
    for (int j = 0; j < 8; ++j) { const int n = (lane >> 3) + 8 * j; const LAS float* p = scr + (8 * c) * 65 + n;
        u32x4 o; o.x = cvt_pk_bf16(p[0 * 65], p[1 * 65]); o.y = cvt_pk_bf16(p[2 * 65], p[3 * 65]); o.z = cvt_pk_bf16(p[4 * 65], p[5 * 65]); o.w = cvt_pk_bf16(p[6 * 65], p[7 * 65]);
        *(u32x4*)(WT + (size_t)(orow + n) * K + k0 + 8 * c) = o; }
    asm volatile("s_waitcnt lgkmcnt(0)" ::: "memory");
}

struct Args { const float* in[28]; float* out; unsigned char* ws; };

__device__ __forceinline__ void p0_weights(const Args& a, int l, int part, LAS unsigned char* lds, int gw, int NGW, int wave, int lane) {
    unsigned char* ws = a.ws;
    LAS float* scr = (LAS float*)(lds + wave * 16640);
    const float QS = 0.0625f * 1.44269504f;
    const int NIN = l ? DZ1 : DZ0, I_IN = 16 * (NIN / 64);
    constexpr int I_SQ = 16 * 16, I_GU = 16 * (DFF / 64), I_DN = (DFF / 64) * 16;
    const int I_KV = (part == 0 || part == 1) ? I_SQ : 0, I_A = (part == 0 || part == 3) ? I_IN : 0, I_S = (part == 0 || part == 3) ? I_SQ : 0, I_G = (part == 0 || part == 4) ? I_GU : 0, I_D = (part == 0 || part == 4) ? I_DN : 0;
    const int NITEMS = I_A + 3 * I_S + 2 * I_KV + 2 * I_G + I_D;
    unsigned char* wl = ws + WS_W + (size_t)l * W_LAYER;
    for (int it = gw; it < NITEMS; it += NGW) {
        int r = it; bool found = false; const float* W = nullptr; int K = 0, N = 0, mode = 0; bf16_t* WT = nullptr; const float* gv = nullptr; float cs = 1.f;
#define SEL(NI, Wp, K_, N_, WTp, g_, cs_, mode_) if (!found) { if (r < (NI)) { W = (Wp); K = (K_); N = (N_); WT = (bf16_t*)(WTp); gv = (g_); cs = (cs_); mode = (mode_); found = true; } else r -= (NI); }
        SEL(I_A, l ? a.in[15] : a.in[7], D, NIN, wl + W_IN, a.in[2] + l * D, 1.f, 0)
        SEL(I_S, l ? a.in[20] : a.in[14], D, D, wl + W_OUT, nullptr, 1.f, 0)
        SEL(I_S, a.in[21] + (size_t)l * D * D, D, D, wl + W_Q, a.in[3] + l * D, QS, 0)
        SEL(I_KV, a.in[22] + (size_t)l * D * D, D, D, wl + W_KV, nullptr, 1.f, 0)
        SEL(I_KV, a.in[23] + (size_t)l * D * D, D, D, wl + W_KV + (size_t)D * D * 2, nullptr, 1.f, 0)
        SEL(I_S, a.in[24] + (size_t)l * D * D, D, D, wl + W_O, nullptr, 1.f, 0)
        SEL(I_G, a.in[25] + (size_t)l * D * DFF, D, DFF, wl + W_GU, a.in[5] + l * D, 1.f, 1)
        SEL(I_G, a.in[26] + (size_t)l * D * DFF, D, DFF, wl + W_GU, a.in[5] + l * D, 1.f, 2)
        SEL(I_D, a.in[27] + (size_t)l * D * DFF, DFF, D, wl + W_DN, nullptr, 1.f, 0)
#undef SEL
        tr_item(W, K, N, WT, gv, cs, mode, scr, r, lane);
    }
}
__device__ __forceinline__ void p0_prologue(const Args& a, LAS unsigned char* lds, int gw, int NGW, int wave, int lane) {
    unsigned char* ws = a.ws;
    { const f32x4* src = (const f32x4*)a.in[18]; u32x2* dst = (u32x2*)(ws + WS_WSB);
      for (int i = gw * 64 + lane; i < 8 * 128 * 128 / 4; i += NGW * 64) { const f32x4 v = src[i]; u32x2 o; o.x = cvt_pk_bf16(v[0], v[1]); o.y = cvt_pk_bf16(v[2], v[3]); dst[i] = o; } }
    { float* ssq = (float*)(ws + WS_SSQ); bf16_t* HB = (bf16_t*)(ws + WS_HB);
      for (int m0 = gw * 4; m0 < T; m0 += NGW * 4) {
          f32x4 v[4][4];
#pragma unroll
          for (int r = 0; r < 4; ++r) { const f32x4* xr = (const f32x4*)(a.in[0] + (size_t)(m0 + r) * D) + lane;
#pragma unroll
              for (int j = 0; j < 4; ++j) v[r][j] = xr[64 * j]; }
          __builtin_amdgcn_sched_barrier(0);
#pragma unroll
          for (int r = 0; r < 4; ++r) { float s = 0.f;
#pragma unroll
              for (int j = 0; j < 4; ++j) s += (v[r][j][0] * v[r][j][0] + v[r][j][1] * v[r][j][1]) + (v[r][j][2] * v[r][j][2] + v[r][j][3] * v[r][j][3]);
              s = wave_sum(s);
              u32x2* o = (u32x2*)(HB + (size_t)(m0 + r) * D) + lane;
#pragma unroll
              for (int j = 0; j < 4; ++j) { u32x2 w; w.x = cvt_pk_bf16(v[r][j][0], v[r][j][1]); w.y = cvt_pk_bf16(v[r][j][2], v[r][j][3]); o[64 * j] = w; }
              if (lane < 16) ssq[(size_t)(m0 + r) * 16 + lane] = lane == 0 ? s : 0.f; }
      } }
    { bf16_t* MN = (bf16_t*)(ws + WS_MEMN);
      for (int m = gw; m < 2 * 512; m += NGW) { const int l = m >> 9, row = m & 511;
          const f32x4* xr = (const f32x4*)(a.in[1] + (size_t)row * D) + lane; const f32x4* gr = (const f32x4*)(a.in[4] + l * D) + lane; f32x4 v[4]; float s = 0.f;
#pragma unroll
          for (int j = 0; j < 4; ++j) { v[j] = xr[64 * j]; s += (v[j][0] * v[j][0] + v[j][1] * v[j][1]) + (v[j][2] * v[j][2] + v[j][3] * v[j][3]); }
          const float rs = rsqrtf(wave_sum(s) * (1.0f / 1024.0f) + RMS_EPS);
          u32x2* o = (u32x2*)(MN + ((size_t)l * 512 + row) * D) + lane;
#pragma unroll
          for (int j = 0; j < 4; ++j) { const f32x4 g = gr[64 * j]; u32x2 w; w.x = cvt_pk_bf16(v[j][0] * rs * g[0], v[j][1] * rs * g[1]); w.y = cvt_pk_bf16(v[j][2] * rs * g[2], v[j][3] * rs * g[3]); o[64 * j] = w; }
      } }
}

__device__ __forceinline__ void unpack8(const u32x4 r, float (&v)[8]) { v[0] = bflo(r.x); v[1] = bfhi(r.x); v[2] = bflo(r.y); v[3] = bfhi(r.y); v[4] = bflo(r.z); v[5] = bfhi(r.z); v[6] = bflo(r.w); v[7] = bfhi(r.w); }
__device__ __forceinline__ void conv_phase(LAS unsigned char* lds, const bf16_t* Z, bf16_t* Mo, const float* cw, const float* cb, const float* lg, const float* lb,
                                           const float* bw, const float* bb, int G, int c, int tid_in) {
    constexpr int TT = 32, RR = TT + 30;
    int tid_ = tid_in; asm volatile("" : "+v"(tid_)); asm volatile("" : "+s"(c), "+s"(G));
    const int tid = tid_, lane = tid & 63, wid = tid >> 6;
    LAS float* as = (LAS float*)lds;
    LAS float* os = (LAS float*)lds;
    for (int u = c; u < G; ++u) {
        const int t0 = u * TT, b = t0 / SEQ, s0 = t0 % SEQ;
        const bf16_t* zb = Z + (size_t)b * SEQ * DZ0;
        __syncthreads();
        { u32x4 rv[8], rg[8];
#pragma unroll
          for (int i = 0; i < 8; ++i) { const int idx = tid + 512 * i, r = idx >> 6, cc = idx & 63, sq = s0 - 15 + r; const bool ok = (idx < RR * 64) && (sq >= 0) && (sq < SEQ);
              const bf16_t* p = zb + (size_t)(ok ? sq : s0) * DZ0 + cc * 8; rv[i] = *(const u32x4*)p; rg[i] = *(const u32x4*)(p + 512);
              if (!ok) rv[i] = (u32x4){0u, 0u, 0u, 0u}; }
          __builtin_amdgcn_sched_barrier(0);
#pragma unroll
          for (int i = 0; i < 8; ++i) { const int idx = tid + 512 * i, r = idx >> 6, cc = idx & 63; float v[8], gt[8]; unpack8(rv[i], v); unpack8(rg[i], gt);
              f32x4 a0, a1;
#pragma unroll
              for (int j = 0; j < 4; ++j) { a0[j] = v[j] * sigm(gt[j]); a1[j] = v[4 + j] * sigm(gt[4 + j]); }
              if (idx < RR * 64) { *(LAS f32x4*)(as + r * 512 + cc * 8) = a0; *(LAS f32x4*)(as + r * 512 + cc * 8 + 4) = a1; } } }
        __syncthreads();
        float o[TT];
        { float w[31]; const float* cw_ = cw; const float* cb_ = cb; asm volatile("" : "+s"(cw_), "+s"(cb_));
#pragma unroll
          for (int k = 0; k < 31; ++k) w[k] = cw_[k * 512 + tid];
          const float cbias = cb_[tid];
          float av[RR];
#pragma unroll
          for (int r = 0; r < RR; ++r) av[r] = as[r * 512 + tid];
#pragma unroll
          for (int t = 0; t < TT; ++t) { float acc = cbias;
#pragma unroll
              for (int k = 0; k < 31; ++k) acc += w[k] * av[t + k];
              o[t] = acc; } }
        __syncthreads();
#pragma unroll
        for (int t = 0; t < TT; ++t) os[t * 512 + tid] = o[t];
        __syncthreads();
        { const float* lg_ = lg; const float* lb_ = lb; asm volatile("" : "+s"(lg_), "+s"(lb_));
          const f32x4 g0 = *(const f32x4*)(lg_ + 8 * lane), g1 = *(const f32x4*)(lg_ + 8 * lane + 4), b0 = *(const f32x4*)(lb_ + 8 * lane), b1 = *(const f32x4*)(lb_ + 8 * lane + 4);
#pragma unroll
          for (int i = 0; i < TT / 8; ++i) { const int t = (TT / 8) * wid + i;
              const f32x4 v0 = *(const LAS f32x4*)(os + t * 512 + 8 * lane), v1 = *(const LAS f32x4*)(os + t * 512 + 8 * lane + 4);
              const float mean = wave_sum(((v0[0] + v0[1]) + (v0[2] + v0[3])) + ((v1[0] + v1[1]) + (v1[2] + v1[3]))) * (1.0f / 512.0f);
              const f32x4 d0 = v0 - mean, d1 = v1 - mean;
              const float var = wave_sum(((d0[0] * d0[0] + d0[1] * d0[1]) + (d0[2] * d0[2] + d0[3] * d0[3])) + ((d1[0] * d1[0] + d1[1] * d1[1]) + (d1[2] * d1[2] + d1[3] * d1[3]))) * (1.0f / 512.0f);
              const float rstd = rsqrtf(var + LN_EPS);
              f32x4 y0 = d0 * rstd * g0 + b0, y1 = d1 * rstd * g1 + b1;
#pragma unroll
              for (int j = 0; j < 4; ++j) { y0[j] = y0[j] * sigm(y0[j]); y1[j] = y1[j] * sigm(y1[j]); }
              *(u32x4*)(Mo + (size_t)(t0 + t) * D + 8 * lane) = pack8(y0, y1); } }
        { const int cc = tid & 63, rgp = tid >> 6, sb = s0 + 4 * rgp;
          u32x4 hh[6], gc[6], gb[4];
#pragma unroll
          for (int r = 0; r < 6; ++r) { const int sq = sb - 1 + r; const bool ok = (sq >= 0) && (sq < SEQ); const bf16_t* p = zb + (size_t)(ok ? sq : s0) * DZ0 + cc * 8;
              hh[r] = *(const u32x4*)(p + 1024); gc[r] = *(const u32x4*)(p + 2048); if (!ok) hh[r] = (u32x4){0u, 0u, 0u, 0u};
              if (r >= 1 && r <= 4) gb[r - 1] = *(const u32x4*)(p + 1536); }
          const float* bw_ = bw; const float* bb_ = bb; asm volatile("" : "+s"(bw_), "+s"(bb_));
          const f32x4 w0a = *(const f32x4*)(bw_ + cc * 8), w0b = *(const f32x4*)(bw_ + cc * 8 + 4), w1a = *(const f32x4*)(bw_ + 512 + cc * 8), w1b = *(const f32x4*)(bw_ + 512 + cc * 8 + 4),
                      w2a = *(const f32x4*)(bw_ + 1024 + cc * 8), w2b = *(const f32x4*)(bw_ + 1024 + cc * 8 + 4), bba = *(const f32x4*)(bb_ + cc * 8), bbb = *(const f32x4*)(bb_ + cc * 8 + 4);
          __builtin_amdgcn_sched_barrier(0);
          float x[6][8];
#pragma unroll
          for (int r = 0; r < 6; ++r) { float hv[8], gv[8]; unpack8(hh[r], hv); unpack8(gc[r], gv);
#pragma unroll
              for (int j = 0; j < 8; ++j) x[r][j] = hv[j] * gv[j]; }
#pragma unroll
          for (int t = 0; t < 4; ++t) { float gbv[8]; unpack8(gb[t], gbv); f32x4 y0, y1;
#pragma unroll
              for (int j = 0; j < 4; ++j) { y0[j] = gbv[j] * (w0a[j] * x[t][j] + w1a[j] * x[t + 1][j] + w2a[j] * x[t + 2][j] + bba[j]);
                  y1[j] = gbv[4 + j] * (w0b[j] * x[t][4 + j] + w1b[j] * x[t + 1][4 + j] + w2b[j] * x[t + 2][4 + j] + bbb[j]); }
              *(u32x4*)(Mo + (size_t)(t0 + 4 * rgp + t) * D + 512 + cc * 8) = pack8(y0, y1); } }
    }
}

__device__ __forceinline__ void sgu_phase(LAS unsigned char* lds, const bf16_t* Z1, const float* vst, const bf16_t* Wsb, const float* bs, const float* lg, const float* lb, bf16_t* Y, int G, int c, int tid_in) {
    constexpr int RS = 272;
    int tid_ = tid_in; asm volatile("" : "+v"(tid_)); asm volatile("" : "+s"(c), "+s"(G));
    const int tid = tid_, lane = tid & 63, wid = tid >> 6, fr = lane & 15, fq = lane >> 4;
    LAS unsigned char* Wl = lds; LAS unsigned char* Vl = lds + 128 * RS;
    for (int u = c; u < G; ++u) {
        const int n = u >> 3, g = u & 7, t0 = n * 128, cg0 = g * 128;
        const int q = tid & 127, qc = tid >> 7;
        u32x4 wt[4], vr[4]; f32x4 sp[8];
#pragma unroll
        for (int i = 0; i < 4; ++i) { const int idx = tid + 512 * i, p = idx >> 4, chn = idx & 15; wt[i] = *(const u32x4*)(Wsb + ((size_t)g * 128 + p) * 128 + chn * 8); }
#pragma unroll
        for (int i = 0; i < 4; ++i) vr[i] = *(const u32x4*)(Z1 + (size_t)(t0 + q) * DZ1 + 1024 + cg0 + qc * 32 + i * 8);
#pragma unroll
        for (int j = 0; j < 8; ++j) sp[j] = *(const f32x4*)(vst + (size_t)(t0 + q) * 32 + 4 * j);
        const int pr = 16 * wid + fr, row = t0 + pr;
        u32x2 uu[8];
#pragma unroll
        for (int cb = 0; cb < 8; ++cb) uu[cb] = *(const u32x2*)(Z1 + (size_t)row * DZ1 + cg0 + 16 * cb + 4 * fq);
        const float bias = bs[g * 128 + pr];
        __builtin_amdgcn_sched_barrier(0);
        __syncthreads();
#pragma unroll
        for (int i = 0; i < 4; ++i) { const int idx = tid + 512 * i, p = idx >> 4, chn = idx & 15; *(LAS u32x4*)(Wl + p * RS + chn * 16) = wt[i]; }
        { float s1 = 0.f, s2 = 0.f;
#pragma unroll
          for (int j = 0; j < 8; ++j) { s1 += sp[j][0] + sp[j][2]; s2 += sp[j][1] + sp[j][3]; }
          const float mean = s1 * (1.0f / 1024.0f), var = s2 * (1.0f / 1024.0f) - mean * mean, rstd = rsqrtf(var + LN_EPS);
#pragma unroll
          for (int i = 0; i < 4; ++i) { const int c0 = qc * 32 + i * 8; float v[8]; unpack8(vr[i], v);
              const f32x4 g0 = *(const f32x4*)(lg + cg0 + c0), g1 = *(const f32x4*)(lg + cg0 + c0 + 4), b0 = *(const f32x4*)(lb + cg0 + c0), b1 = *(const f32x4*)(lb + cg0 + c0 + 4);
#pragma unroll
              for (int j = 0; j < 8; ++j) { const float gg = j < 4 ? g0[j & 3] : g1[j & 3], bbv = j < 4 ? b0[j & 3] : b1[j & 3];
                  *(LAS bf16_t*)(Vl + (c0 + j) * RS + q * 2) = f2bf((v[j] - mean) * rstd * gg + bbv); } } }
        __syncthreads();
        bf16x8 wf[4];
#pragma unroll
        for (int ks = 0; ks < 4; ++ks) wf[ks] = *(const LAS bf16x8*)(Wl + (16 * wid + fr) * RS + (32 * ks + 8 * fq) * 2);
        f32x4 acc[8];
#pragma unroll
        for (int cb = 0; cb < 8; ++cb) { acc[cb] = (f32x4){0.f, 0.f, 0.f, 0.f};
#pragma unroll
            for (int ks = 0; ks < 4; ++ks) { const bf16x8 vf = *(const LAS bf16x8*)(Vl + (16 * cb + fr) * RS + (32 * ks + 8 * fq) * 2);
                acc[cb] = __builtin_amdgcn_mfma_f32_16x16x32_bf16(vf, wf[ks], acc[cb], 0, 0, 0); } }
#pragma unroll
        for (int cb = 0; cb < 8; ++cb) { const int cc = cg0 + 16 * cb + 4 * fq;
            u32x2 o; o.x = cvt_pk_bf16(bflo(uu[cb].x) * (acc[cb][0] + bias), bfhi(uu[cb].x) * (acc[cb][1] + bias)); o.y = cvt_pk_bf16(bflo(uu[cb].y) * (acc[cb][2] + bias), bfhi(uu[cb].y) * (acc[cb][3] + bias));
            *(u32x2*)(Y + (size_t)row * D + cc) = o; }
    }
}

__device__ __forceinline__ void attn_phase(LAS unsigned char* lds, const bf16_t* Q, const bf16_t* Kb, const bf16_t* Vt, bf16_t* O, int G, int c, int tid_in) {
    constexpr int RS = 528;
    int tid_ = tid_in; asm volatile("" : "+v"(tid_)); asm volatile("" : "+s"(c), "+s"(G));
    const int tid = tid_, lane = tid & 63, wid = tid >> 6, fr = lane & 15, fq = lane >> 4;
    for (int u = c; u < 512; u += G) {
        const int qb = u >> 2, h = u & 3, b = qb >> 6, q0 = qb * 128;
        const bf16_t* qrow = Q + (size_t)(q0 + 16 * wid + fr) * D + h * 256 + 8 * fq;
        bf16x8 qf[8];
#pragma unroll
        for (int ks = 0; ks < 8; ++ks) qf[ks] = *(const bf16x8*)(qrow + 32 * ks);
        __syncthreads();
        { u32x4 tv[16];
#pragma unroll
          for (int i = 0; i < 16; ++i) { const int idx = tid + 512 * i, key = idx >> 5, ch = idx & 31; tv[i] = *(const u32x4*)(Kb + (size_t)(b * 256 + key) * D + h * 256 + ch * 8); }
          __builtin_amdgcn_sched_barrier(0);
#pragma unroll
          for (int i = 0; i < 16; ++i) { const int idx = tid + 512 * i, key = idx >> 5, ch = idx & 31; *(LAS u32x4*)(lds + key * RS + ch * 16) = tv[i]; } }
        __syncthreads();
        f32x4 S[16];
#pragma unroll
        for (int kb = 0; kb < 16; ++kb) { S[kb] = (f32x4){0.f, 0.f, 0.f, 0.f};
#pragma unroll
            for (int ks = 0; ks < 8; ++ks) { const bf16x8 kf = *(const LAS bf16x8*)(lds + (16 * kb + fr) * RS + (32 * ks + 8 * fq) * 2);
                S[kb] = __builtin_amdgcn_mfma_f32_16x16x32_bf16(kf, qf[ks], S[kb], 0, 0, 0); } }
        float mx = -3.0e38f;
#pragma unroll
        for (int kb = 0; kb < 16; ++kb) mx = fmaxf(mx, fmaxf(fmaxf(S[kb][0], S[kb][1]), fmaxf(S[kb][2], S[kb][3])));
        mx = fmaxf(mx, __shfl_xor(mx, 16)); mx = fmaxf(mx, __shfl_xor(mx, 32));
        float l = 0.f;
#pragma unroll
        for (int kb = 0; kb < 16; ++kb)
#pragma unroll
            for (int j = 0; j < 4; ++j) { const float p = __builtin_amdgcn_exp2f(S[kb][j] - mx); S[kb][j] = p; l += p; }
        l += __shfl_xor(l, 16); l += __shfl_xor(l, 32);
        bf16x8 pf[8];
#pragma unroll
        for (int cc = 0; cc < 8; ++cc) { const u32x4 w = pack8(S[2 * cc], S[2 * cc + 1]); pf[cc] = __builtin_bit_cast(bf16x8, w); }
        __syncthreads();
        { u32x4 tv[16];
#pragma unroll
          for (int i = 0; i < 16; ++i) { const int idx = tid + 512 * i, d = idx >> 5, ch = idx & 31; tv[i] = *(const u32x4*)(Vt + ((size_t)b * D + h * 256 + d) * NMEM + ch * 8); }
          __builtin_amdgcn_sched_barrier(0);
#pragma unroll
          for (int i = 0; i < 16; ++i) { const int idx = tid + 512 * i, d = idx >> 5, ch = idx & 31; *(LAS u32x4*)(lds + d * RS + ch * 16) = tv[i]; } }
        __syncthreads();
        const float inv = 1.0f / l;
        bf16_t* orow = O + (size_t)(q0 + 16 * wid + fr) * D + h * 256 + 4 * fq;
#pragma unroll
        for (int db = 0; db < 16; ++db) { f32x4 oa = (f32x4){0.f, 0.f, 0.f, 0.f};
#pragma unroll
            for (int cc = 0; cc < 8; ++cc) { const bf16x8 vf = *(const LAS bf16x8*)(lds + (16 * db + fr) * RS + (32 * cc + 8 * fq) * 2);
                oa = __builtin_amdgcn_mfma_f32_16x16x32_bf16(vf, pf[cc], oa, 0, 0, 0); }
            u32x2 o; o.x = cvt_pk_bf16(oa[0] * inv, oa[1] * inv); o.y = cvt_pk_bf16(oa[2] * inv, oa[3] * inv);
            *(u32x2*)(orow + 16 * db) = o; }
    }
}

struct EpiQAttn {
    static constexpr bool PERM = true, AFTER_DRAIN = true;
    const float* ssq; const bf16_t* Kb; const bf16_t* Vt; bf16_t* O;
    __device__ __forceinline__ void operator()(const f32x4 (&)[2][2][4][2], const Unit&, int, int, int, int) const {}
    __device__ __forceinline__ void fused(f32x4 (&acc)[2][2][4][2], const Unit& u, int wr, int wc, int fr, int fq, PG8_LAS unsigned char* lds, int wid, int lane) const {
        constexpr int RS = 528;
        const int tid = wid * 64 + lane, h = u.pn, b = u.pm >> 5;
        const unsigned r0 = (unsigned)tid >> 5, ch = (unsigned)tid & 31u;
        const bf16_t* kbase = Kb + (size_t)(b * 256) * D + h * 256; const bf16_t* vbase = Vt + ((size_t)b * D + h * 256) * NMEM;
        const unsigned goffk = r0 * (unsigned)(D * 2) + ch * 16u, goffv = r0 * (unsigned)(NMEM * 2) + ch * 16u, loff = r0 * (unsigned)RS + ch * 16u;
        unsigned loffa = loff, loffb = loff + 7 * 16 * RS; asm volatile("" : "+v"(loffa), "+v"(loffb));
#pragma unroll
        for (int ai = 0; ai < 2; ++ai)
#pragma unroll
            for (int m = 0; m < 4; ++m) { const int lr = ai * HALF + wr * 64 + m * 16 + fr; const float rs = row_rstd(ssq, u.pm * BM + lr, fq);
#pragma unroll
                for (int bj = 0; bj < 2; ++bj) *(PG8_LAS u32x4*)(lds + lr * RS + (bj * HALF + wc * 32 + 8 * fq) * 2) = pack8(acc[ai][bj][m][0] * rs, acc[ai][bj][m][1] * rs); }
        __syncthreads();
        bf16x8 qf[2][8];
#pragma unroll
        for (int qb = 0; qb < 2; ++qb)
#pragma unroll
            for (int ks = 0; ks < 8; ++ks) qf[qb][ks] = *(const PG8_LAS bf16x8*)(lds + (32 * wid + 16 * qb + fr) * RS + (32 * ks + 8 * fq) * 2);
        __builtin_amdgcn_sched_barrier(0);
        u32x4 tv[16];
#pragma unroll
        for (int i = 0; i < 16; ++i) tv[i] = *(const u32x4*)((const char*)kbase + (goffk + (unsigned)(i * 16 * D * 2)));
        __builtin_amdgcn_sched_barrier(0);
        __syncthreads();
#pragma unroll
        for (int i = 0; i < 16; ++i) *(PG8_LAS u32x4*)(lds + (i < 7 ? loffa : loffb) + (i < 7 ? i : i - 7) * 16 * RS) = tv[i];
        __syncthreads();
        unsigned fb0 = (unsigned)(fr * RS + fq * 16), fb1 = fb0 + 8 * 16 * RS; asm volatile("" : "+v"(fb0), "+v"(fb1));
        f32x4 S[2][16];
#pragma unroll
        for (int kb = 0; kb < 16; ++kb) { S[0][kb] = (f32x4){0.f, 0.f, 0.f, 0.f}; S[1][kb] = (f32x4){0.f, 0.f, 0.f, 0.f};
#pragma unroll
            for (int ks = 0; ks < 8; ++ks) { const bf16x8 kf = *(const PG8_LAS bf16x8*)(lds + (kb < 8 ? fb0 : fb1) + ((kb & 7) * 16 * RS + ks * 64));
                S[0][kb] = __builtin_amdgcn_mfma_f32_16x16x32_bf16(kf, qf[0][ks], S[0][kb], 0, 0, 0);
                S[1][kb] = __builtin_amdgcn_mfma_f32_16x16x32_bf16(kf, qf[1][ks], S[1][kb], 0, 0, 0); } }
        __builtin_amdgcn_sched_barrier(0);
        bf16x8 pf[2][8]; float inv[2];
#pragma unroll
        for (int qb = 0; qb < 2; ++qb) {
            float mx = -3.0e38f;
#pragma unroll
            for (int kb = 0; kb < 16; ++kb) mx = fmaxf(mx, fmaxf(fmaxf(S[qb][kb][0], S[qb][kb][1]), fmaxf(S[qb][kb][2], S[qb][kb][3])));
            mx = fmaxf(mx, __shfl_xor(mx, 16)); mx = fmaxf(mx, __shfl_xor(mx, 32));
            float l = 0.f;
#pragma unroll
            for (int kb = 0; kb < 16; ++kb)
#pragma unroll
                for (int j = 0; j < 4; ++j) { const float p = __builtin_amdgcn_exp2f(S[qb][kb][j] - mx); S[qb][kb][j] = p; l += p; }
            l += __shfl_xor(l, 16); l += __shfl_xor(l, 32); inv[qb] = 1.0f / l;
#pragma unroll
            for (int cc = 0; cc < 8; ++cc) { const u32x4 w = pack8(S[qb][2 * cc], S[qb][2 * cc + 1]); pf[qb][cc] = __builtin_bit_cast(bf16x8, w); }
        }
        __builtin_amdgcn_sched_barrier(0);
        unsigned loff2a = loff, loff2b = loff + 7 * 16 * RS; asm volatile("" : "+v"(loff2a), "+v"(loff2b));
#pragma unroll
        for (int i = 0; i < 16; ++i) tv[i] = *(const u32x4*)((const char*)vbase + (goffv + (unsigned)(i * 16 * NMEM * 2)));
        __builtin_amdgcn_sched_barrier(0);
        __syncthreads();
#pragma unroll
        for (int i = 0; i < 16; ++i) *(PG8_LAS u32x4*)(lds + (i < 7 ? loff2a : loff2b) + (i < 7 ? i : i - 7) * 16 * RS) = tv[i];
        __syncthreads();
        unsigned vb0 = (unsigned)(fr * RS + fq * 16), vb1 = vb0 + 8 * 16 * RS; asm volatile("" : "+v"(vb0), "+v"(vb1));
        bf16_t* orow = O + (size_t)(u.pm * BM + 32 * wid + fr) * D + h * 256 + 4 * fq;
#pragma unroll
        for (int db = 0; db < 16; ++db) { f32x4 o0 = (f32x4){0.f, 0.f, 0.f, 0.f}, o1 = (f32x4){0.f, 0.f, 0.f, 0.f};
#pragma unroll
            for (int cc = 0; cc < 8; ++cc) { const bf16x8 vf = *(const PG8_LAS bf16x8*)(lds + (db < 8 ? vb0 : vb1) + ((db & 7) * 16 * RS + cc * 64));
                o0 = __builtin_amdgcn_mfma_f32_16x16x32_bf16(vf, pf[0][cc], o0, 0, 0, 0); o1 = __builtin_amdgcn_mfma_f32_16x16x32_bf16(vf, pf[1][cc], o1, 0, 0, 0); }
            u32x2 w0, w1; w0.x = cvt_pk_bf16(o0[0] * inv[0], o0[1] * inv[0]); w0.y = cvt_pk_bf16(o0[2] * inv[0], o0[3] * inv[0]);
            w1.x = cvt_pk_bf16(o1[0] * inv[1], o1[1] * inv[1]); w1.y = cvt_pk_bf16(o1[2] * inv[1], o1[3] * inv[1]);
            *(u32x2*)(orow + 16 * db) = w0; *(u32x2*)(orow + (size_t)16 * D + 16 * db) = w1; }
        __syncthreads();
    }
};

__device__ __forceinline__ int lane_id_volatile() { int l; asm volatile("v_mbcnt_lo_u32_b32 %0, -1, 0\n\tv_mbcnt_hi_u32_b32 %0, -1, %0" : "=v"(l)); return l; }
#ifndef REP_P0
#define REP_P0 1
#endif
#ifndef REP_CONV
#define REP_CONV 1
#endif
#ifndef REP_SGU
#define REP_SGU 1
#endif
#ifndef REP_ATTN
#define REP_ATTN 1
#endif
#ifndef LSTART
#define LSTART 0
#endif
#ifndef LEND
#define LEND 2
#endif
struct PanelOrder {
    int pm, j, nN;
    __device__ __forceinline__ bool next(int i, Unit& u) const { const int pn = j + 4 * i; if (pn >= nN) return false; int pmv = pm; asm volatile("" : "+s"(pmv)); u.pm = pmv; u.pn = pn; return true; }
    __device__ __forceinline__ void a_ready(const Unit&) const {}
    __device__ __forceinline__ void done(const Unit&) const {}
};
__device__ __forceinline__ void group_barrier(unsigned* cnt, unsigned target, bool coxcd, unsigned* tmo, int ktid) {
    asm volatile("s_waitcnt vmcnt(0)" ::: "memory");
    __syncthreads();
    if (ktid == 0) {
        if (!coxcd) { __builtin_amdgcn_fence(__ATOMIC_RELEASE, "agent"); asm volatile("s_waitcnt vmcnt(0)" ::: "memory"); }
        (void)xb_add(cnt, 1u);
        unsigned sp = 0;
        while (xb_ld(cnt) < target) { __builtin_amdgcn_s_sleep(1); if ((++sp & 255u) == 0u) { if (xb_ld(tmo)) break; if (sp > XB_SPIN_CAP) { atomicAdd(tmo, 1u); break; } } }
        __builtin_amdgcn_fence(__ATOMIC_ACQUIRE, "agent");
        asm volatile("s_waitcnt vmcnt(0)" ::: "memory");
    }
    __syncthreads();
}

__global__ void __launch_bounds__(NTHR, 2) fwd_kernel(Args a) {
    extern __shared__ __attribute__((aligned(16))) unsigned char lds_raw[];
    LAS unsigned char* lds = (LAS unsigned char*)lds_raw;
    volatile LAS unsigned* MISC = (volatile LAS unsigned*)(lds + MISC_OFF);
    const int wave = __builtin_amdgcn_readfirstlane((int)threadIdx.x >> 6);
#define TID() (wave * 64 + lane_id_volatile())
    const int tid = TID(), lane = tid & 63;
    const int G = gridDim.x, bx = blockIdx.x, vcu = (bx % 8) * (G / 8) + bx / 8;
    unsigned char* ws = a.ws;
    unsigned* ctl = (unsigned*)(ws + WS_CTL);
    int pm, pj; { StaticOrder S0; S0.init(T, D, G, bx); Unit own; S0.next(0, own); pm = own.pm; pj = own.pn; }
    if (tid < 32) MISC[tid] = 0u;
    if (tid == 0) __hip_atomic_store(ctl + 8192 + pm * 4 + pj, xb_xcc_id() + 1u, __ATOMIC_RELAXED, __HIP_MEMORY_SCOPE_AGENT);
    __syncthreads();
    XcdBarrier bar = xcd_barrier_post(ctl, MISC + 8, tid);
    const int gw = vcu * NWAVES + wave, NGW = G * NWAVES;
    float* out = a.out; float* ssq = (float*)(ws + WS_SSQ); float* vst = (float*)(ws + WS_VST);
    bf16_t* HB = (bf16_t*)(ws + WS_HB); bf16_t* MB = (bf16_t*)(ws + WS_MB); bf16_t* BIG = (bf16_t*)(ws + WS_BIG);
    bf16_t* MEMN = (bf16_t*)(ws + WS_MEMN); bf16_t* KB = (bf16_t*)(ws + WS_KB); bf16_t* VT = (bf16_t*)(ws + WS_VT);
    unsigned gseq = 0u;
#define GRID_BAR() xcd_barrier(bar, TID())
#define GROUP_BAR() do { gseq += 4u; group_barrier(ctl + 4096 + 64 * pm, gseq, coxcd, ctl + XB_TMO, TID()); } while (0)
#define GEMM(EpiT, E, Ap, Bp, M_, N_, K_, cc) do { Gemm g{(const bf16_t*)(Ap), (const bf16_t*)(Bp), (M_), (N_), (K_)}; int cc_ = (cc); asm volatile("" : "+s"(cc_)); StaticOrder S; S.init((M_), (N_), G, cc_); gemm_phase<EpiT, StaticOrder, true, true>(lds, g, S, (E), TID()); } while (0)
#define GEMMP(EpiT, AL, E, Ap, Bp, N_, K_) do { Gemm g{(const bf16_t*)(Ap), (const bf16_t*)(Bp), T, (N_), (K_)}; int pm_ = pm, pj_ = pj; asm volatile("" : "+s"(pm_), "+s"(pj_)); PanelOrder S{pm_, pj_, (N_) / BM}; gemm_phase<EpiT, PanelOrder, AL, true>(lds, g, S, (E), TID()); } while (0)

    p0_weights(a, 0, 0, lds, gw, NGW, wave, lane); p0_weights(a, 1, 1, lds, gw, NGW, wave, lane); p0_prologue(a, lds, gw, NGW, wave, lane);
    if (a.ws == nullptr) cg::this_grid().sync();
    GRID_BAR();
    bool coxcd; { const unsigned x0 = xb_ld(ctl + 8192 + pm * 4), x1 = xb_ld(ctl + 8192 + pm * 4 + 1), x2 = xb_ld(ctl + 8192 + pm * 4 + 2), x3 = xb_ld(ctl + 8192 + pm * 4 + 3);
        coxcd = __builtin_amdgcn_readfirstlane((x0 != 0u && x0 == x1 && x1 == x2 && x2 == x3) ? 1 : 0) != 0; }
    const int spare = pj >= 2 ? pm * 2 + (pj - 2) : (1 << 20);

#pragma unroll
    for (int l = 0; l < 2; ++l) {
        unsigned char* wl = ws + WS_W + (size_t)l * W_LAYER;
        if (l == 0) {
            { EpiScale E{BIG, DZ0, ssq}; GEMMP(EpiScale, true, E, HB, wl + W_IN, DZ0, D); }
#pragma unroll 1
            for (int l2 = 0; l2 < 2; ++l2) { EpiKV E{KB + (size_t)l2 * 512 * D, VT + (size_t)l2 * 2 * D * NMEM};
                const int c2 = (spare >= 16 * l2 && spare < 16 * l2 + 16) ? spare - 16 * l2 : (1 << 20);
                GEMM(EpiKV, E, MEMN + (size_t)l2 * 512 * D, ws + WS_W + (size_t)l2 * W_LAYER + W_KV, 512, 2 * D, D, c2); }
            if (spare >= 32 && spare < 128) { const int t3 = TID(); p0_weights(a, 1, 3, lds, (spare - 32) * NWAVES + wave, 96 * NWAVES, wave, t3 & 63); }
            GRID_BAR();
            conv_phase(lds, BIG, MB, a.in[8], a.in[9], a.in[10], a.in[11], a.in[12], a.in[13], 8 * pm + 2 * pj + 2, 8 * pm + 2 * pj, TID());
            GRID_BAR();
            { EpiRes E{HB, ssq}; GEMMP(EpiRes, true, E, MB, wl + W_OUT, D, D); }
        } else {
            { EpiZ1 E{BIG, ssq, vst}; GEMMP(EpiZ1, true, E, HB, wl + W_IN, DZ1, D); }
            GROUP_BAR();
            sgu_phase(lds, BIG, vst, (const bf16_t*)(ws + WS_WSB), a.in[19], a.in[16], a.in[17], MB, 16 * pm + 4 * pj + 4, 16 * pm + 4 * pj, TID());
            GRID_BAR();
            { EpiRes E{HB, ssq}; GEMMP(EpiRes, true, E, MB, wl + W_OUT, D, D); }
        }
        GROUP_BAR();
        { EpiQAttn E{ssq, KB + (size_t)l * 512 * D, VT + (size_t)l * 2 * D * NMEM, MB}; GEMMP(EpiQAttn, false, E, HB, wl + W_Q, D, D); }
        GROUP_BAR();
        { EpiRes E{HB, ssq}; GEMMP(EpiRes, true, E, MB, wl + W_O, D, D); }
        GROUP_BAR();
        { EpiGU E{BIG, ssq}; GEMMP(EpiGU, true, E, HB, wl + W_GU, NGU, D); }
        if (l == 0 && spare < 128) { const int t3 = TID(); p0_weights(a, 1, 4, lds, spare * NWAVES + wave, 128 * NWAVES, wave, t3 & 63); }
        GROUP_BAR();
        { EpiRes E{HB, ssq}; GEMMP(EpiRes, true, E, BIG, wl + W_DN, D, DFF); }
        if (l == 0) GRID_BAR(); else GROUP_BAR();
    }
    { int t2 = TID(); asm volatile("" : "+v"(t2)); const int lane = t2 & 63, wv = __builtin_amdgcn_readfirstlane(t2 >> 6);
      const f32x4 g0 = *(const f32x4*)(a.in[6] + 8 * lane), g1 = *(const f32x4*)(a.in[6] + 8 * lane + 4), g2 = *(const f32x4*)(a.in[6] + 512 + 8 * lane), g3 = *(const f32x4*)(a.in[6] + 512 + 8 * lane + 4);
#pragma unroll 1
      for (int it = 0; it < 2; ++it) { const int m0 = pm * BM + pj * 64 + wv * 8 + it * 4;
          u32x4 r0[4], r1[4];
#pragma unroll
          for (int r = 0; r < 4; ++r) { const bf16_t* p = HB + (size_t)(m0 + r) * D + 8 * lane; r0[r] = *(const u32x4*)p; r1[r] = *(const u32x4*)(p + 512); }
          __builtin_amdgcn_sched_barrier(0);
#pragma unroll
          for (int r = 0; r < 4; ++r) { float v[8], w[8]; unpack8(r0[r], v); unpack8(r1[r], w); float sq = 0.f;
#pragma unroll
              for (int j = 0; j < 8; ++j) sq += v[j] * v[j] + w[j] * w[j];
              const float rs = rsqrtf(wave_sum(sq) * (1.0f / 1024.0f) + RMS_EPS);
              float* o = out + (size_t)(m0 + r) * D + 8 * lane;
              *(f32x4*)o = (f32x4){v[0], v[1], v[2], v[3]} * rs * g0; *(f32x4*)(o + 4) = (f32x4){v[4], v[5], v[6], v[7]} * rs * g1;
              *(f32x4*)(o + 512) = (f32x4){w[0], w[1], w[2], w[3]} * rs * g2; *(f32x4*)(o + 516) = (f32x4){w[4], w[5], w[6], w[7]} * rs * g3; } } }
}

extern "C" void kernel_launch(void* const* d_in, const int* in_sizes, int n_in, void* d_out, int out_size, void* d_ws, size_t ws_size, hipStream_t stream) {
    static int grid = 0;
    if (grid == 0) {
        if (n_in != 28 || out_size != T * D || ws_size < WS_END) { fprintf(stderr, "kernel_launch: unexpected shapes (n_in %d out %d ws %zu)\n", n_in, out_size, ws_size); grid = -1; return; }
        int dev = 0, cus = 0, per_cu = 0;
        (void)hipGetDevice(&dev); (void)hipDeviceGetAttribute(&cus, hipDeviceAttributeMultiprocessorCount, dev);
        (void)hipFuncSetAttribute((const void*)fwd_kernel, hipFuncAttributeMaxDynamicSharedMemorySize, LDS_BYTES);
        (void)hipOccupancyMaxActiveBlocksPerMultiprocessor(&per_cu, (const void*)fwd_kernel, NTHR, LDS_BYTES);
        if (per_cu < 1) per_cu = 1;
        (void)hipGetLastError();
        grid = cus;
        if (grid != 256) { fprintf(stderr, "kernel_launch: built for a 256-CU device (one workgroup per CU, four per row panel); found %d CUs; nothing launched\n", grid); grid = -1; return; }
    }
    if (grid < 0) return;
    (void)hipMemsetAsync((char*)d_ws + WS_CTL, 0, CTL_ZERO_BYTES, stream);
    Args a{};
    for (int i = 0; i < 28; ++i) a.in[i] = (const float*)d_in[i];
    a.out = (float*)d_out; a.ws = (unsigned char*)d_ws;
    void* args[] = {&a};
    hipError_t e = hipLaunchCooperativeKernel((const void*)fwd_kernel, dim3(grid), dim3(NTHR), args, LDS_BYTES, stream);
    if (e != hipSuccess) fprintf(stderr, "cooperative launch failed: %s (grid %d)\n", hipGetErrorString(e), grid);
}
```

```cpp
#include <hip/hip_runtime.h>
#include <hip/hip_cooperative_groups.h>
#include <cstdio>
#include <cstdint>
namespace cg = cooperative_groups;
namespace pg8 {
#define PG8_LAS __attribute__((address_space(3)))
typedef unsigned short bf16_t;
typedef short bf16x8 __attribute__((ext_vector_type(8)));
typedef float f32x4 __attribute__((ext_vector_type(4)));
typedef unsigned u32x4 __attribute__((ext_vector_type(4)));
constexpr int BM = 256, BK = 64, HALF = 128, HTB = HALF * BK * 2  , STAGE_BYTES = 8 * HTB, NXCD = 8, WGM = 8;

__host__ __device__ __forceinline__ int lds_byte(int r, int c) { const int st = (r >> 4) * 2 + (c >> 5), rr = r & 15, cc = c & 31, ob = rr * 64 + cc * 2; return st * 1024 + (ob ^ (((ob >> 9) & 1) << 5)); }
__host__ __device__ __forceinline__ void stage_rc(int b, int& R, int& C) { const int st = b / 1024, sb = b % 1024, swz = sb ^ (((sb >> 9) & 1) << 5); R = (st >> 1) * 16 + swz / 64; C = (st & 1) * 32 + (swz % 64) / 2; }
__host__ __device__ __forceinline__ int perm32(int rho) { const int n = rho >> 4, i = rho & 15; return 8 * (i >> 2) + 4 * n + (i & 3); }

struct Unit { int pm, pn; };
struct Gemm { const bf16_t* A; const bf16_t* Bt; int M, N, K; };

struct StaticOrder {
    int nM, nN, nwg, G, c;
    __host__ __device__ void init(int M, int N, int G_, int c_) { nM = M / BM; nN = N / BM; nwg = nM * nN; G = G_; c = c_; }
    __host__ __device__ bool next(int i, Unit& u) const {
        const long L = (long)i * G + c; if (L >= nwg) return false;
        int wgid = (int)L; { const int q = nwg / NXCD, r = nwg % NXCD, xcd = wgid % NXCD, off = wgid / NXCD; wgid = (xcd < r ? xcd * (q + 1) : r * (q + 1) + (xcd - r) * q) + off; }
        const int nig = WGM * nN, gid = wgid / nig, fm = gid * WGM, gsz = (nM - fm) < WGM ? (nM - fm) : WGM;
        u.pm = fm + ((wgid % nig) % gsz); u.pn = (wgid % nig) / gsz; return true;
    }
    __device__ __forceinline__ void a_ready(const Unit&) const {}
    __device__ __forceinline__ void done(const Unit&) const {}
};

__device__ __forceinline__ unsigned cvt_pk_bf16(float lo, float hi) { unsigned r; asm volatile("v_cvt_pk_bf16_f32 %0, %1, %2" : "=v"(r) : "v"(lo), "v"(hi)); return r; }
typedef float f32x2 __attribute__((ext_vector_type(2)));
template <class Epi, class Sched, bool ALIGN_EPI = false, bool SP2 = false>
__device__ __forceinline__ void gemm_phase(PG8_LAS unsigned char* lds, const Gemm g, const Sched& S, const Epi& E, int tid_in) {
    int tid_ = tid_in; asm volatile("" : "+v"(tid_));
    const int tid = tid_, wid = __builtin_amdgcn_readfirstlane(tid >> 6), lane = tid & 63, wr = wid >> 2, wc = wid & 3, fr = lane & 15, fq = lane >> 4;
    const int K = g.K, nt = K / BK;
    unsigned voffA[2], voffB[2];
#pragma unroll
    for (int i = 0; i < 2; ++i) { int R, C; stage_rc(tid * 16 + i * 8192, R, C); const int Rb = Epi::PERM ? ((R & ~31) + perm32(R & 31)) : R;
        voffA[i] = (unsigned)(R * K + C) * 2u; voffB[i] = (unsigned)(Rb * K + C) * 2u; }
    const size_t kstep = (size_t)(BK * 2);
    const size_t hstep = (size_t)HALF * K * 2;
    const size_t tstep = 2 * hstep;
    const unsigned ldsw = (unsigned)wid * 1024u;
    const int aoff = lds_byte(wr * 64 + fr, fq * 8), boff = lds_byte(wc * 32 + fr, fq * 8);
#define PG8_SA(b, h) (((b) * 2 + (h)) * HTB)
#define PG8_SB(b, h) ((4 + (b) * 2 + (h)) * HTB)
#define PG8_STAGE(bufoff, gbase, voff) do { _Pragma("unroll") for (int _i = 0; _i < 2; ++_i) \
        __builtin_amdgcn_global_load_lds((const unsigned*)((const char*)(gbase) + (voff)[_i]), (PG8_LAS unsigned*)(lds + (bufoff) + ldsw + _i * 8192), 16, 0, 0); } while (0)
#define PG8_LDA(dst, b, h) do { _Pragma("unroll") for (int m = 0; m < 4; ++m) _Pragma("unroll") for (int k = 0; k < 2; ++k) dst[m][k] = *(const PG8_LAS bf16x8*)(lds + PG8_SA(b, h) + aoff + m * 2048 + k * 1024); } while (0)
#define PG8_LDB(dst, b, h) do { _Pragma("unroll") for (int n = 0; n < 2; ++n) _Pragma("unroll") for (int k = 0; k < 2; ++k) dst[n][k] = *(const PG8_LAS bf16x8*)(lds + PG8_SB(b, h) + boff + n * 2048 + k * 1024); } while (0)
#define PG8_MMA(ai, bj, At, Bt) do { __builtin_amdgcn_s_setprio(1); _Pragma("unroll") for (int m = 0; m < 4; ++m) _Pragma("unroll") for (int n = 0; n < 2; ++n) _Pragma("unroll") for (int k = 0; k < 2; ++k) \
        acc[ai][bj][m][n] = __builtin_amdgcn_mfma_f32_16x16x32_bf16(Bt[n][k], At[m][k], acc[ai][bj][m][n], 0, 0, 0); __builtin_amdgcn_s_setprio(0); } while (0)
#define PG8_WAIT_V(n) asm volatile("s_waitcnt vmcnt(" #n ")" ::: "memory")
#define PG8_WAIT_L(n) asm volatile("s_waitcnt lgkmcnt(" #n ")" ::: "memory")
#define PG8_BAR __builtin_amdgcn_s_barrier()
#define PG8_SCHED __builtin_amdgcn_sched_barrier(0)
    Unit cur, nxt; int ui = 0;
    if (!S.next(0, cur)) return;
    f32x4 acc[2][2][4][2];
#pragma unroll
    for (int a = 0; a < 2; ++a)
#pragma unroll
        for (int b = 0; b < 2; ++b)
#pragma unroll
            for (int m = 0; m < 4; ++m)
#pragma unroll
                for (int n = 0; n < 2; ++n) acc[a][b][m][n] = (f32x4){0.f, 0.f, 0.f, 0.f};
    bf16x8 At[4][2], B0[2][2], B1[2][2];
    const char* cA = (const char*)g.A + (size_t)cur.pm * tstep; const char* cB = (const char*)g.Bt + (size_t)cur.pn * tstep;
    S.a_ready(cur);
    if constexpr (SP2) {
        PG8_STAGE(PG8_SB(0, 0), cB, voffB); PG8_STAGE(PG8_SB(0, 1), cB + hstep, voffB); PG8_STAGE(PG8_SA(0, 0), cA, voffA); PG8_STAGE(PG8_SA(0, 1), cA + hstep, voffA);
        if (wr == 1) PG8_BAR;
        PG8_WAIT_V(2); PG8_BAR;
        PG8_STAGE(PG8_SB(1, 0), cB + kstep, voffB); PG8_STAGE(PG8_SA(1, 0), cA + kstep, voffA); PG8_STAGE(PG8_SB(1, 1), cB + hstep + kstep, voffB);
        PG8_WAIT_V(6); PG8_BAR;
    } else {
        PG8_STAGE(PG8_SB(0, 0), cB, voffB); PG8_STAGE(PG8_SA(0, 0), cA, voffA); PG8_STAGE(PG8_SB(0, 1), cB + hstep, voffB); PG8_STAGE(PG8_SA(0, 1), cA + hstep, voffA);
        if (wr == 1) PG8_BAR;
        PG8_WAIT_V(4); PG8_BAR;
        PG8_STAGE(PG8_SB(1, 0), cB + kstep, voffB); PG8_STAGE(PG8_SA(1, 0), cA + kstep, voffA); PG8_STAGE(PG8_SB(1, 1), cB + hstep + kstep, voffB);
        PG8_WAIT_V(6); PG8_BAR;
    }
    for (;;) {
        const bool has_next = S.next(ui + 1, nxt);
        const char* nA = has_next ? (const char*)g.A + (size_t)nxt.pm * tstep : cA; const char* nB = has_next ? (const char*)g.Bt + (size_t)nxt.pn * tstep : cB;
        for (int t = 0; t < nt; t += 2) {
            const bool last = (t == nt - 2);
            const char* a1 = cA + (size_t)(t + 1) * kstep;
            const char* a2 = last ? nA : cA + (size_t)(t + 2) * kstep; const char* b2 = last ? nB : cB + (size_t)(t + 2) * kstep;
            const char* a3 = a2 + kstep; const char* b3 = b2 + kstep;
            if (last && has_next) S.a_ready(nxt);
            if constexpr (SP2) {
            PG8_LDB(B0, 0, 0); PG8_LDB(B1, 0, 1); PG8_SCHED; PG8_LDA(At, 0, 0); PG8_STAGE(PG8_SA(1, 1), a1 + hstep, voffA);
            PG8_WAIT_V(8); PG8_WAIT_L(0); PG8_BAR; PG8_MMA(0, 0, At, B0); PG8_MMA(0, 1, At, B1); PG8_BAR; PG8_SCHED;
            PG8_LDA(At, 0, 1); PG8_STAGE(PG8_SB(0, 0), b2, voffB); PG8_STAGE(PG8_SB(0, 1), b2 + hstep, voffB); PG8_STAGE(PG8_SA(0, 0), a2, voffA);
            PG8_WAIT_V(8); PG8_WAIT_L(0); PG8_BAR; PG8_MMA(1, 0, At, B0); PG8_MMA(1, 1, At, B1); PG8_BAR; PG8_SCHED;
            PG8_LDB(B0, 1, 0); PG8_LDB(B1, 1, 1); PG8_SCHED; PG8_LDA(At, 1, 0); PG8_STAGE(PG8_SA(0, 1), a2 + hstep, voffA);
            PG8_WAIT_V(8); PG8_WAIT_L(0); PG8_BAR; PG8_MMA(0, 0, At, B0); PG8_MMA(0, 1, At, B1); PG8_BAR; PG8_SCHED;
            PG8_LDA(At, 1, 1); PG8_STAGE(PG8_SB(1, 0), b3, voffB); PG8_STAGE(PG8_SB(1, 1), b3 + hstep, voffB); PG8_STAGE(PG8_SA(1, 0), a3, voffA);
            PG8_WAIT_V(8); PG8_WAIT_L(0); PG8_BAR; PG8_MMA(1, 0, At, B0); PG8_MMA(1, 1, At, B1); PG8_BAR; PG8_SCHED;
            } else {
            PG8_LDB(B0, 0, 0); PG8_SCHED; PG8_LDA(At, 0, 0); PG8_STAGE(PG8_SA(1, 1), a1 + hstep, voffA);
            PG8_WAIT_L(8); PG8_BAR; PG8_WAIT_L(0); PG8_MMA(0, 0, At, B0); PG8_BAR; PG8_SCHED;
            PG8_LDB(B1, 0, 1); PG8_STAGE(PG8_SB(0, 0), b2, voffB);
            PG8_BAR; PG8_WAIT_L(0); PG8_MMA(0, 1, At, B1); PG8_BAR;
            PG8_LDA(At, 0, 1); PG8_STAGE(PG8_SA(0, 0), a2, voffA);
            PG8_BAR; PG8_WAIT_L(0); PG8_MMA(1, 0, At, B0); PG8_BAR; PG8_SCHED;
            PG8_STAGE(PG8_SB(0, 1), b2 + hstep, voffB);
            PG8_WAIT_V(6); PG8_BAR; PG8_MMA(1, 1, At, B1); PG8_BAR;
            PG8_LDB(B0, 1, 0); PG8_SCHED; PG8_LDA(At, 1, 0); PG8_STAGE(PG8_SA(0, 1), a2 + hstep, voffA);
            PG8_WAIT_L(8); PG8_BAR; PG8_WAIT_L(0); PG8_MMA(0, 0, At, B0); PG8_BAR; PG8_SCHED;
            PG8_LDB(B1, 1, 1); PG8_STAGE(PG8_SB(1, 0), b3, voffB);
            PG8_BAR; PG8_WAIT_L(0); PG8_MMA(0, 1, At, B1); PG8_BAR;
            PG8_LDA(At, 1, 1); PG8_STAGE(PG8_SA(1, 0), a3, voffA);
            PG8_BAR; PG8_WAIT_L(0); PG8_MMA(1, 0, At, B0); PG8_BAR; PG8_SCHED;
            PG8_STAGE(PG8_SB(1, 1), b3 + hstep, voffB);
            PG8_WAIT_V(6); PG8_BAR; PG8_MMA(1, 1, At, B1); PG8_BAR;
            }
        }
        if constexpr (ALIGN_EPI) { if (wr == 0) PG8_BAR; }
        if constexpr (!Epi::AFTER_DRAIN) { E(acc, cur, wr, wc, fr, fq); S.done(cur); }
        if (!has_next) break;
#pragma unroll
        for (int a = 0; a < 2; ++a)
#pragma unroll
            for (int b = 0; b < 2; ++b)
#pragma unroll
                for (int m = 0; m < 4; ++m)
#pragma unroll
                    for (int n = 0; n < 2; ++n) acc[a][b][m][n] = (f32x4){0.f, 0.f, 0.f, 0.f};
        cur = nxt; cA = nA; cB = nB; ++ui;
        if constexpr (ALIGN_EPI) { if (wr == 1) PG8_BAR; }
    }
    PG8_WAIT_V(0);
    if constexpr (!ALIGN_EPI) { if (wr == 0) PG8_BAR; }
    PG8_BAR;
    if constexpr (Epi::AFTER_DRAIN) { E.fused(acc, cur, wr, wc, fr, fq, lds, wid, lane); S.done(cur); }
#undef PG8_SA
#undef PG8_SB
#undef PG8_STAGE
#undef PG8_LDA
#undef PG8_LDB
#undef PG8_MMA
#undef PG8_WAIT_V
#undef PG8_WAIT_L
#undef PG8_BAR
#undef PG8_SCHED
}
}
#define LAS __attribute__((address_space(3)))
#define XB_TMO      128
#define XB_XCNT(j)  (256  + 64 * (j))
#define XB_XSUB(j)  (1280 + 64 * (j))
#define XB_XGEN(j)  (2304 + 64 * (j))
#define XB_TOP      3328
#define XB_TOPGEN   3392
#define XCD_BAR_WORDS 3456
#define XB_SPIN_CAP (1u << 18)

__device__ __forceinline__ unsigned xb_ld(unsigned* p)              { return __hip_atomic_load(p, __ATOMIC_RELAXED, __HIP_MEMORY_SCOPE_AGENT); }
__device__ __forceinline__ unsigned xb_add(unsigned* p, unsigned v) { return __hip_atomic_fetch_add(p, v, __ATOMIC_RELAXED, __HIP_MEMORY_SCOPE_AGENT); }
__device__ __forceinline__ unsigned xb_xcc_id() { return (unsigned)__builtin_amdgcn_s_getreg((3 << 11) | 20) & 0xFu; }
#define XB_SPIN(cond, bar) do { unsigned _sp = 0; while (cond) { __builtin_amdgcn_s_sleep(1); \
    if ((++_sp & 255u) == 0u) { if (xb_ld(&(bar)[XB_TMO])) break; if (_sp > XB_SPIN_CAP) { atomicAdd(&(bar)[XB_TMO], 1u); break; } } } } while (0)

struct XcdBarrier {
    unsigned* bar; unsigned x;
    volatile LAS unsigned* st;
};

__device__ __forceinline__ XcdBarrier xcd_barrier_post(unsigned* bar, volatile LAS unsigned* st, int ktid) {
    XcdBarrier b; b.bar = bar; b.x = xb_xcc_id(); b.st = st;
    if (ktid == 0) (void)xb_add(&bar[XB_XCNT(b.x)], 1u);
    return b;
}
__device__ __forceinline__ void xcd_barrier_complete(unsigned* bar, unsigned x, unsigned& nloc, unsigned& nx) {
    const unsigned G = gridDim.x * gridDim.y * gridDim.z;
    unsigned sum, cnt, mine, sp = 0u;
    for (;;) {
        sum = 0u; cnt = 0u; mine = 0u;
#pragma unroll
        for (unsigned j = 0; j < 16; ++j) { const unsigned c = xb_ld(&bar[XB_XCNT(j)]); sum += c; cnt += (c > 0u) ? 1u : 0u; mine = (j == x) ? c : mine; }
        if (sum == G) break;
        __builtin_amdgcn_s_sleep(1);
        if ((++sp & 255u) == 0u) { if (xb_ld(&bar[XB_TMO])) break; if (sp > XB_SPIN_CAP) { atomicAdd(&bar[XB_TMO], 1u); break; } }
    }
    nloc = mine > 0u ? mine : 1u; nx = cnt > 0u ? cnt : 1u;
}

__device__ __forceinline__ void xcd_barrier(const XcdBarrier& b, int ktid) {
    asm volatile("s_waitcnt vmcnt(0)" ::: "memory");
    __syncthreads();
    if (ktid == 0) {
        unsigned* bar = b.bar; const unsigned bx_ = xb_xcc_id();
        __builtin_amdgcn_s_waitcnt(0);
        unsigned nloc = b.st[0], nx = b.st[1];
        if (nloc == 0u) { xcd_barrier_complete(bar, bx_, nloc, nx); b.st[0] = nloc; b.st[1] = nx; }
        const unsigned old = xb_add(&bar[XB_XSUB(bx_)], 1u);
        const unsigned gen = old / nloc;
        if (old + 1u == (gen + 1u) * nloc) {
            __builtin_amdgcn_fence(__ATOMIC_RELEASE, "agent");
            asm volatile("s_waitcnt vmcnt(0)" ::: "memory");
            const unsigned og = xb_add(&bar[XB_TOP], 1u);
            const unsigned tg = og / nx;
            if (og + 1u == (tg + 1u) * nx) xb_add(&bar[XB_TOPGEN], 1u);
            else XB_SPIN(xb_ld(&bar[XB_TOPGEN]) == tg, bar);
            __builtin_amdgcn_fence(__ATOMIC_ACQUIRE, "agent");
            xb_add(&bar[XB_XGEN(bx_)], 1u);
            asm volatile("s_waitcnt vmcnt(0)" ::: "memory");
        } else {
            XB_SPIN(xb_ld(&bar[XB_XGEN(bx_)]) == gen, bar);
            __builtin_amdgcn_fence(__ATOMIC_ACQUIRE, "agent");
            asm volatile("s_waitcnt vmcnt(0)" ::: "memory");
        }
    }
    __syncthreads();
}
#undef LAS
using namespace pg8;
#define LAS __attribute__((address_space(3)))
typedef unsigned u32x2 __attribute__((ext_vector_type(2)));

constexpr int NWAVES = 8, NTHR = 512;
constexpr int SEQ = 8192, NBATCH = 2, T = NBATCH * SEQ, D = 1024, DZ0 = 2560, DZ1 = 2048, DFF = 2816, NGU = 2 * DFF, NMEM = 256;
constexpr float RMS_EPS = 1e-6f, LN_EPS = 1e-5f;
constexpr size_t MiB = 1u << 20;
constexpr size_t WS_CTL = 0, CTL_ZERO_BYTES = 64 * 1024;
constexpr size_t WS_W = 2 * MiB, W_LAYER = 32 * MiB;
constexpr size_t W_IN = 0, W_OUT = 5 * MiB, W_Q = 7 * MiB, W_KV = 9 * MiB, W_O = 13 * MiB, W_GU = 15 * MiB, W_DN = 26 * MiB;
constexpr size_t WS_WSB = 66 * MiB;
constexpr size_t WS_SSQ = 67 * MiB;
constexpr size_t WS_VST = 68 * MiB;
constexpr size_t WS_MEMN = 70 * MiB;
constexpr size_t WS_KB = 72 * MiB;
constexpr size_t WS_VT = 74 * MiB;
constexpr size_t WS_HB = 76 * MiB;
constexpr size_t WS_MB = 108 * MiB;
constexpr size_t WS_BIG = 140 * MiB;
constexpr size_t WS_END = 228 * MiB;
constexpr int LDS_BYTES = 147456, MISC_OFF = 139264;

__device__ __forceinline__ float wave_sum(float v) {
#pragma unroll
    for (int o = 1; o < 64; o <<= 1) v += __shfl_xor(v, o);
    return v;
}
__device__ __forceinline__ float bf2f(unsigned short b) { return __uint_as_float((unsigned)b << 16); }
__device__ __forceinline__ float bflo(unsigned w) { return __uint_as_float(w << 16); }
__device__ __forceinline__ float bfhi(unsigned w) { return __uint_as_float(w & 0xffff0000u); }
__device__ __forceinline__ unsigned short f2bf(float f) { return (unsigned short)(cvt_pk_bf16(f, 0.f) & 0xffffu); }
__device__ __forceinline__ float sigm(float x) { return __builtin_amdgcn_rcpf(1.f + __builtin_amdgcn_exp2f(-1.44269504f * x)); }
__device__ __forceinline__ float gelu_tanh(float x) { const float y = 1.5957691216f * (x + 0.044715f * x * x * x); return x * sigm(y); }

__device__ __forceinline__ float row_rstd(const float* ssq, int row, int fq) {
    const f32x4 a = *(const f32x4*)(ssq + (size_t)row * 16 + 4 * fq);
    float s = (a[0] + a[1]) + (a[2] + a[3]);
    s += __shfl_xor(s, 16); s += __shfl_xor(s, 32);
    return rsqrtf(s * (1.0f / 1024.0f) + RMS_EPS);
}
__device__ __forceinline__ u32x4 pack8(const f32x4 v0, const f32x4 v1) { u32x4 w; w.x = cvt_pk_bf16(v0[0], v0[1]); w.y = cvt_pk_bf16(v0[2], v0[3]); w.z = cvt_pk_bf16(v1[0], v1[1]); w.w = cvt_pk_bf16(v1[2], v1[3]); return w; }

struct EpiScale {
    static constexpr bool PERM = true, AFTER_DRAIN = false;
    bf16_t* O; int ldc; const float* ssq;
    __device__ __forceinline__ void operator()(const f32x4 (&acc)[2][2][4][2], const Unit& u, int wr, int wc, int fr, int fq) const {
        const int row0 = u.pm * BM + wr * 64 + fr, col0 = u.pn * BM + wc * 32 + 8 * fq;
#pragma unroll
        for (int ai = 0; ai < 2; ++ai)
#pragma unroll
            for (int m = 0; m < 4; ++m) { const int row = row0 + ai * HALF + m * 16; const float rs = ssq ? row_rstd(ssq, row, fq) : 1.f; bf16_t* rowp = O + (size_t)row * ldc + col0;
#pragma unroll
                for (int bj = 0; bj < 2; ++bj) *(u32x4*)(rowp + bj * HALF) = pack8(acc[ai][bj][m][0] * rs, acc[ai][bj][m][1] * rs); }
    }
};
constexpr int DZ3 = 1536;
struct EpiZ0 {
    static constexpr bool PERM = true, AFTER_DRAIN = false;
    bf16_t* O; const float* ssq;
    __device__ __forceinline__ void operator()(const f32x4 (&acc)[2][2][4][2], const Unit& u, int wr, int wc, int fr, int fq) const {
        const int row0 = u.pm * BM + wr * 64 + fr, cin = wc * 32 + 8 * fq;
#pragma unroll
        for (int ai = 0; ai < 2; ++ai)
#pragma unroll
            for (int m = 0; m < 4; ++m) { const int row = row0 + ai * HALF + m * 16; const float rs = row_rstd(ssq, row, fq); bf16_t* rowp = O + (size_t)row * DZ3;
                if (u.pn >= 8) {
#pragma unroll
                    for (int bj = 0; bj < 2; ++bj) *(u32x4*)(rowp + 1024 + (u.pn - 8) * BM + bj * HALF + cin) = pack8(acc[ai][bj][m][0] * rs, acc[ai][bj][m][1] * rs);
                } else { f32x4 h[2];
#pragma unroll
                    for (int n = 0; n < 2; ++n)
#pragma unroll
                        for (int j = 0; j < 4; ++j) { const float p = acc[ai][0][m][n][j] * rs, q = acc[ai][1][m][n][j] * rs; h[n][j] = u.pn < 4 ? p * sigm(q) : p * q; }
                    *(u32x4*)(rowp + u.pn * HALF + cin) = pack8(h[0], h[1]); } }
    }
};
struct EpiRes {
    static constexpr bool PERM = true, AFTER_DRAIN = false;
    bf16_t* hb; float* ssq;
    __device__ __forceinline__ void operator()(const f32x4 (&acc)[2][2][4][2], const Unit& u, int wr, int wc, int fr, int fq) const {
        const int row0 = u.pm * BM + wr * 64 + fr, col0 = u.pn * BM + wc * 32 + 8 * fq;
#pragma unroll
        for (int ai = 0; ai < 2; ++ai)
#pragma unroll
            for (int m = 0; m < 4; ++m) { const int row = row0 + ai * HALF + m * 16; const size_t off = (size_t)row * D + col0; float q = 0.f;
#pragma unroll
                for (int bj = 0; bj < 2; ++bj) { const u32x4 bb = *(const u32x4*)(hb + off + bj * HALF);
                    const f32x4 b0 = (f32x4){bflo(bb.x), bfhi(bb.x), bflo(bb.y), bfhi(bb.y)}, b1 = (f32x4){bflo(bb.z), bfhi(bb.z), bflo(bb.w), bfhi(bb.w)};
                    const f32x4 v0 = b0 + acc[ai][bj][m][0], v1 = b1 + acc[ai][bj][m][1];
                    *(u32x4*)(hb + off + bj * HALF) = pack8(v0, v1);
                    q += ((v0[0] * v0[0] + v0[1] * v0[1]) + (v0[2] * v0[2] + v0[3] * v0[3])) + ((v1[0] * v1[0] + v1[1] * v1[1]) + (v1[2] * v1[2] + v1[3] * v1[3])); }
                q += __shfl_xor(q, 16); q += __shfl_xor(q, 32);
                if (fq == 0) ssq[(size_t)row * 16 + u.pn * 4 + wc] = q; }
    }
};
struct EpiGU {
    static constexpr bool PERM = true, AFTER_DRAIN = false;
    bf16_t* O; const float* ssq;
    __device__ __forceinline__ void operator()(const f32x4 (&acc)[2][2][4][2], const Unit& u, int wr, int wc, int fr, int fq) const {
        const int row0 = u.pm * BM + wr * 64 + fr, col0 = u.pn * HALF + wc * 32 + 8 * fq;
#pragma unroll
        for (int ai = 0; ai < 2; ++ai)
#pragma unroll
            for (int m = 0; m < 4; ++m) { const int row = row0 + ai * HALF + m * 16; const float rs = row_rstd(ssq, row, fq);
                f32x4 h[2];
#pragma unroll
                for (int n = 0; n < 2; ++n)
#pragma unroll
                    for (int j = 0; j < 4; ++j) { const float g = acc[ai][0][m][n][j] * rs, up = acc[ai][1][m][n][j] * rs; h[n][j] = g * sigm(g) * up; }
                *(u32x4*)(O + (size_t)row * DFF + col0) = pack8(h[0], h[1]); }
    }
};
struct EpiZ1 {
    static constexpr bool PERM = true, AFTER_DRAIN = false;
    bf16_t* O; const float* ssq; float* vst;
    __device__ __forceinline__ void operator()(const f32x4 (&acc)[2][2][4][2], const Unit& u, int wr, int wc, int fr, int fq) const {
        const int row0 = u.pm * BM + wr * 64 + fr, col0 = u.pn * BM + wc * 32 + 8 * fq;
#pragma unroll
        for (int ai = 0; ai < 2; ++ai)
#pragma unroll
            for (int m = 0; m < 4; ++m) { const int row = row0 + ai * HALF + m * 16; const float rs = row_rstd(ssq, row, fq); bf16_t* rowp = O + (size_t)row * DZ1 + col0; float s = 0.f, q = 0.f;
#pragma unroll
                for (int bj = 0; bj < 2; ++bj) { f32x4 v[2];
#pragma unroll
                    for (int n = 0; n < 2; ++n)
#pragma unroll
                        for (int j = 0; j < 4; ++j) { const float g = gelu_tanh(acc[ai][bj][m][n][j] * rs); v[n][j] = g; s += g; q += g * g; }
                    *(u32x4*)(rowp + bj * HALF) = pack8(v[0], v[1]); }
                if (u.pn >= 4) { s += __shfl_xor(s, 16); s += __shfl_xor(s, 32); q += __shfl_xor(q, 16); q += __shfl_xor(q, 32);
                    if (fq == 0) { float* p = vst + ((size_t)row * 16 + (u.pn - 4) * 4 + wc) * 2; p[0] = s; p[1] = q; } } }
    }
};
struct EpiKV {
    static constexpr bool PERM = true, AFTER_DRAIN = false;
    bf16_t* Kb; bf16_t* Vt;
    __device__ __forceinline__ void operator()(const f32x4 (&acc)[2][2][4][2], const Unit& u, int wr, int wc, int fr, int fq) const {
        const int col0 = (u.pn & 3) * BM + wc * 32 + 8 * fq;
#pragma unroll
        for (int ai = 0; ai < 2; ++ai)
#pragma unroll
            for (int m = 0; m < 4; ++m) { const int key = ai * HALF + wr * 64 + m * 16 + fr;
                if (u.pn < 4) { bf16_t* rowp = Kb + (size_t)(u.pm * BM + key) * D + col0;
#pragma unroll
                    for (int bj = 0; bj < 2; ++bj) *(u32x4*)(rowp + bj * HALF) = pack8(acc[ai][bj][m][0], acc[ai][bj][m][1]);
                } else { const int kp = (key & ~31) + 8 * ((key >> 2) & 3) + 4 * ((key >> 4) & 1) + (key & 3);
#pragma unroll
                    for (int bj = 0; bj < 2; ++bj)
#pragma unroll
                        for (int n = 0; n < 2; ++n)
#pragma unroll
                            for (int j = 0; j < 4; ++j) Vt[((size_t)u.pm * D + col0 + bj * HALF + 4 * n + j) * NMEM + kp] = f2bf(acc[ai][bj][m][n][j]); } }
    }
};

__device__ __forceinline__ void tr_item(const float* W, int K, int N, bf16_t* WT, const float* g, float cs, int mode, LAS float* scr, int item, int lane) {
    const int nblk = N / 64, kb = item / nblk, nb = item % nblk, k0 = 64 * kb, n0 = 64 * nb;
    int orow;
    if (mode == 3) {
        const int sec = n0 >> 9, np = n0 & 511, il = (np >> 7) * 256 + (np & 127);
        orow = sec == 0 ? il : sec == 1 ? il + 128 : sec == 2 ? 1024 + il : sec == 3 ? 2048 + np : 1024 + il + 128;
    } else orow = mode == 0 ? n0 : ((n0 >> 7) * 256 + (n0 & 127) + (mode == 2 ? 128 : 0));
    const int kq = lane >> 4, n4 = (lane & 15) * 4;
    f32x4 v[16]; float sc[16];
#pragma unroll
    for (int i = 0; i < 16; ++i) { const int kk = 4 * i + kq; v[i] = *(const f32x4*)(W + (size_t)(k0 + kk) * N + n0 + n4); sc[i] = g ? g[k0 + kk] * cs : cs; }
    __builtin_amdgcn_sched_barrier(0);
#pragma unroll
    for (int i = 0; i < 16; ++i) { const int kk = 4 * i + kq; LAS float* d = scr + kk * 65 + n4; d[0] = v[i][0] * sc[i]; d[1] = v[i][1] * sc[i]; d[2] = v[i][2] * sc[i]; d[3] = v[i][3] * sc[i]; }
    asm volatile("s_waitcnt lgkmcnt(0)" ::: "memory");
    const int c = lane & 7;
#pragma unroll
    for (int j = 0; j < 8; ++j) { const int n = (lane >> 3) + 8 * j; const LAS float* p = scr + (8 * c) * 65 + n;
        u32x4 o; o.x = cvt_pk_bf16(p[0 * 65], p[1 * 65]); o.y = cvt_pk_bf16(p[2 * 65], p[3 * 65]); o.z = cvt_pk_bf16(p[4 * 65], p[5 * 65]); o.w = cvt_pk_bf16(p[6 * 65], p[7 * 65]);
        *(u32x4*)(WT + (size_t)(orow + n) * K + k0 + 8 * c) = o; }
    asm volatile("s_waitcnt lgkmcnt(0)" ::: "memory");
}

struct Args { const float* in[28]; float* out; unsigned char* ws; };

__device__ __forceinline__ void p0_weights(const Args& a, int l, int part, LAS unsigned char* lds, int gw, int NGW, int wave, int lane) {
    unsigned char* ws = a.ws;
    LAS float* scr = (LAS float*)(lds + wave * 16640);
    const float QS = 0.0625f * 1.44269504f;
    const int NIN = l ? DZ1 : DZ0, I_IN = 16 * (NIN / 64);
    constexpr int I_SQ = 16 * 16, I_GU = 16 * (DFF / 64), I_DN = (DFF / 64) * 16;
    const int I_KV = (part == 0 || part == 1) ? I_SQ : 0, I_A = (part == 0 || part == 3) ? I_IN : 0, I_S = (part == 0 || part == 3) ? I_SQ : 0, I_G = (part == 0 || part == 4) ? I_GU : 0, I_D = (part == 0 || part == 4) ? I_DN : 0;
    const int NITEMS = I_A + 3 * I_S + 2 * I_KV + 2 * I_G + I_D;
    unsigned char* wl = ws + WS_W + (size_t)l * W_LAYER;
    for (int it = gw; it < NITEMS; it += NGW) {
        int r = it; bool found = false; const float* W = nullptr; int K = 0, N = 0, mode = 0; bf16_t* WT = nullptr; const float* gv = nullptr; float cs = 1.f;
#define SEL(NI, Wp, K_, N_, WTp, g_, cs_, mode_) if (!found) { if (r < (NI)) { W = (Wp); K = (K_); N = (N_); WT = (bf16_t*)(WTp); gv = (g_); cs = (cs_); mode = (mode_); found = true; } else r -= (NI); }
        SEL(I_A, l ? a.in[15] : a.in[7], D, NIN, wl + W_IN, a.in[2] + l * D, 1.f, l ? 0 : 3)
        SEL(I_S, l ? a.in[20] : a.in[14], D, D, wl + W_OUT, nullptr, 1.f, 0)
        SEL(I_S, a.in[21] + (size_t)l * D * D, D, D, wl + W_Q, a.in[3] + l * D, QS, 0)
        SEL(I_KV, a.in[22] + (size_t)l * D * D, D, D, wl + W_KV, nullptr, 1.f, 0)
        SEL(I_KV, a.in[23] + (size_t)l * D * D, D, D, wl + W_KV + (size_t)D * D * 2, nullptr, 1.f, 0)
        SEL(I_S, a.in[24] + (size_t)l * D * D, D, D, wl + W_O, nullptr, 1.f, 0)
        SEL(I_G, a.in[25] + (size_t)l * D * DFF, D, DFF, wl + W_GU, a.in[5] + l * D, 1.f, 1)
        SEL(I_G, a.in[26] + (size_t)l * D * DFF, D, DFF, wl + W_GU, a.in[5] + l * D, 1.f, 2)
        SEL(I_D, a.in[27] + (size_t)l * D * DFF, DFF, D, wl + W_DN, nullptr, 1.f, 0)
#undef SEL
        tr_item(W, K, N, WT, gv, cs, mode, scr, r, lane);
    }
}
__device__ __forceinline__ void p0_prologue(const Args& a, LAS unsigned char* lds, int gw, int NGW, int wave, int lane) {
    unsigned char* ws = a.ws;
    { const f32x4* src = (const f32x4*)a.in[18]; u32x2* dst = (u32x2*)(ws + WS_WSB);
      for (int i = gw * 64 + lane; i < 8 * 128 * 128 / 4; i += NGW * 64) { const f32x4 v = src[i]; u32x2 o; o.x = cvt_pk_bf16(v[0], v[1]); o.y = cvt_pk_bf16(v[2], v[3]); dst[i] = o; } }
    { float* ssq = (float*)(ws + WS_SSQ); bf16_t* HB = (bf16_t*)(ws + WS_HB);
      for (int m0 = gw * 4; m0 < T; m0 += NGW * 4) {
          f32x4 v[4][4];
#pragma unroll
          for (int r = 0; r < 4; ++r) { const f32x4* xr = (const f32x4*)(a.in[0] + (size_t)(m0 + r) * D) + lane;
#pragma unroll
              for (int j = 0; j < 4; ++j) v[r][j] = xr[64 * j]; }
          __builtin_amdgcn_sched_barrier(0);
#pragma unroll
          for (int r = 0; r < 4; ++r) { float s = 0.f;
#pragma unroll
              for (int j = 0; j < 4; ++j) s += (v[r][j][0] * v[r][j][0] + v[r][j][1] * v[r][j][1]) + (v[r][j][2] * v[r][j][2] + v[r][j][3] * v[r][j][3]);
              s = wave_sum(s);
              u32x2* o = (u32x2*)(HB + (size_t)(m0 + r) * D) + lane;
#pragma unroll
              for (int j = 0; j < 4; ++j) { u32x2 w; w.x = cvt_pk_bf16(v[r][j][0], v[r][j][1]); w.y = cvt_pk_bf16(v[r][j][2], v[r][j][3]); o[64 * j] = w; }
              if (lane < 16) ssq[(size_t)(m0 + r) * 16 + lane] = lane == 0 ? s : 0.f; }
      } }
    { bf16_t* MN = (bf16_t*)(ws + WS_MEMN);
      for (int m = gw; m < 2 * 512; m += NGW) { const int l = m >> 9, row = m & 511;
          const f32x4* xr = (const f32x4*)(a.in[1] + (size_t)row * D) + lane; const f32x4* gr = (const f32x4*)(a.in[4] + l * D) + lane; f32x4 v[4]; float s = 0.f;
#pragma unroll
          for (int j = 0; j < 4; ++j) { v[j] = xr[64 * j]; s += (v[j][0] * v[j][0] + v[j][1] * v[j][1]) + (v[j][2] * v[j][2] + v[j][3] * v[j][3]); }
          const float rs = rsqrtf(wave_sum(s) * (1.0f / 1024.0f) + RMS_EPS);
          u32x2* o = (u32x2*)(MN + ((size_t)l * 512 + row) * D) + lane;
#pragma unroll
          for (int j = 0; j < 4; ++j) { const f32x4 g = gr[64 * j]; u32x2 w; w.x = cvt_pk_bf16(v[j][0] * rs * g[0], v[j][1] * rs * g[1]); w.y = cvt_pk_bf16(v[j][2] * rs * g[2], v[j][3] * rs * g[3]); o[64 * j] = w; }
      } }
}

__device__ __forceinline__ void unpack8(const u32x4 r, float (&v)[8]) { v[0] = bflo(r.x); v[1] = bfhi(r.x); v[2] = bflo(r.y); v[3] = bfhi(r.y); v[4] = bflo(r.z); v[5] = bfhi(r.z); v[6] = bflo(r.w); v[7] = bfhi(r.w); }
__device__ __forceinline__ void conv_phase(LAS unsigned char* lds, const bf16_t* Z, bf16_t* Mo, const float* cw, const float* cb, const float* lg, const float* lb,
                                           const float* bw, const float* bb, int G, int c, int tid_in) {
    constexpr int TT = 32, RR = TT + 30;
    int tid_ = tid_in; asm volatile("" : "+v"(tid_)); asm volatile("" : "+s"(c), "+s"(G));
    const int tid = tid_, lane = tid & 63, wid = tid >> 6;
    LAS float* as = (LAS float*)lds;
    LAS float* os = (LAS float*)lds;
    for (int u = c; u < G; ++u) {
        const int t0 = u * TT, b = t0 / SEQ, s0 = t0 % SEQ;
        const bf16_t* zb = Z + (size_t)b * SEQ * DZ3;
        __syncthreads();
        { u32x4 rv[8];
#pragma unroll
          for (int i = 0; i < 8; ++i) { const int idx = tid + 512 * i, r = idx >> 6, cc = idx & 63, sq = s0 - 15 + r; const bool ok = (idx < RR * 64) && (sq >= 0) && (sq < SEQ);
              rv[i] = *(const u32x4*)(zb + (size_t)(ok ? sq : s0) * DZ3 + cc * 8);
              if (!ok) rv[i] = (u32x4){0u, 0u, 0u, 0u}; }
          __builtin_amdgcn_sched_barrier(0);
#pragma unroll
          for (int i = 0; i < 8; ++i) { const int idx = tid + 512 * i, r = idx >> 6, cc = idx & 63; float v[8]; unpack8(rv[i], v);
              if (idx < RR * 64) { *(LAS f32x4*)(as + r * 512 + cc * 8) = (f32x4){v[0], v[1], v[2], v[3]}; *(LAS f32x4*)(as + r * 512 + cc * 8 + 4) = (f32x4){v[4], v[5], v[6], v[7]}; } } }
        __syncthreads();
        float o[TT];
        { float w[31]; const float* cw_ = cw; const float* cb_ = cb; asm volatile("" : "+s"(cw_), "+s"(cb_));
#pragma unroll
          for (int k = 0; k < 31; ++k) w[k] = cw_[k * 512 + tid];
          const float cbias = cb_[tid];
          float av[RR];
#pragma unroll
          for (int r = 0; r < RR; ++r) av[r] = as[r * 512 + tid];
#pragma unroll
          for (int t = 0; t < TT; ++t) { float acc = cbias;
#pragma unroll
              for (int k = 0; k < 31; ++k) acc += w[k] * av[t + k];
              o[t] = acc; } }
        __syncthreads();
#pragma unroll
        for (int t = 0; t < TT; ++t) os[t * 512 + tid] = o[t];
        __syncthreads();
        { const float* lg_ = lg; const float* lb_ = lb; asm volatile("" : "+s"(lg_), "+s"(lb_));
          const f32x4 g0 = *(const f32x4*)(lg_ + 8 * lane), g1 = *(const f32x4*)(lg_ + 8 * lane + 4), b0 = *(const f32x4*)(lb_ + 8 * lane), b1 = *(const f32x4*)(lb_ + 8 * lane + 4);
#pragma unroll
          for (int i = 0; i < TT / 8; ++i) { const int t = (TT / 8) * wid + i;
              const f32x4 v0 = *(const LAS f32x4*)(os + t * 512 + 8 * lane), v1 = *(const LAS f32x4*)(os + t * 512 + 8 * lane + 4);
              const float mean = wave_sum(((v0[0] + v0[1]) + (v0[2] + v0[3])) + ((v1[0] + v1[1]) + (v1[2] + v1[3]))) * (1.0f / 512.0f);
              const f32x4 d0 = v0 - mean, d1 = v1 - mean;
              const float var = wave_sum(((d0[0] * d0[0] + d0[1] * d0[1]) + (d0[2] * d0[2] + d0[3] * d0[3])) + ((d1[0] * d1[0] + d1[1] * d1[1]) + (d1[2] * d1[2] + d1[3] * d1[3]))) * (1.0f / 512.0f);
              const float rstd = rsqrtf(var + LN_EPS);
              f32x4 y0 = d0 * rstd * g0 + b0, y1 = d1 * rstd * g1 + b1;
#pragma unroll
              for (int j = 0; j < 4; ++j) { y0[j] = y0[j] * sigm(y0[j]); y1[j] = y1[j] * sigm(y1[j]); }
              *(u32x4*)(Mo + (size_t)(t0 + t) * D + 8 * lane) = pack8(y0, y1); } }
        { const int cc = tid & 63, rgp = tid >> 6, sb = s0 + 4 * rgp;
          u32x4 xx[6], gb[4];
#pragma unroll
          for (int r = 0; r < 6; ++r) { const int sq = sb - 1 + r; const bool ok = (sq >= 0) && (sq < SEQ); const bf16_t* p = zb + (size_t)(ok ? sq : s0) * DZ3 + cc * 8;
              xx[r] = *(const u32x4*)(p + 512); if (!ok) xx[r] = (u32x4){0u, 0u, 0u, 0u};
              if (r >= 1 && r <= 4) gb[r - 1] = *(const u32x4*)(p + 1024); }
          const float* bw_ = bw; const float* bb_ = bb; asm volatile("" : "+s"(bw_), "+s"(bb_));
          const f32x4 w0a = *(const f32x4*)(bw_ + cc * 8), w0b = *(const f32x4*)(bw_ + cc * 8 + 4), w1a = *(const f32x4*)(bw_ + 512 + cc * 8), w1b = *(const f32x4*)(bw_ + 512 + cc * 8 + 4),
                      w2a = *(const f32x4*)(bw_ + 1024 + cc * 8), w2b = *(const f32x4*)(bw_ + 1024 + cc * 8 + 4), bba = *(const f32x4*)(bb_ + cc * 8), bbb = *(const f32x4*)(bb_ + cc * 8 + 4);
          __builtin_amdgcn_sched_barrier(0);
          float x[6][8];
#pragma unroll
          for (int r = 0; r < 6; ++r) unpack8(xx[r], x[r]);
#pragma unroll
          for (int t = 0; t < 4; ++t) { float gbv[8]; unpack8(gb[t], gbv); f32x4 y0, y1;
#pragma unroll
              for (int j = 0; j < 4; ++j) { y0[j] = gbv[j] * (w0a[j] * x[t][j] + w1a[j] * x[t + 1][j] + w2a[j] * x[t + 2][j] + bba[j]);
                  y1[j] = gbv[4 + j] * (w0b[j] * x[t][4 + j] + w1b[j] * x[t + 1][4 + j] + w2b[j] * x[t + 2][4 + j] + bbb[j]); }
              *(u32x4*)(Mo + (size_t)(t0 + 4 * rgp + t) * D + 512 + cc * 8) = pack8(y0, y1); } }
    }
}

__device__ __forceinline__ void sgu_phase(LAS unsigned char* lds, const bf16_t* Z1, const float* vst, const bf16_t* Wsb, const float* bs, const float* lg, const float* lb, bf16_t* Y, int G, int c, int tid_in) {
    constexpr int RS = 272;
    int tid_ = tid_in; asm volatile("" : "+v"(tid_)); asm volatile("" : "+s"(c), "+s"(G));
    const int tid = tid_, lane = tid & 63, wid = tid >> 6, fr = lane & 15, fq = lane >> 4;
    LAS unsigned char* Wl = lds; LAS unsigned char* Vl = lds + 128 * RS;
    for (int u = c; u < G; ++u) {
        const int n = u >> 3, g = u & 7, t0 = n * 128, cg0 = g * 128;
        const int q = tid & 127, qc = tid >> 7;
        u32x4 wt[4], vr[4]; f32x4 sp[8];
#pragma unroll
        for (int i = 0; i < 4; ++i) { const int idx = tid + 512 * i, p = idx >> 4, chn = idx & 15; wt[i] = *(const u32x4*)(Wsb + ((size_t)g * 128 + p) * 128 + chn * 8); }
#pragma unroll
        for (int i = 0; i < 4; ++i) vr[i] = *(const u32x4*)(Z1 + (size_t)(t0 + q) * DZ1 + 1024 + cg0 + qc * 32 + i * 8);
#pragma unroll
        for (int j = 0; j < 8; ++j) sp[j] = *(const f32x4*)(vst + (size_t)(t0 + q) * 32 + 4 * j);
        const int pr = 16 * wid + fr, row = t0 + pr;
        u32x2 uu[8];
#pragma unroll
        for (int cb = 0; cb < 8; ++cb) uu[cb] = *(const u32x2*)(Z1 + (size_t)row * DZ1 + cg0 + 16 * cb + 4 * fq);
        const float bias = bs[g * 128 + pr];
        __builtin_amdgcn_sched_barrier(0);
        __syncthreads();
#pragma unroll
        for (int i = 0; i < 4; ++i) { const int idx = tid + 512 * i, p = idx >> 4, chn = idx & 15; *(LAS u32x4*)(Wl + p * RS + chn * 16) = wt[i]; }
        { float s1 = 0.f, s2 = 0.f;
#pragma unroll
          for (int j = 0; j < 8; ++j) { s1 += sp[j][0] + sp[j][2]; s2 += sp[j][1] + sp[j][3]; }
          const float mean = s1 * (1.0f / 1024.0f), var = s2 * (1.0f / 1024.0f) - mean * mean, rstd = rsqrtf(var + LN_EPS);
#pragma unroll
          for (int i = 0; i < 4; ++i) { const int c0 = qc * 32 + i * 8; float v[8]; unpack8(vr[i], v);
              const f32x4 g0 = *(const f32x4*)(lg + cg0 + c0), g1 = *(const f32x4*)(lg + cg0 + c0 + 4), b0 = *(const f32x4*)(lb + cg0 + c0), b1 = *(const f32x4*)(lb + cg0 + c0 + 4);
#pragma unroll
              for (int j = 0; j < 8; ++j) { const float gg = j < 4 ? g0[j & 3] : g1[j & 3], bbv = j < 4 ? b0[j & 3] : b1[j & 3];
                  *(LAS bf16_t*)(Vl + (c0 + j) * RS + q * 2) = f2bf((v[j] - mean) * rstd * gg + bbv); } } }
        __syncthreads();
        bf16x8 wf[4];
#pragma unroll
        for (int ks = 0; ks < 4; ++ks) wf[ks] = *(const LAS bf16x8*)(Wl + (16 * wid + fr) * RS + (32 * ks + 8 * fq) * 2);
        f32x4 acc[8];
#pragma unroll
        for (int cb = 0; cb < 8; ++cb) { acc[cb] = (f32x4){0.f, 0.f, 0.f, 0.f};
#pragma unroll
            for (int ks = 0; ks < 4; ++ks) { const bf16x8 vf = *(const LAS bf16x8*)(Vl + (16 * cb + fr) * RS + (32 * ks + 8 * fq) * 2);
                acc[cb] = __builtin_amdgcn_mfma_f32_16x16x32_bf16(vf, wf[ks], acc[cb], 0, 0, 0); } }
#pragma unroll
        for (int cb = 0; cb < 8; ++cb) { const int cc = cg0 + 16 * cb + 4 * fq;
            u32x2 o; o.x = cvt_pk_bf16(bflo(uu[cb].x) * (acc[cb][0] + bias), bfhi(uu[cb].x) * (acc[cb][1] + bias)); o.y = cvt_pk_bf16(bflo(uu[cb].y) * (acc[cb][2] + bias), bfhi(uu[cb].y) * (acc[cb][3] + bias));
            *(u32x2*)(Y + (size_t)row * D + cc) = o; }
    }
}

__device__ __forceinline__ void attn_phase(LAS unsigned char* lds, const bf16_t* Q, const bf16_t* Kb, const bf16_t* Vt, bf16_t* O, int G, int c, int tid_in) {
    constexpr int RS = 528;
    int tid_ = tid_in; asm volatile("" : "+v"(tid_)); asm volatile("" : "+s"(c), "+s"(G));
    const int tid = tid_, lane = tid & 63, wid = tid >> 6, fr = lane & 15, fq = lane >> 4;
    for (int u = c; u < 512; u += G) {
        const int qb = u >> 2, h = u & 3, b = qb >> 6, q0 = qb * 128;
        const bf16_t* qrow = Q + (size_t)(q0 + 16 * wid + fr) * D + h * 256 + 8 * fq;
        bf16x8 qf[8];
#pragma unroll
        for (int ks = 0; ks < 8; ++ks) qf[ks] = *(const bf16x8*)(qrow + 32 * ks);
        __syncthreads();
        { u32x4 tv[16];
#pragma unroll
          for (int i = 0; i < 16; ++i) { const int idx = tid + 512 * i, key = idx >> 5, ch = idx & 31; tv[i] = *(const u32x4*)(Kb + (size_t)(b * 256 + key) * D + h * 256 + ch * 8); }
          __builtin_amdgcn_sched_barrier(0);
#pragma unroll
          for (int i = 0; i < 16; ++i) { const int idx = tid + 512 * i, key = idx >> 5, ch = idx & 31; *(LAS u32x4*)(lds + key * RS + ch * 16) = tv[i]; } }
        __syncthreads();
        f32x4 S[16];
#pragma unroll
        for (int kb = 0; kb < 16; ++kb) { S[kb] = (f32x4){0.f, 0.f, 0.f, 0.f};
#pragma unroll
            for (int ks = 0; ks < 8; ++ks) { const bf16x8 kf = *(const LAS bf16x8*)(lds + (16 * kb + fr) * RS + (32 * ks + 8 * fq) * 2);
                S[kb] = __builtin_amdgcn_mfma_f32_16x16x32_bf16(kf, qf[ks], S[kb], 0, 0, 0); } }
        float mx = -3.0e38f;
#pragma unroll
        for (int kb = 0; kb < 16; ++kb) mx = fmaxf(mx, fmaxf(fmaxf(S[kb][0], S[kb][1]), fmaxf(S[kb][2], S[kb][3])));
        mx = fmaxf(mx, __shfl_xor(mx, 16)); mx = fmaxf(mx, __shfl_xor(mx, 32));
        float l = 0.f;
#pragma unroll
        for (int kb = 0; kb < 16; ++kb)
#pragma unroll
            for (int j = 0; j < 4; ++j) { const float p = __builtin_amdgcn_exp2f(S[kb][j] - mx); S[kb][j] = p; l += p; }
        l += __shfl_xor(l, 16); l += __shfl_xor(l, 32);
        bf16x8 pf[8];
#pragma unroll
        for (int cc = 0; cc < 8; ++cc) { const u32x4 w = pack8(S[2 * cc], S[2 * cc + 1]); pf[cc] = __builtin_bit_cast(bf16x8, w); }
        __syncthreads();
        { u32x4 tv[16];
#pragma unroll
          for (int i = 0; i < 16; ++i) { const int idx = tid + 512 * i, d = idx >> 5, ch = idx & 31; tv[i] = *(const u32x4*)(Vt + ((size_t)b * D + h * 256 + d) * NMEM + ch * 8); }
          __builtin_amdgcn_sched_barrier(0);
#pragma unroll
          for (int i = 0; i < 16; ++i) { const int idx = tid + 512 * i, d = idx >> 5, ch = idx & 31; *(LAS u32x4*)(lds + d * RS + ch * 16) = tv[i]; } }
        __syncthreads();
        const float inv = 1.0f / l;
        bf16_t* orow = O + (size_t)(q0 + 16 * wid + fr) * D + h * 256 + 4 * fq;
#pragma unroll
        for (int db = 0; db < 16; ++db) { f32x4 oa = (f32x4){0.f, 0.f, 0.f, 0.f};
#pragma unroll
            for (int cc = 0; cc < 8; ++cc) { const bf16x8 vf = *(const LAS bf16x8*)(lds + (16 * db + fr) * RS + (32 * cc + 8 * fq) * 2);
                oa = __builtin_amdgcn_mfma_f32_16x16x32_bf16(vf, pf[cc], oa, 0, 0, 0); }
            u32x2 o; o.x = cvt_pk_bf16(oa[0] * inv, oa[1] * inv); o.y = cvt_pk_bf16(oa[2] * inv, oa[3] * inv);
            *(u32x2*)(orow + 16 * db) = o; }
    }
}

struct EpiQAttn {
    static constexpr bool PERM = true, AFTER_DRAIN = true;
    const float* ssq; const bf16_t* Kb; const bf16_t* Vt; bf16_t* O;
    __device__ __forceinline__ void operator()(const f32x4 (&)[2][2][4][2], const Unit&, int, int, int, int) const {}
    __device__ __forceinline__ void fused(f32x4 (&acc)[2][2][4][2], const Unit& u, int wr, int wc, int fr, int fq, PG8_LAS unsigned char* lds, int wid, int lane) const {
        constexpr int RS = 528;
        const int tid = wid * 64 + lane, h = u.pn, b = u.pm >> 5;
        const unsigned r0 = (unsigned)tid >> 5, ch = (unsigned)tid & 31u;
        const bf16_t* kbase = Kb + (size_t)(b * 256) * D + h * 256; const bf16_t* vbase = Vt + ((size_t)b * D + h * 256) * NMEM;
        const unsigned goffk = r0 * (unsigned)(D * 2) + ch * 16u, goffv = r0 * (unsigned)(NMEM * 2) + ch * 16u, loff = r0 * (unsigned)RS + ch * 16u;
        unsigned loffa = loff, loffb = loff + 7 * 16 * RS; asm volatile("" : "+v"(loffa), "+v"(loffb));
#pragma unroll
        for (int ai = 0; ai < 2; ++ai)
#pragma unroll
            for (int m = 0; m < 4; ++m) { const int lr = ai * HALF + wr * 64 + m * 16 + fr; const float rs = row_rstd(ssq, u.pm * BM + lr, fq);
#pragma unroll
                for (int bj = 0; bj < 2; ++bj) *(PG8_LAS u32x4*)(lds + lr * RS + (bj * HALF + wc * 32 + 8 * fq) * 2) = pack8(acc[ai][bj][m][0] * rs, acc[ai][bj][m][1] * rs); }
        __syncthreads();
        bf16x8 qf[2][8];
#pragma unroll
        for (int qb = 0; qb < 2; ++qb)
#pragma unroll
            for (int ks = 0; ks < 8; ++ks) qf[qb][ks] = *(const PG8_LAS bf16x8*)(lds + (32 * wid + 16 * qb + fr) * RS + (32 * ks + 8 * fq) * 2);
        __builtin_amdgcn_sched_barrier(0);
        u32x4 tv[16];
#pragma unroll
        for (int i = 0; i < 16; ++i) tv[i] = *(const u32x4*)((const char*)kbase + (goffk + (unsigned)(i * 16 * D * 2)));
        __builtin_amdgcn_sched_barrier(0);
        __syncthreads();
#pragma unroll
        for (int i = 0; i < 16; ++i) *(PG8_LAS u32x4*)(lds + (i < 7 ? loffa : loffb) + (i < 7 ? i : i - 7) * 16 * RS) = tv[i];
        __syncthreads();
        unsigned fb0 = (unsigned)(fr * RS + fq * 16), fb1 = fb0 + 8 * 16 * RS; asm volatile("" : "+v"(fb0), "+v"(fb1));
        f32x4 S[2][16];
#pragma unroll
        for (int kb = 0; kb < 16; ++kb) { S[0][kb] = (f32x4){0.f, 0.f, 0.f, 0.f}; S[1][kb] = (f32x4){0.f, 0.f, 0.f, 0.f};
#pragma unroll
            for (int ks = 0; ks < 8; ++ks) { const bf16x8 kf = *(const PG8_LAS bf16x8*)(lds + (kb < 8 ? fb0 : fb1) + ((kb & 7) * 16 * RS + ks * 64));
                S[0][kb] = __builtin_amdgcn_mfma_f32_16x16x32_bf16(kf, qf[0][ks], S[0][kb], 0, 0, 0);
                S[1][kb] = __builtin_amdgcn_mfma_f32_16x16x32_bf16(kf, qf[1][ks], S[1][kb], 0, 0, 0); } }
        __builtin_amdgcn_sched_barrier(0);
        bf16x8 pf[2][8]; float inv[2];
#pragma unroll
        for (int qb = 0; qb < 2; ++qb) {
            float mx = -3.0e38f;
#pragma unroll
            for (int kb = 0; kb < 16; ++kb) mx = fmaxf(mx, fmaxf(fmaxf(S[qb][kb][0], S[qb][kb][1]), fmaxf(S[qb][kb][2], S[qb][kb][3])));
            mx = fmaxf(mx, __shfl_xor(mx, 16)); mx = fmaxf(mx, __shfl_xor(mx, 32));
            float l = 0.f;
#pragma unroll
            for (int kb = 0; kb < 16; ++kb)
#pragma unroll
                for (int j = 0; j < 4; ++j) { const float p = __builtin_amdgcn_exp2f(S[qb][kb][j] - mx); S[qb][kb][j] = p; l += p; }
            l += __shfl_xor(l, 16); l += __shfl_xor(l, 32); inv[qb] = 1.0f / l;
#pragma unroll
            for (int cc = 0; cc < 8; ++cc) { const u32x4 w = pack8(S[qb][2 * cc], S[qb][2 * cc + 1]); pf[qb][cc] = __builtin_bit_cast(bf16x8, w); }
        }
        __builtin_amdgcn_sched_barrier(0);
        unsigned loff2a = loff, loff2b = loff + 7 * 16 * RS; asm volatile("" : "+v"(loff2a), "+v"(loff2b));
#pragma unroll
        for (int i = 0; i < 16; ++i) tv[i] = *(const u32x4*)((const char*)vbase + (goffv + (unsigned)(i * 16 * NMEM * 2)));
        __builtin_amdgcn_sched_barrier(0);
        __syncthreads();
#pragma unroll
        for (int i = 0; i < 16; ++i) *(PG8_LAS u32x4*)(lds + (i < 7 ? loff2a : loff2b) + (i < 7 ? i : i - 7) * 16 * RS) = tv[i];
        __syncthreads();
        unsigned vb0 = (unsigned)(fr * RS + fq * 16), vb1 = vb0 + 8 * 16 * RS; asm volatile("" : "+v"(vb0), "+v"(vb1));
        bf16_t* orow = O + (size_t)(u.pm * BM + 32 * wid + fr) * D + h * 256 + 4 * fq;
#pragma unroll
        for (int db = 0; db < 16; ++db) { f32x4 o0 = (f32x4){0.f, 0.f, 0.f, 0.f}, o1 = (f32x4){0.f, 0.f, 0.f, 0.f};
#pragma unroll
            for (int cc = 0; cc < 8; ++cc) { const bf16x8 vf = *(const PG8_LAS bf16x8*)(lds + (db < 8 ? vb0 : vb1) + ((db & 7) * 16 * RS + cc * 64));
                o0 = __builtin_amdgcn_mfma_f32_16x16x32_bf16(vf, pf[0][cc], o0, 0, 0, 0); o1 = __builtin_amdgcn_mfma_f32_16x16x32_bf16(vf, pf[1][cc], o1, 0, 0, 0); }
            u32x2 w0, w1; w0.x = cvt_pk_bf16(o0[0] * inv[0], o0[1] * inv[0]); w0.y = cvt_pk_bf16(o0[2] * inv[0], o0[3] * inv[0]);
            w1.x = cvt_pk_bf16(o1[0] * inv[1], o1[1] * inv[1]); w1.y = cvt_pk_bf16(o1[2] * inv[1], o1[3] * inv[1]);
            *(u32x2*)(orow + 16 * db) = w0; *(u32x2*)(orow + (size_t)16 * D + 16 * db) = w1; }
        __syncthreads();
    }
};

__device__ __forceinline__ int lane_id_volatile() { int l; asm volatile("v_mbcnt_lo_u32_b32 %0, -1, 0\n\tv_mbcnt_hi_u32_b32 %0, -1, %0" : "=v"(l)); return l; }
#ifndef REP_P0
#define REP_P0 1
#endif
#ifndef REP_CONV
#define REP_CONV 1
#endif
#ifndef REP_SGU
#define REP_SGU 1
#endif
#ifndef REP_ATTN
#define REP_ATTN 1
#endif
#ifndef LSTART
#define LSTART 0
#endif
#ifndef LEND
#define LEND 2
#endif
struct PanelOrder {
    int pm, j, nN;
    __device__ __forceinline__ bool next(int i, Unit& u) const { const int pn = j + 4 * i; if (pn >= nN) return false; int pmv = pm; asm volatile("" : "+s"(pmv)); u.pm = pmv; u.pn = pn; return true; }
    __device__ __forceinline__ void a_ready(const Unit&) const {}
    __device__ __forceinline__ void done(const Unit&) const {}
};
__device__ __forceinline__ void group_barrier(unsigned* cnt, unsigned target, bool coxcd, unsigned* tmo, int ktid) {
    asm volatile("s_waitcnt vmcnt(0)" ::: "memory");
    __syncthreads();
    if (ktid == 0) {
        if (!coxcd) { __builtin_amdgcn_fence(__ATOMIC_RELEASE, "agent"); asm volatile("s_waitcnt vmcnt(0)" ::: "memory"); }
        (void)xb_add(cnt, 1u);
        unsigned sp = 0;
        while (xb_ld(cnt) < target) { __builtin_amdgcn_s_sleep(1); if ((++sp & 255u) == 0u) { if (xb_ld(tmo)) break; if (sp > XB_SPIN_CAP) { atomicAdd(tmo, 1u); break; } } }
        __builtin_amdgcn_fence(__ATOMIC_ACQUIRE, "agent");
        asm volatile("s_waitcnt vmcnt(0)" ::: "memory");
    }
    __syncthreads();
}

__global__ void __launch_bounds__(NTHR, 2) fwd_kernel(Args a) {
    extern __shared__ __attribute__((aligned(16))) unsigned char lds_raw[];
    LAS unsigned char* lds = (LAS unsigned char*)lds_raw;
    volatile LAS unsigned* MISC = (volatile LAS unsigned*)(lds + MISC_OFF);
    const int wave = __builtin_amdgcn_readfirstlane((int)threadIdx.x >> 6);
#define TID() (wave * 64 + lane_id_volatile())
    const int tid = TID(), lane = tid & 63;
    const int G = gridDim.x, bx = blockIdx.x, vcu = (bx % 8) * (G / 8) + bx / 8;
    unsigned char* ws = a.ws;
    unsigned* ctl = (unsigned*)(ws + WS_CTL);
    int pm, pj; { StaticOrder S0; S0.init(T, D, G, bx); Unit own; S0.next(0, own); pm = own.pm; pj = own.pn; }
    if (tid < 32) MISC[tid] = 0u;
    if (tid == 0) __hip_atomic_store(ctl + 8192 + pm * 4 + pj, xb_xcc_id() + 1u, __ATOMIC_RELAXED, __HIP_MEMORY_SCOPE_AGENT);
    __syncthreads();
    XcdBarrier bar = xcd_barrier_post(ctl, MISC + 8, tid);
    const int gw = vcu * NWAVES + wave, NGW = G * NWAVES;
    float* out = a.out; float* ssq = (float*)(ws + WS_SSQ); float* vst = (float*)(ws + WS_VST);
    bf16_t* HB = (bf16_t*)(ws + WS_HB); bf16_t* MB = (bf16_t*)(ws + WS_MB); bf16_t* BIG = (bf16_t*)(ws + WS_BIG);
    bf16_t* MEMN = (bf16_t*)(ws + WS_MEMN); bf16_t* KB = (bf16_t*)(ws + WS_KB); bf16_t* VT = (bf16_t*)(ws + WS_VT);
    unsigned gseq = 0u;
#define GRID_BAR() xcd_barrier(bar, TID())
#define GROUP_BAR() do { gseq += 4u; group_barrier(ctl + 4096 + 64 * pm, gseq, coxcd, ctl + XB_TMO, TID()); } while (0)
#define GEMM(EpiT, E, Ap, Bp, M_, N_, K_, cc) do { Gemm g{(const bf16_t*)(Ap), (const bf16_t*)(Bp), (M_), (N_), (K_)}; int cc_ = (cc); asm volatile("" : "+s"(cc_)); StaticOrder S; S.init((M_), (N_), G, cc_); gemm_phase<EpiT, StaticOrder, true, true>(lds, g, S, (E), TID()); } while (0)
#define GEMMP(EpiT, AL, E, Ap, Bp, N_, K_) do { Gemm g{(const bf16_t*)(Ap), (const bf16_t*)(Bp), T, (N_), (K_)}; int pm_ = pm, pj_ = pj; asm volatile("" : "+s"(pm_), "+s"(pj_)); PanelOrder S{pm_, pj_, (N_) / BM}; gemm_phase<EpiT, PanelOrder, AL, true>(lds, g, S, (E), TID()); } while (0)

    p0_weights(a, 0, 0, lds, gw, NGW, wave, lane); p0_weights(a, 1, 1, lds, gw, NGW, wave, lane); p0_prologue(a, lds, gw, NGW, wave, lane);
    if (a.ws == nullptr) cg::this_grid().sync();
    GRID_BAR();
    bool coxcd; { const unsigned x0 = xb_ld(ctl + 8192 + pm * 4), x1 = xb_ld(ctl + 8192 + pm * 4 + 1), x2 = xb_ld(ctl + 8192 + pm * 4 + 2), x3 = xb_ld(ctl + 8192 + pm * 4 + 3);
        coxcd = __builtin_amdgcn_readfirstlane((x0 != 0u && x0 == x1 && x1 == x2 && x2 == x3) ? 1 : 0) != 0; }
    const int spare = pj >= 2 ? pm * 2 + (pj - 2) : (1 << 20);

#pragma unroll
    for (int l = 0; l < 2; ++l) {
        unsigned char* wl = ws + WS_W + (size_t)l * W_LAYER;
        if (l == 0) {
            { EpiZ0 E{BIG, ssq}; GEMMP(EpiZ0, true, E, HB, wl + W_IN, DZ0, D); }
#pragma unroll 1
            for (int l2 = 0; l2 < 2; ++l2) { EpiKV E{KB + (size_t)l2 * 512 * D, VT + (size_t)l2 * 2 * D * NMEM};
                const int c2 = (spare >= 16 * l2 && spare < 16 * l2 + 16) ? spare - 16 * l2 : (1 << 20);
                GEMM(EpiKV, E, MEMN + (size_t)l2 * 512 * D, ws + WS_W + (size_t)l2 * W_LAYER + W_KV, 512, 2 * D, D, c2); }
            if (spare >= 32 && spare < 128) { const int t3 = TID(); p0_weights(a, 1, 3, lds, (spare - 32) * NWAVES + wave, 96 * NWAVES, wave, t3 & 63); }
            GRID_BAR();
            conv_phase(lds, BIG, MB, a.in[8], a.in[9], a.in[10], a.in[11], a.in[12], a.in[13], 8 * pm + 2 * pj + 2, 8 * pm + 2 * pj, TID());
            GRID_BAR();
            { EpiRes E{HB, ssq}; GEMMP(EpiRes, true, E, MB, wl + W_OUT, D, D); }
        } else {
            { EpiZ1 E{BIG, ssq, vst}; GEMMP(EpiZ1, true, E, HB, wl + W_IN, DZ1, D); }
            GROUP_BAR();
            sgu_phase(lds, BIG, vst, (const bf16_t*)(ws + WS_WSB), a.in[19], a.in[16], a.in[17], MB, 16 * pm + 4 * pj + 4, 16 * pm + 4 * pj, TID());
            GRID_BAR();
            { EpiRes E{HB, ssq}; GEMMP(EpiRes, true, E, MB, wl + W_OUT, D, D); }
        }
        GROUP_BAR();
        { EpiQAttn E{ssq, KB + (size_t)l * 512 * D, VT + (size_t)l * 2 * D * NMEM, MB}; GEMMP(EpiQAttn, false, E, HB, wl + W_Q, D, D); }
        GROUP_BAR();
        { EpiRes E{HB, ssq}; GEMMP(EpiRes, true, E, MB, wl + W_O, D, D); }
        GROUP_BAR();
        { EpiGU E{BIG, ssq}; GEMMP(EpiGU, true, E, HB, wl + W_GU, NGU, D); }
        if (l == 0 && spare < 128) { const int t3 = TID(); p0_weights(a, 1, 4, lds, spare * NWAVES + wave, 128 * NWAVES, wave, t3 & 63); }
        GROUP_BAR();
        { EpiRes E{HB, ssq}; GEMMP(EpiRes, true, E, BIG, wl + W_DN, D, DFF); }
        if (l == 0) GRID_BAR(); else GROUP_BAR();
    }
    { int t2 = TID(); asm volatile("" : "+v"(t2)); const int lane = t2 & 63, wv = __builtin_amdgcn_readfirstlane(t2 >> 6);
      const f32x4 g0 = *(const f32x4*)(a.in[6] + 8 * lane), g1 = *(const f32x4*)(a.in[6] + 8 * lane + 4), g2 = *(const f32x4*)(a.in[6] + 512 + 8 * lane), g3 = *(const f32x4*)(a.in[6] + 512 + 8 * lane + 4);
#pragma unroll 1
      for (int it = 0; it < 2; ++it) { const int m0 = pm * BM + pj * 64 + wv * 8 + it * 4;
          u32x4 r0[4], r1[4];
#pragma unroll
          for (int r = 0; r < 4; ++r) { const bf16_t* p = HB + (size_t)(m0 + r) * D + 8 * lane; r0[r] = *(const u32x4*)p; r1[r] = *(const u32x4*)(p + 512); }
          __builtin_amdgcn_sched_barrier(0);
#pragma unroll
          for (int r = 0; r < 4; ++r) { float v[8], w[8]; unpack8(r0[r], v); unpack8(r1[r], w); float sq = 0.f;
#pragma unroll
              for (int j = 0; j < 8; ++j) sq += v[j] * v[j] + w[j] * w[j];
              const float rs = rsqrtf(wave_sum(sq) * (1.0f / 1024.0f) + RMS_EPS);
              float* o = out + (size_t)(m0 + r) * D + 8 * lane;
              *(f32x4*)o = (f32x4){v[0], v[1], v[2], v[3]} * rs * g0; *(f32x4*)(o + 4) = (f32x4){v[4], v[5], v[6], v[7]} * rs * g1;
              *(f32x4*)(o + 512) = (f32x4){w[0], w[1], w[2], w[3]} * rs * g2; *(f32x4*)(o + 516) = (f32x4){w[4], w[5], w[6], w[7]} * rs * g3; } } }
}

extern "C" void kernel_launch(void* const* d_in, const int* in_sizes, int n_in, void* d_out, int out_size, void* d_ws, size_t ws_size, hipStream_t stream) {
    static int grid = 0;
    if (grid == 0) {
        if (n_in != 28 || out_size != T * D || ws_size < WS_END) { fprintf(stderr, "kernel_launch: unexpected shapes (n_in %d out %d ws %zu)\n", n_in, out_size, ws_size); grid = -1; return; }
        int dev = 0, cus = 0, per_cu = 0;
        (void)hipGetDevice(&dev); (void)hipDeviceGetAttribute(&cus, hipDeviceAttributeMultiprocessorCount, dev);
        (void)hipFuncSetAttribute((const void*)fwd_kernel, hipFuncAttributeMaxDynamicSharedMemorySize, LDS_BYTES);
        (void)hipOccupancyMaxActiveBlocksPerMultiprocessor(&per_cu, (const void*)fwd_kernel, NTHR, LDS_BYTES);
        if (per_cu < 1) per_cu = 1;
        (void)hipGetLastError();
        grid = cus;
        if (grid != 256) { fprintf(stderr, "kernel_launch: built for a 256-CU device (one workgroup per CU, four per row panel); found %d CUs; nothing launched\n", grid); grid = -1; return; }
    }
    if (grid < 0) return;
    (void)hipMemsetAsync((char*)d_ws + WS_CTL, 0, CTL_ZERO_BYTES, stream);
    Args a{};
    for (int i = 0; i < 28; ++i) a.in[i] = (const float*)d_in[i];
    a.out = (float*)d_out; a.ws = (unsigned char*)d_ws;
    void* args[] = {&a};
    hipError_t e = hipLaunchCooperativeKernel((const void*)fwd_kernel, dim3(grid), dim3(NTHR), args, LDS_BYTES, stream);
    if (e != hipSuccess) fprintf(stderr, "cooperative launch failed: %s (grid %d)\n", hipGetErrorString(e), grid);
}
```

```cpp
#include <hip/hip_runtime.h>
#include <hip/hip_cooperative_groups.h>
#include <cstdio>
#include <cstdint>
namespace cg = cooperative_groups;
namespace pg8 {
#define PG8_LAS __attribute__((address_space(3)))
typedef unsigned short bf16_t;
typedef short bf16x8 __attribute__((ext_vector_type(8)));
typedef float f32x4 __attribute__((ext_vector_type(4)));
typedef unsigned u32x4 __attribute__((ext_vector_type(4)));
constexpr int BM = 256, BK = 64, HALF = 128, HTB = HALF * BK * 2  , STAGE_BYTES = 8 * HTB, NXCD = 8, WGM = 8;

__host__ __device__ __forceinline__ int lds_byte(int r, int c) { const int st = (r >> 4) * 2 + (c >> 5), rr = r & 15, cc = c & 31, ob = rr * 64 + cc * 2; return st * 1024 + (ob ^ (((ob >> 9) & 1) << 5)); }
__host__ __device__ __forceinline__ void stage_rc(int b, int& R, int& C) { const int st = b / 1024, sb = b % 1024, swz = sb ^ (((sb >> 9) & 1) << 5); R = (st >> 1) * 16 + swz / 64; C = (st & 1) * 32 + (swz % 64) / 2; }
__host__ __device__ __forceinline__ int perm32(int rho) { const int n = rho >> 4, i = rho & 15; return 8 * (i >> 2) + 4 * n + (i & 3); }

struct Unit { int pm, pn; };
struct Gemm { const bf16_t* A; const bf16_t* Bt; int M, N, K; };

struct StaticOrder {
    int nM, nN, nwg, G, c;
    __host__ __device__ void init(int M, int N, int G_, int c_) { nM = M / BM; nN = N / BM; nwg = nM * nN; G = G_; c = c_; }
    __host__ __device__ bool next(int i, Unit& u) const {
        const long L = (long)i * G + c; if (L >= nwg) return false;
        int wgid = (int)L; { const int q = nwg / NXCD, r = nwg % NXCD, xcd = wgid % NXCD, off = wgid / NXCD; wgid = (xcd < r ? xcd * (q + 1) : r * (q + 1) + (xcd - r) * q) + off; }
        const int nig = WGM * nN, gid = wgid / nig, fm = gid * WGM, gsz = (nM - fm) < WGM ? (nM - fm) : WGM;
        u.pm = fm + ((wgid % nig) % gsz); u.pn = (wgid % nig) / gsz; return true;
    }
    __device__ __forceinline__ void a_ready(const Unit&) const {}
    __device__ __forceinline__ void done(const Unit&) const {}
};

__device__ __forceinline__ unsigned cvt_pk_bf16(float lo, float hi) { unsigned r; asm volatile("v_cvt_pk_bf16_f32 %0, %1, %2" : "=v"(r) : "v"(lo), "v"(hi)); return r; }
typedef float f32x2 __attribute__((ext_vector_type(2)));
template <class Epi, class Sched, bool ALIGN_EPI = false, bool SP2 = false>
__device__ __forceinline__ void gemm_phase(PG8_LAS unsigned char* lds, const Gemm g, const Sched& S, const Epi& E, int tid_in) {
    int tid_ = tid_in; asm volatile("" : "+v"(tid_));
    const int tid = tid_, wid = __builtin_amdgcn_readfirstlane(tid >> 6), lane = tid & 63, wr = wid >> 2, wc = wid & 3, fr = lane & 15, fq = lane >> 4;
    const int K = g.K, nt = K / BK;
    unsigned voffA[2], voffB[2];
#pragma unroll
    for (int i = 0; i < 2; ++i) { int R, C; stage_rc(tid * 16 + i * 8192, R, C); const int Rb = Epi::PERM ? ((R & ~31) + perm32(R & 31)) : R;
        voffA[i] = (unsigned)(R * K + C) * 2u; voffB[i] = (unsigned)(Rb * K + C) * 2u; }
    const size_t kstep = (size_t)(BK * 2);
    const size_t hstep = (size_t)HALF * K * 2;
    const size_t tstep = 2 * hstep;
    const unsigned ldsw = (unsigned)wid * 1024u;
    const int aoff = lds_byte(wr * 64 + fr, fq * 8), boff = lds_byte(wc * 32 + fr, fq * 8);
#define PG8_SA(b, h) (((b) * 2 + (h)) * HTB)
#define PG8_SB(b, h) ((4 + (b) * 2 + (h)) * HTB)
#define PG8_STAGE(bufoff, gbase, voff) do { _Pragma("unroll") for (int _i = 0; _i < 2; ++_i) \
        __builtin_amdgcn_global_load_lds((const unsigned*)((const char*)(gbase) + (voff)[_i]), (PG8_LAS unsigned*)(lds + (bufoff) + ldsw + _i * 8192), 16, 0, 0); } while (0)
#define PG8_LDA(dst, b, h) do { _Pragma("unroll") for (int m = 0; m < 4; ++m) _Pragma("unroll") for (int k = 0; k < 2; ++k) dst[m][k] = *(const PG8_LAS bf16x8*)(lds + PG8_SA(b, h) + aoff + m * 2048 + k * 1024); } while (0)
#define PG8_LDB(dst, b, h) do { _Pragma("unroll") for (int n = 0; n < 2; ++n) _Pragma("unroll") for (int k = 0; k < 2; ++k) dst[n][k] = *(const PG8_LAS bf16x8*)(lds + PG8_SB(b, h) + boff + n * 2048 + k * 1024); } while (0)
#define PG8_MMA(ai, bj, At, Bt) do { __builtin_amdgcn_s_setprio(1); _Pragma("unroll") for (int m = 0; m < 4; ++m) _Pragma("unroll") for (int n = 0; n < 2; ++n) _Pragma("unroll") for (int k = 0; k < 2; ++k) \
        acc[ai][bj][m][n] = __builtin_amdgcn_mfma_f32_16x16x32_bf16(Bt[n][k], At[m][k], acc[ai][bj][m][n], 0, 0, 0); __builtin_amdgcn_s_setprio(0); } while (0)
#define PG8_WAIT_V(n) asm volatile("s_waitcnt vmcnt(" #n ")" ::: "memory")
#define PG8_WAIT_L(n) asm volatile("s_waitcnt lgkmcnt(" #n ")" ::: "memory")
#define PG8_BAR __builtin_amdgcn_s_barrier()
#define PG8_SCHED __builtin_amdgcn_sched_barrier(0)
    Unit cur, nxt; int ui = 0;
    if (!S.next(0, cur)) return;
    f32x4 acc[2][2][4][2];
#pragma unroll
    for (int a = 0; a < 2; ++a)
#pragma unroll
        for (int b = 0; b < 2; ++b)
#pragma unroll
            for (int m = 0; m < 4; ++m)
#pragma unroll
                for (int n = 0; n < 2; ++n) acc[a][b][m][n] = (f32x4){0.f, 0.f, 0.f, 0.f};
    bf16x8 At[4][2], B0[2][2], B1[2][2];
    const char* cA = (const char*)g.A + (size_t)cur.pm * tstep; const char* cB = (const char*)g.Bt + (size_t)cur.pn * tstep;
    S.a_ready(cur);
    if constexpr (SP2) {
        PG8_STAGE(PG8_SB(0, 0), cB, voffB); PG8_STAGE(PG8_SB(0, 1), cB + hstep, voffB); PG8_STAGE(PG8_SA(0, 0), cA, voffA); PG8_STAGE(PG8_SA(0, 1), cA + hstep, voffA);
        if (wr == 1) PG8_BAR;
        PG8_WAIT_V(2); PG8_BAR;
        PG8_STAGE(PG8_SB(1, 0), cB + kstep, voffB); PG8_STAGE(PG8_SA(1, 0), cA + kstep, voffA); PG8_STAGE(PG8_SB(1, 1), cB + hstep + kstep, voffB);
        PG8_WAIT_V(6); PG8_BAR;
    } else {
        PG8_STAGE(PG8_SB(0, 0), cB, voffB); PG8_STAGE(PG8_SA(0, 0), cA, voffA); PG8_STAGE(PG8_SB(0, 1), cB + hstep, voffB); PG8_STAGE(PG8_SA(0, 1), cA + hstep, voffA);
        if (wr == 1) PG8_BAR;
        PG8_WAIT_V(4); PG8_BAR;
        PG8_STAGE(PG8_SB(1, 0), cB + kstep, voffB); PG8_STAGE(PG8_SA(1, 0), cA + kstep, voffA); PG8_STAGE(PG8_SB(1, 1), cB + hstep + kstep, voffB);
        PG8_WAIT_V(6); PG8_BAR;
    }
    for (;;) {
        const bool has_next = S.next(ui + 1, nxt);
        const char* nA = has_next ? (const char*)g.A + (size_t)nxt.pm * tstep : cA; const char* nB = has_next ? (const char*)g.Bt + (size_t)nxt.pn * tstep : cB;
        for (int t = 0; t < nt; t += 2) {
            const bool last = (t == nt - 2);
            const char* a1 = cA + (size_t)(t + 1) * kstep;
            const char* a2 = last ? nA : cA + (size_t)(t + 2) * kstep; const char* b2 = last ? nB : cB + (size_t)(t + 2) * kstep;
            const char* a3 = a2 + kstep; const char* b3 = b2 + kstep;
            if (last && has_next) S.a_ready(nxt);
            if constexpr (SP2) {
            PG8_LDB(B0, 0, 0); PG8_LDB(B1, 0, 1); PG8_SCHED; PG8_LDA(At, 0, 0); PG8_STAGE(PG8_SA(1, 1), a1 + hstep, voffA);
            PG8_WAIT_V(8); PG8_WAIT_L(0); PG8_BAR; PG8_MMA(0, 0, At, B0); PG8_MMA(0, 1, At, B1); PG8_BAR; PG8_SCHED;
            PG8_LDA(At, 0, 1); PG8_STAGE(PG8_SB(0, 0), b2, voffB); PG8_STAGE(PG8_SB(0, 1), b2 + hstep, voffB); PG8_STAGE(PG8_SA(0, 0), a2, voffA);
            PG8_WAIT_V(8); PG8_WAIT_L(0); PG8_BAR; PG8_MMA(1, 0, At, B0); PG8_MMA(1, 1, At, B1); PG8_BAR; PG8_SCHED;
            PG8_LDB(B0, 1, 0); PG8_LDB(B1, 1, 1); PG8_SCHED; PG8_LDA(At, 1, 0); PG8_STAGE(PG8_SA(0, 1), a2 + hstep, voffA);
            PG8_WAIT_V(8); PG8_WAIT_L(0); PG8_BAR; PG8_MMA(0, 0, At, B0); PG8_MMA(0, 1, At, B1); PG8_BAR; PG8_SCHED;
            PG8_LDA(At, 1, 1); PG8_STAGE(PG8_SB(1, 0), b3, voffB); PG8_STAGE(PG8_SB(1, 1), b3 + hstep, voffB); PG8_STAGE(PG8_SA(1, 0), a3, voffA);
            PG8_WAIT_V(8); PG8_WAIT_L(0); PG8_BAR; PG8_MMA(1, 0, At, B0); PG8_MMA(1, 1, At, B1); PG8_BAR; PG8_SCHED;
            } else {
            PG8_LDB(B0, 0, 0); PG8_SCHED; PG8_LDA(At, 0, 0); PG8_STAGE(PG8_SA(1, 1), a1 + hstep, voffA);
            PG8_WAIT_L(8); PG8_BAR; PG8_WAIT_L(0); PG8_MMA(0, 0, At, B0); PG8_BAR; PG8_SCHED;
            PG8_LDB(B1, 0, 1); PG8_STAGE(PG8_SB(0, 0), b2, voffB);
            PG8_BAR; PG8_WAIT_L(0); PG8_MMA(0, 1, At, B1); PG8_BAR;
            PG8_LDA(At, 0, 1); PG8_STAGE(PG8_SA(0, 0), a2, voffA);
            PG8_BAR; PG8_WAIT_L(0); PG8_MMA(1, 0, At, B0); PG8_BAR; PG8_SCHED;
            PG8_STAGE(PG8_SB(0, 1), b2 + hstep, voffB);
            PG8_WAIT_V(6); PG8_BAR; PG8_MMA(1, 1, At, B1); PG8_BAR;
            PG8_LDB(B0, 1, 0); PG8_SCHED; PG8_LDA(At, 1, 0); PG8_STAGE(PG8_SA(0, 1), a2 + hstep, voffA);
            PG8_WAIT_L(8); PG8_BAR; PG8_WAIT_L(0); PG8_MMA(0, 0, At, B0); PG8_BAR; PG8_SCHED;
            PG8_LDB(B1, 1, 1); PG8_STAGE(PG8_SB(1, 0), b3, voffB);
            PG8_BAR; PG8_WAIT_L(0); PG8_MMA(0, 1, At, B1); PG8_BAR;
            PG8_LDA(At, 1, 1); PG8_STAGE(PG8_SA(1, 0), a3, voffA);
            PG8_BAR; PG8_WAIT_L(0); PG8_MMA(1, 0, At, B0); PG8_BAR; PG8_SCHED;
            PG8_STAGE(PG8_SB(1, 1), b3 + hstep, voffB);
            PG8_WAIT_V(6); PG8_BAR; PG8_MMA(1, 1, At, B1); PG8_BAR;
            }
        }
        if constexpr (ALIGN_EPI) { if (wr == 0) PG8_BAR; }
        if constexpr (!Epi::AFTER_DRAIN) { E(acc, cur, wr, wc, fr, fq); S.done(cur); }
        if (!has_next) break;
#pragma unroll
        for (int a = 0; a < 2; ++a)
#pragma unroll
            for (int b = 0; b < 2; ++b)
#pragma unroll
                for (int m = 0; m < 4; ++m)
#pragma unroll
                    for (int n = 0; n < 2; ++n) acc[a][b][m][n] = (f32x4){0.f, 0.f, 0.f, 0.f};
        cur = nxt; cA = nA; cB = nB; ++ui;
        if constexpr (ALIGN_EPI) { if (wr == 1) PG8_BAR; }
    }
    PG8_WAIT_V(0);
    if constexpr (!ALIGN_EPI) { if (wr == 0) PG8_BAR; }
    PG8_BAR;
    if constexpr (Epi::AFTER_DRAIN) { E.fused(acc, cur, wr, wc, fr, fq, lds, wid, lane); S.done(cur); }
#undef PG8_SA
#undef PG8_SB
#undef PG8_STAGE
#undef PG8_LDA
#undef PG8_LDB
#undef PG8_MMA
#undef PG8_WAIT_V
#undef PG8_WAIT_L
#undef PG8_BAR
#undef PG8_SCHED
}
}
#define LAS __attribute__((address_space(3)))
#define XB_TMO      128
#define XB_XCNT(j)  (256  + 64 * (j))
#define XB_XSUB(j)  (1280 + 64 * (j))
#define XB_XGEN(j)  (2304 + 64 * (j))
#define XB_TOP      3328
#define XB_TOPGEN   3392
#define XCD_BAR_WORDS 3456
#define XB_SPIN_CAP (1u << 18)

__device__ __forceinline__ unsigned xb_ld(unsigned* p)              { return __hip_atomic_load(p, __ATOMIC_RELAXED, __HIP_MEMORY_SCOPE_AGENT); }
__device__ __forceinline__ unsigned xb_add(unsigned* p, unsigned v) { return __hip_atomic_fetch_add(p, v, __ATOMIC_RELAXED, __HIP_MEMORY_SCOPE_AGENT); }
__device__ __forceinline__ unsigned xb_xcc_id() { return (unsigned)__builtin_amdgcn_s_getreg((3 << 11) | 20) & 0xFu; }
#define XB_SPIN(cond, bar) do { unsigned _sp = 0; while (cond) { __builtin_amdgcn_s_sleep(1); \
    if ((++_sp & 255u) == 0u) { if (xb_ld(&(bar)[XB_TMO])) break; if (_sp > XB_SPIN_CAP) { atomicAdd(&(bar)[XB_TMO], 1u); break; } } } } while (0)

struct XcdBarrier {
    unsigned* bar; unsigned x;
    volatile LAS unsigned* st;
};

__device__ __forceinline__ XcdBarrier xcd_barrier_post(unsigned* bar, volatile LAS unsigned* st, int ktid) {
    XcdBarrier b; b.bar = bar; b.x = xb_xcc_id(); b.st = st;
    if (ktid == 0) (void)xb_add(&bar[XB_XCNT(b.x)], 1u);
    return b;
}
__device__ __forceinline__ void xcd_barrier_complete(unsigned* bar, unsigned x, unsigned& nloc, unsigned& nx) {
    const unsigned G = gridDim.x * gridDim.y * gridDim.z;
    unsigned sum, cnt, mine, sp = 0u;
    for (;;) {
        sum = 0u; cnt = 0u; mine = 0u;
#pragma unroll
        for (unsigned j = 0; j < 16; ++j) { const unsigned c = xb_ld(&bar[XB_XCNT(j)]); sum += c; cnt += (c > 0u) ? 1u : 0u; mine = (j == x) ? c : mine; }
        if (sum == G) break;
        __builtin_amdgcn_s_sleep(1);
        if ((++sp & 255u) == 0u) { if (xb_ld(&bar[XB_TMO])) break; if (sp > XB_SPIN_CAP) { atomicAdd(&bar[XB_TMO], 1u); break; } }
    }
    nloc = mine > 0u ? mine : 1u; nx = cnt > 0u ? cnt : 1u;
}

__device__ __forceinline__ void xcd_barrier(const XcdBarrier& b, int ktid) {
    asm volatile("s_waitcnt vmcnt(0)" ::: "memory");
    __syncthreads();
    if (ktid == 0) {
        unsigned* bar = b.bar; const unsigned bx_ = xb_xcc_id();
        __builtin_amdgcn_s_waitcnt(0);
        unsigned nloc = b.st[0], nx = b.st[1];
        if (nloc == 0u) { xcd_barrier_complete(bar, bx_, nloc, nx); b.st[0] = nloc; b.st[1] = nx; }
        const unsigned old = xb_add(&bar[XB_XSUB(bx_)], 1u);
        const unsigned gen = old / nloc;
        if (old + 1u == (gen + 1u) * nloc) {
            __builtin_amdgcn_fence(__ATOMIC_RELEASE, "agent");
            asm volatile("s_waitcnt vmcnt(0)" ::: "memory");
            const unsigned og = xb_add(&bar[XB_TOP], 1u);
            const unsigned tg = og / nx;
            if (og + 1u == (tg + 1u) * nx) xb_add(&bar[XB_TOPGEN], 1u);
            else XB_SPIN(xb_ld(&bar[XB_TOPGEN]) == tg, bar);
            __builtin_amdgcn_fence(__ATOMIC_ACQUIRE, "agent");
            xb_add(&bar[XB_XGEN(bx_)], 1u);
            asm volatile("s_waitcnt vmcnt(0)" ::: "memory");
        } else {
            XB_SPIN(xb_ld(&bar[XB_XGEN(bx_)]) == gen, bar);
            __builtin_amdgcn_fence(__ATOMIC_ACQUIRE, "agent");
            asm volatile("s_waitcnt vmcnt(0)" ::: "memory");
        }
    }
    __syncthreads();
}
#undef LAS
using namespace pg8;
#define LAS __attribute__((address_space(3)))
typedef unsigned u32x2 __attribute__((ext_vector_type(2)));

constexpr int NWAVES = 8, NTHR = 512;
constexpr int SEQ = 8192, NBATCH = 2, T = NBATCH * SEQ, D = 1024, DZ0 = 2560, DZ1 = 2048, DFF = 2816, NGU = 2 * DFF, NMEM = 256;
constexpr float RMS_EPS = 1e-6f, LN_EPS = 1e-5f;
constexpr size_t MiB = 1u << 20;
constexpr size_t WS_CTL = 0, CTL_ZERO_BYTES = 64 * 1024;
constexpr size_t WS_W = 2 * MiB, W_LAYER = 32 * MiB;
constexpr size_t W_IN = 0, W_OUT = 5 * MiB, W_Q = 7 * MiB, W_KV = 9 * MiB, W_O = 13 * MiB, W_GU = 15 * MiB, W_DN = 26 * MiB;
constexpr size_t WS_WSB = 66 * MiB;
constexpr size_t WS_SSQ = 67 * MiB;
constexpr size_t WS_VST = 68 * MiB;
constexpr size_t WS_MEMN = 70 * MiB;
constexpr size_t WS_KB = 72 * MiB;
constexpr size_t WS_VT = 74 * MiB;
constexpr size_t WS_HB = 76 * MiB;
constexpr size_t WS_MB = 108 * MiB;
constexpr size_t WS_BIG = 140 * MiB;
constexpr size_t WS_END = 228 * MiB;
constexpr int LDS_BYTES = 147456, MISC_OFF = 139264, TAB_OFF = 135168;

template <int CTRL> __device__ __forceinline__ float dpp_mov(float v) { return __builtin_bit_cast(float, __builtin_amdgcn_update_dpp(0, __builtin_bit_cast(int, v), CTRL, 0xF, 0xF, true)); }
__device__ __forceinline__ float wave_sum(float v) {
    v += dpp_mov<0xB1>(v);
    v += dpp_mov<0x4E>(v);
    v += dpp_mov<0x141>(v);
    v += dpp_mov<0x140>(v);
    const int vi = __builtin_bit_cast(int, v);
    const float r0 = __builtin_bit_cast(float, __builtin_amdgcn_readlane(vi, 0)), r1 = __builtin_bit_cast(float, __builtin_amdgcn_readlane(vi, 16)),
                r2 = __builtin_bit_cast(float, __builtin_amdgcn_readlane(vi, 32)), r3 = __builtin_bit_cast(float, __builtin_amdgcn_readlane(vi, 48));
    return (r0 + r1) + (r2 + r3);
}
__device__ __forceinline__ float xrow16_sum(float x) {
    auto s = __builtin_amdgcn_permlane16_swap(__float_as_uint(x), __float_as_uint(x), false, false);
    x = __uint_as_float(s[0]) + __uint_as_float(s[1]);
    auto t = __builtin_amdgcn_permlane32_swap(__float_as_uint(x), __float_as_uint(x), false, false);
    return __uint_as_float(t[0]) + __uint_as_float(t[1]);
}
__device__ __forceinline__ float xrow16_max(float x) {
    auto s = __builtin_amdgcn_permlane16_swap(__float_as_uint(x), __float_as_uint(x), false, false);
    x = fmaxf(__uint_as_float(s[0]), __uint_as_float(s[1]));
    auto t = __builtin_amdgcn_permlane32_swap(__float_as_uint(x), __float_as_uint(x), false, false);
    return fmaxf(__uint_as_float(t[0]), __uint_as_float(t[1]));
}
__device__ __forceinline__ float bf2f(unsigned short b) { return __uint_as_float((unsigned)b << 16); }
__device__ __forceinline__ float bflo(unsigned w) { return __uint_as_float(w << 16); }
__device__ __forceinline__ float bfhi(unsigned w) { return __uint_as_float(w & 0xffff0000u); }
__device__ __forceinline__ unsigned short f2bf(float f) { return (unsigned short)(cvt_pk_bf16(f, 0.f) & 0xffffu); }
__device__ __forceinline__ float sigm(float x) { return __builtin_amdgcn_rcpf(1.f + __builtin_amdgcn_exp2f(-1.44269504f * x)); }
typedef float f32x2 __attribute__((ext_vector_type(2)));
__device__ __forceinline__ f32x2 exp2_pk(f32x2 t) { f32x2 e; e.x = __builtin_amdgcn_exp2f(t.x); e.y = __builtin_amdgcn_exp2f(t.y); return e; }
__device__ __forceinline__ f32x2 rcp_pk(f32x2 d) { f32x2 r; r.x = __builtin_amdgcn_rcpf(d.x); r.y = __builtin_amdgcn_rcpf(d.y); return r; }
__device__ __forceinline__ f32x2 swiglu_pk(f32x2 ag, f32x2 au, float c1, float c2) { const f32x2 r = rcp_pk(exp2_pk(ag * c1) + 1.0f); return (ag * au) * r * c2; }
__device__ __forceinline__ f32x2 gelu_tanh_pk(f32x2 x) { const f32x2 x2 = x * x, t = x * (x2 * (-2.3022081986f * 0.044715f) + (-2.3022081986f)); return x * rcp_pk(exp2_pk(t) + 1.0f); }
__device__ __forceinline__ float gelu_tanh(float x) { const float y = 1.5957691216f * (x + 0.044715f * x * x * x); return x * sigm(y); }

__device__ __forceinline__ float row_rstd(const float* ssq, int row, int fq) {
    const f32x4 a = *(const f32x4*)(ssq + (size_t)row * 16 + 4 * fq);
    float s = (a[0] + a[1]) + (a[2] + a[3]);
    s = xrow16_sum(s);
    return rsqrtf(s * (1.0f / 1024.0f) + RMS_EPS);
}
__device__ __forceinline__ void rstd_table(LAS unsigned char* lds, const float* ssq, int pm, int tid) {
    if (tid < 256) { const f32x4* p = (const f32x4*)(ssq + ((size_t)pm * 256 + tid) * 16); const f32x4 a = p[0], b = p[1], c = p[2], d = p[3];
        const float s = (((a[0] + a[1]) + (a[2] + a[3])) + ((b[0] + b[1]) + (b[2] + b[3]))) + (((c[0] + c[1]) + (c[2] + c[3])) + ((d[0] + d[1]) + (d[2] + d[3])));
        ((LAS float*)(lds + TAB_OFF))[tid] = rsqrtf(s * (1.0f / 1024.0f) + RMS_EPS); }
    __syncthreads();
}
__device__ __forceinline__ u32x4 pack8(const f32x4 v0, const f32x4 v1) { u32x4 w; w.x = cvt_pk_bf16(v0[0], v0[1]); w.y = cvt_pk_bf16(v0[2], v0[3]); w.z = cvt_pk_bf16(v1[0], v1[1]); w.w = cvt_pk_bf16(v1[2], v1[3]); return w; }

struct EpiScale {
    static constexpr bool PERM = true, AFTER_DRAIN = false;
    bf16_t* O; int ldc; const float* ssq;
    __device__ __forceinline__ void operator()(const f32x4 (&acc)[2][2][4][2], const Unit& u, int wr, int wc, int fr, int fq) const {
        const int row0 = u.pm * BM + wr * 64 + fr, col0 = u.pn * BM + wc * 32 + 8 * fq;
#pragma unroll
        for (int ai = 0; ai < 2; ++ai)
#pragma unroll
            for (int m = 0; m < 4; ++m) { const int row = row0 + ai * HALF + m * 16; const float rs = ssq ? row_rstd(ssq, row, fq) : 1.f; bf16_t* rowp = O + (size_t)row * ldc + col0;
#pragma unroll
                for (int bj = 0; bj < 2; ++bj) *(u32x4*)(rowp + bj * HALF) = pack8(acc[ai][bj][m][0] * rs, acc[ai][bj][m][1] * rs); }
    }
};
constexpr int DZ3 = 1536;
struct EpiZ0 {
    static constexpr bool PERM = true, AFTER_DRAIN = false;
    bf16_t* O; const LAS float* tab;
    __device__ __forceinline__ void operator()(const f32x4 (&acc)[2][2][4][2], const Unit& u, int wr, int wc, int fr, int fq) const {
        const int row0 = u.pm * BM + wr * 64 + fr, cin = wc * 32 + 8 * fq;
#pragma unroll
        for (int ai = 0; ai < 2; ++ai)
#pragma unroll
            for (int m = 0; m < 4; ++m) { const int row = row0 + ai * HALF + m * 16; const float rs = tab[ai * HALF + wr * 64 + m * 16 + fr]; bf16_t* rowp = O + (size_t)row * DZ3;
                if (u.pn >= 8) {
#pragma unroll
                    for (int bj = 0; bj < 2; ++bj) *(u32x4*)(rowp + 1024 + (u.pn - 8) * BM + bj * HALF + cin) = pack8(acc[ai][bj][m][0] * rs, acc[ai][bj][m][1] * rs);
                } else { f32x4 h[2]; const float c1 = -1.44269504f * rs, c2 = rs * rs;
#pragma unroll
                    for (int n = 0; n < 2; ++n) { const f32x4 ap = acc[ai][0][m][n], aq = acc[ai][1][m][n];
                        const f32x2 pl = (f32x2){ap[0], ap[1]}, ph = (f32x2){ap[2], ap[3]}, ql = (f32x2){aq[0], aq[1]}, qh = (f32x2){aq[2], aq[3]};
                        f32x2 lo, hi;
                        if (u.pn < 4) { lo = (pl * rs) * rcp_pk(exp2_pk(ql * c1) + 1.0f); hi = (ph * rs) * rcp_pk(exp2_pk(qh * c1) + 1.0f); }
                        else { lo = (pl * ql) * c2; hi = (ph * qh) * c2; }
                        h[n] = (f32x4){lo.x, lo.y, hi.x, hi.y}; }
                    *(u32x4*)(rowp + u.pn * HALF + cin) = pack8(h[0], h[1]); } }
    }
};
struct EpiRes {
    static constexpr bool PERM = true, AFTER_DRAIN = false;
    bf16_t* hb; float* ssq;
    __device__ __forceinline__ void operator()(const f32x4 (&acc)[2][2][4][2], const Unit& u, int wr, int wc, int fr, int fq) const {
        const int row0 = u.pm * BM + wr * 64 + fr, col0 = u.pn * BM + wc * 32 + 8 * fq;
#pragma unroll
        for (int ai = 0; ai < 2; ++ai)
#pragma unroll
            for (int m = 0; m < 4; ++m) { const int row = row0 + ai * HALF + m * 16; const size_t off = (size_t)row * D + col0; float q = 0.f; f32x2 q2 = (f32x2){0.f, 0.f};
#pragma unroll
                for (int bj = 0; bj < 2; ++bj) { const u32x4 bb = *(const u32x4*)(hb + off + bj * HALF);
                    const f32x4 b0 = (f32x4){bflo(bb.x), bfhi(bb.x), bflo(bb.y), bfhi(bb.y)}, b1 = (f32x4){bflo(bb.z), bfhi(bb.z), bflo(bb.w), bfhi(bb.w)};
                    const f32x4 v0 = b0 + acc[ai][bj][m][0], v1 = b1 + acc[ai][bj][m][1];
                    *(u32x4*)(hb + off + bj * HALF) = pack8(v0, v1);
                    const f32x2 a0 = (f32x2){v0[0], v0[1]}, a1 = (f32x2){v0[2], v0[3]}, a2 = (f32x2){v1[0], v1[1]}, a3 = (f32x2){v1[2], v1[3]};
                    q2 += a0 * a0; q2 += a1 * a1; q2 += a2 * a2; q2 += a3 * a3; }
                q = xrow16_sum(q2.x + q2.y);
                if (fq == 0) ssq[(size_t)row * 16 + u.pn * 4 + wc] = q; }
    }
};
struct EpiGU {
    static constexpr bool PERM = true, AFTER_DRAIN = false;
    bf16_t* O; const LAS float* tab;
    __device__ __forceinline__ void operator()(const f32x4 (&acc)[2][2][4][2], const Unit& u, int wr, int wc, int fr, int fq) const {
        const int row0 = u.pm * BM + wr * 64 + fr, col0 = u.pn * HALF + wc * 32 + 8 * fq;
#ifdef EPI_GU_REP
        _Pragma("unroll 1") for (int rep = 0; rep < EPI_GU_REP; ++rep) { asm volatile("" ::: "memory");
#else
        {
#endif
#pragma unroll
        for (int ai = 0; ai < 2; ++ai)
#pragma unroll
            for (int m = 0; m < 4; ++m) { const int row = row0 + ai * HALF + m * 16; const float rs = tab[ai * HALF + wr * 64 + m * 16 + fr];
                const float c1 = -1.44269504f * rs, c2 = rs * rs; f32x4 h[2];
#pragma unroll
                for (int n = 0; n < 2; ++n) { const f32x4 ag = acc[ai][0][m][n], au = acc[ai][1][m][n];
                    const f32x2 lo = swiglu_pk((f32x2){ag[0], ag[1]}, (f32x2){au[0], au[1]}, c1, c2), hi = swiglu_pk((f32x2){ag[2], ag[3]}, (f32x2){au[2], au[3]}, c1, c2);
                    h[n] = (f32x4){lo.x, lo.y, hi.x, hi.y}; }
                *(u32x4*)(O + (size_t)row * DFF + col0) = pack8(h[0], h[1]); }
        }
    }
};
struct EpiZ1 {
    static constexpr bool PERM = true, AFTER_DRAIN = false;
    bf16_t* O; const LAS float* tab; float* vst;
    __device__ __forceinline__ void operator()(const f32x4 (&acc)[2][2][4][2], const Unit& u, int wr, int wc, int fr, int fq) const {
        const int row0 = u.pm * BM + wr * 64 + fr, col0 = u.pn * BM + wc * 32 + 8 * fq;
#pragma unroll
        for (int ai = 0; ai < 2; ++ai)
#pragma unroll
            for (int m = 0; m < 4; ++m) { const int row = row0 + ai * HALF + m * 16; const float rs = tab[ai * HALF + wr * 64 + m * 16 + fr]; bf16_t* rowp = O + (size_t)row * DZ1 + col0; float s = 0.f, q = 0.f;
                f32x2 s2 = (f32x2){0.f, 0.f}, q2 = (f32x2){0.f, 0.f};
#pragma unroll
                for (int bj = 0; bj < 2; ++bj) { f32x4 v[2];
#pragma unroll
                    for (int n = 0; n < 2; ++n) { const f32x4 av = acc[ai][bj][m][n];
                        const f32x2 lo = gelu_tanh_pk((f32x2){av[0], av[1]} * rs), hi = gelu_tanh_pk((f32x2){av[2], av[3]} * rs);
                        s2 += lo; s2 += hi; q2 += lo * lo; q2 += hi * hi; v[n] = (f32x4){lo.x, lo.y, hi.x, hi.y}; }
                    *(u32x4*)(rowp + bj * HALF) = pack8(v[0], v[1]); }
                s = s2.x + s2.y; q = q2.x + q2.y;
                if (u.pn >= 4) { s = xrow16_sum(s); q = xrow16_sum(q);
                    if (fq == 0) { float* p = vst + ((size_t)row * 16 + (u.pn - 4) * 4 + wc) * 2; p[0] = s; p[1] = q; } } }
    }
};
struct EpiVt {
    static constexpr bool PERM = true, AFTER_DRAIN = false;
    bf16_t* Vt;
    __device__ __forceinline__ void operator()(const f32x4 (&acc)[2][2][4][2], const Unit& u, int wr, int wc, int fr, int fq) const {
        const int row0 = u.pm * BM + wr * 64 + fr, col0 = wc * 32 + 8 * fq;
#pragma unroll
        for (int ai = 0; ai < 2; ++ai)
#pragma unroll
            for (int m = 0; m < 4; ++m) { bf16_t* rowp = Vt + ((size_t)u.pn * D + row0 + ai * HALF + m * 16) * NMEM + col0;
#pragma unroll
                for (int bj = 0; bj < 2; ++bj) *(u32x4*)(rowp + bj * HALF) = pack8(acc[ai][bj][m][0], acc[ai][bj][m][1]); }
    }
};

__device__ __forceinline__ void tr_item(const float* W, int K, int N, bf16_t* WT, const float* g, float cs, int mode, LAS float* scr, int item, int lane) {
    const int nblk = N / 64, kb = item / nblk, nb = item % nblk, k0 = 64 * kb, n0 = 64 * nb;
    int orow;
    if (mode == 3) {
        const int sec = n0 >> 9, np = n0 & 511, il = (np >> 7) * 256 + (np & 127);
        orow = sec == 0 ? il : sec == 1 ? il + 128 : sec == 2 ? 1024 + il : sec == 3 ? 2048 + np : 1024 + il + 128;
    } else orow = mode == 0 ? n0 : ((n0 >> 7) * 256 + (n0 & 127) + (mode == 2 ? 128 : 0));
    const int kq = lane >> 4, n4 = (lane & 15) * 4;
    f32x4 v[16]; float sc[16];
#pragma unroll
    for (int i = 0; i < 16; ++i) { const int kk = 4 * i + kq; v[i] = *(const f32x4*)(W + (size_t)(k0 + kk) * N + n0 + n4); sc[i] = g ? g[k0 + kk] * cs : cs; }
    __builtin_amdgcn_sched_barrier(0);
#pragma unroll
    for (int i = 0; i < 16; ++i) { const int kk = 4 * i + kq; LAS float* d = scr + kk * 65 + n4; d[0] = v[i][0] * sc[i]; d[1] = v[i][1] * sc[i]; d[2] = v[i][2] * sc[i]; d[3] = v[i][3] * sc[i]; }
    asm volatile("s_waitcnt lgkmcnt(0)" ::: "memory");
    const int c = lane & 7;
#pragma unroll
    for (int j = 0; j < 8; ++j) { const int n = (lane >> 3) + 8 * j; const LAS float* p = scr + (8 * c) * 65 + n;
        u32x4 o; o.x = cvt_pk_bf16(p[0 * 65], p[1 * 65]); o.y = cvt_pk_bf16(p[2 * 65], p[3 * 65]); o.z = cvt_pk_bf16(p[4 * 65], p[5 * 65]); o.w = cvt_pk_bf16(p[6 * 65], p[7 * 65]);
        *(u32x4*)(WT + (size_t)(orow + n) * K + k0 + 8 * c) = o; }
    asm volatile("s_waitcnt lgkmcnt(0)" ::: "memory");
}

struct Args { const float* in[28]; float* out; unsigned char* ws; };

__device__ __forceinline__ void p0_weights(const Args& a, int l, int part, LAS unsigned char* lds, int gw, int NGW, int wave, int lane) {
    unsigned char* ws = a.ws;
    LAS float* scr = (LAS float*)(lds + wave * 16640);
    const float QS = 0.0625f * 1.44269504f;
    const int NIN = l ? DZ1 : DZ0, I_IN = 16 * (NIN / 64);
    constexpr int I_SQ = 16 * 16, I_GU = 16 * (DFF / 64), I_DN = (DFF / 64) * 16;
    const int I_A = (part & 1) ? I_IN : 0, I_S = (part & 2) ? I_SQ : 0, I_KV = (part & 4) ? I_SQ : 0, I_G = (part & 8) ? I_GU : 0, I_D = (part & 16) ? I_DN : 0;
    const int NITEMS = I_A + 3 * I_S + 2 * I_KV + 2 * I_G + I_D;
    unsigned char* wl = ws + WS_W + (size_t)l * W_LAYER;
    for (int it = gw; it < NITEMS; it += NGW) {
        int r = it; bool found = false; const float* W = nullptr; int K = 0, N = 0, mode = 0; bf16_t* WT = nullptr; const float* gv = nullptr; float cs = 1.f;
#define SEL(NI, Wp, K_, N_, WTp, g_, cs_, mode_) if (!found) { if (r < (NI)) { W = (Wp); K = (K_); N = (N_); WT = (bf16_t*)(WTp); gv = (g_); cs = (cs_); mode = (mode_); found = true; } else r -= (NI); }
        SEL(I_A, l ? a.in[15] : a.in[7], D, NIN, wl + W_IN, a.in[2] + l * D, 1.f, l ? 0 : 3)
        SEL(I_S, l ? a.in[20] : a.in[14], D, D, wl + W_OUT, nullptr, 1.f, 0)
        SEL(I_S, a.in[21] + (size_t)l * D * D, D, D, wl + W_Q, a.in[3] + l * D, QS, 0)
        SEL(I_KV, a.in[22] + (size_t)l * D * D, D, D, wl + W_KV, nullptr, 1.f, 0)
        SEL(I_KV, a.in[23] + (size_t)l * D * D, D, D, wl + W_KV + (size_t)D * D * 2, nullptr, 1.f, 0)
        SEL(I_S, a.in[24] + (size_t)l * D * D, D, D, wl + W_O, nullptr, 1.f, 0)
        SEL(I_G, a.in[25] + (size_t)l * D * DFF, D, DFF, wl + W_GU, a.in[5] + l * D, 1.f, 1)
        SEL(I_G, a.in[26] + (size_t)l * D * DFF, D, DFF, wl + W_GU, a.in[5] + l * D, 1.f, 2)
        SEL(I_D, a.in[27] + (size_t)l * D * DFF, DFF, D, wl + W_DN, nullptr, 1.f, 0)
#undef SEL
        tr_item(W, K, N, WT, gv, cs, mode, scr, r, lane);
    }
}
__device__ __forceinline__ void p0_prologue(const Args& a, LAS unsigned char* lds, int gw, int NGW, int wave, int lane, int xrow0) {
    unsigned char* ws = a.ws;
    { const f32x4* src = (const f32x4*)a.in[18]; u32x2* dst = (u32x2*)(ws + WS_WSB);
      for (int i = gw * 64 + lane; i < 8 * 128 * 128 / 4; i += NGW * 64) { const f32x4 v = src[i]; u32x2 o; o.x = cvt_pk_bf16(v[0], v[1]); o.y = cvt_pk_bf16(v[2], v[3]); dst[i] = o; } }
    { float* ssq = (float*)(ws + WS_SSQ); bf16_t* HB = (bf16_t*)(ws + WS_HB);
      _Pragma("unroll 1") for (int it = 0; it < 2; ++it) { const int m0 = xrow0 + wave * 8 + it * 4;
          f32x4 v[4][4];
#pragma unroll
          for (int r = 0; r < 4; ++r) { const f32x4* xr = (const f32x4*)(a.in[0] + (size_t)(m0 + r) * D) + lane;
#pragma unroll
              for (int j = 0; j < 4; ++j) v[r][j] = xr[64 * j]; }
          __builtin_amdgcn_sched_barrier(0);
#pragma unroll
          for (int r = 0; r < 4; ++r) { float s = 0.f;
#pragma unroll
              for (int j = 0; j < 4; ++j) s += (v[r][j][0] * v[r][j][0] + v[r][j][1] * v[r][j][1]) + (v[r][j][2] * v[r][j][2] + v[r][j][3] * v[r][j][3]);
              s = wave_sum(s);
              u32x2* o = (u32x2*)(HB + (size_t)(m0 + r) * D) + lane;
#pragma unroll
              for (int j = 0; j < 4; ++j) { u32x2 w; w.x = cvt_pk_bf16(v[r][j][0], v[r][j][1]); w.y = cvt_pk_bf16(v[r][j][2], v[r][j][3]); o[64 * j] = w; }
              if (lane < 16) ssq[(size_t)(m0 + r) * 16 + lane] = lane == 0 ? s : 0.f; }
      } }
    { bf16_t* MN = (bf16_t*)(ws + WS_MEMN);
      for (int m = gw; m < 2 * 512; m += NGW) { const int l = m >> 9, row = m & 511;
          const f32x4* xr = (const f32x4*)(a.in[1] + (size_t)row * D) + lane; const f32x4* gr = (const f32x4*)(a.in[4] + l * D) + lane; f32x4 v[4]; float s = 0.f;
#pragma unroll
          for (int j = 0; j < 4; ++j) { v[j] = xr[64 * j]; s += (v[j][0] * v[j][0] + v[j][1] * v[j][1]) + (v[j][2] * v[j][2] + v[j][3] * v[j][3]); }
          const float rs = rsqrtf(wave_sum(s) * (1.0f / 1024.0f) + RMS_EPS);
          u32x2* o = (u32x2*)(MN + ((size_t)l * 512 + row) * D) + lane;
#pragma unroll
          for (int j = 0; j < 4; ++j) { const f32x4 g = gr[64 * j]; u32x2 w; w.x = cvt_pk_bf16(v[j][0] * rs * g[0], v[j][1] * rs * g[1]); w.y = cvt_pk_bf16(v[j][2] * rs * g[2], v[j][3] * rs * g[3]); o[64 * j] = w; }
      } }
}

__device__ __forceinline__ void unpack8(const u32x4 r, float (&v)[8]) { v[0] = bflo(r.x); v[1] = bfhi(r.x); v[2] = bflo(r.y); v[3] = bfhi(r.y); v[4] = bflo(r.z); v[5] = bfhi(r.z); v[6] = bflo(r.w); v[7] = bfhi(r.w); }
__device__ __forceinline__ void conv_phase(LAS unsigned char* lds, const bf16_t* Z, bf16_t* Mo, const float* cw, const float* cb, const float* lg, const float* lb,
                                           const float* bw, const float* bb, int G, int c, int tid_in) {
    constexpr int TT = 32, RR = TT + 30;
    int tid_ = tid_in; asm volatile("" : "+v"(tid_)); asm volatile("" : "+s"(c), "+s"(G));
    const int tid = tid_, lane = tid & 63, wid = tid >> 6;
    LAS float* as = (LAS float*)lds;
    LAS float* os = (LAS float*)lds;
    for (int u = c; u < G; ++u) {
        const int t0 = u * TT, b = t0 / SEQ, s0 = t0 % SEQ;
        const bf16_t* zb = Z + (size_t)b * SEQ * DZ3;
        __syncthreads();
        { u32x4 rv[8];
#pragma unroll
          for (int i = 0; i < 8; ++i) { const int idx = tid + 512 * i, r = idx >> 6, cc = idx & 63, sq = s0 - 15 + r; const bool ok = (idx < RR * 64) && (sq >= 0) && (sq < SEQ);
              rv[i] = *(const u32x4*)(zb + (size_t)(ok ? sq : s0) * DZ3 + cc * 8);
              if (!ok) rv[i] = (u32x4){0u, 0u, 0u, 0u}; }
          __builtin_amdgcn_sched_barrier(0);
#pragma unroll
          for (int i = 0; i < 8; ++i) { const int idx = tid + 512 * i, r = idx >> 6, cc = idx & 63; float v[8]; unpack8(rv[i], v);
              if (idx < RR * 64) { *(LAS f32x4*)(as + r * 512 + cc * 8) = (f32x4){v[0], v[1], v[2], v[3]}; *(LAS f32x4*)(as + r * 512 + cc * 8 + 4) = (f32x4){v[4], v[5], v[6], v[7]}; } } }
        __syncthreads();
        float o[TT];
        {
          const float* cw_ = cw; const float* cb_ = cb; asm volatile("" : "+s"(cw_), "+s"(cb_));
          f32x2 w2[16];
#pragma unroll
          for (int j = 0; j < 16; ++j) { w2[j].x = cw_[(2 * j) * 512 + tid]; w2[j].y = (2 * j + 1 < 31) ? cw_[(2 * j + 1) * 512 + tid] : 0.f; }
          const float cbias = cb_[tid];
          f32x2 aE[31], aO[31];
#pragma unroll
          for (int i = 0; i < 31; ++i) { aE[i].x = as[(2 * i) * 512 + tid]; aE[i].y = as[(2 * i + 1) * 512 + tid]; }
#pragma unroll
          for (int i = 0; i < 31; ++i) { aO[i].x = aE[i].y; aO[i].y = (i < 30) ? aE[i + 1].x : 0.f; }
#pragma unroll
          for (int i = 0; i < TT / 2; ++i) { f32x2 pe = (f32x2){0.f, 0.f}, po = (f32x2){0.f, 0.f};
#pragma unroll
              for (int j = 0; j < 16; ++j) { pe += w2[j] * aE[i + j]; po += w2[j] * aO[i + j]; }
              o[2 * i] = cbias + (pe.x + pe.y); o[2 * i + 1] = cbias + (po.x + po.y); } }
        __syncthreads();
#pragma unroll
        for (int t = 0; t < TT; ++t) os[t * 512 + tid] = o[t];
        __syncthreads();
        { const float* lg_ = lg; const float* lb_ = lb; asm volatile("" : "+s"(lg_), "+s"(lb_));
          const f32x4 g0 = *(const f32x4*)(lg_ + 8 * lane), g1 = *(const f32x4*)(lg_ + 8 * lane + 4), b0 = *(const f32x4*)(lb_ + 8 * lane), b1 = *(const f32x4*)(lb_ + 8 * lane + 4);
#pragma unroll
          for (int i = 0; i < TT / 8; ++i) { const int t = (TT / 8) * wid + i;
              const f32x4 v0 = *(const LAS f32x4*)(os + t * 512 + 8 * lane), v1 = *(const LAS f32x4*)(os + t * 512 + 8 * lane + 4);
              const float mean = wave_sum(((v0[0] + v0[1]) + (v0[2] + v0[3])) + ((v1[0] + v1[1]) + (v1[2] + v1[3]))) * (1.0f / 512.0f);
              const f32x4 d0 = v0 - mean, d1 = v1 - mean;
              const float var = wave_sum(((d0[0] * d0[0] + d0[1] * d0[1]) + (d0[2] * d0[2] + d0[3] * d0[3])) + ((d1[0] * d1[0] + d1[1] * d1[1]) + (d1[2] * d1[2] + d1[3] * d1[3]))) * (1.0f / 512.0f);
              const float rstd = rsqrtf(var + LN_EPS);
              f32x4 y0 = d0 * rstd * g0 + b0, y1 = d1 * rstd * g1 + b1;
#pragma unroll
              for (int j = 0; j < 4; ++j) { y0[j] = y0[j] * sigm(y0[j]); y1[j] = y1[j] * sigm(y1[j]); }
              *(u32x4*)(Mo + (size_t)(t0 + t) * D + 8 * lane) = pack8(y0, y1); } }
        { const int cc = tid & 63, rgp = tid >> 6, sb = s0 + 4 * rgp;
          u32x4 xx[6], gb[4];
#pragma unroll
          for (int r = 0; r < 6; ++r) { const int sq = sb - 1 + r; const bool ok = (sq >= 0) && (sq < SEQ); const bf16_t* p = zb + (size_t)(ok ? sq : s0) * DZ3 + cc * 8;
              xx[r] = *(const u32x4*)(p + 512); if (!ok) xx[r] = (u32x4){0u, 0u, 0u, 0u};
              if (r >= 1 && r <= 4) gb[r - 1] = *(const u32x4*)(p + 1024); }
          const float* bw_ = bw; const float* bb_ = bb; asm volatile("" : "+s"(bw_), "+s"(bb_));
          const f32x4 w0a = *(const f32x4*)(bw_ + cc * 8), w0b = *(const f32x4*)(bw_ + cc * 8 + 4), w1a = *(const f32x4*)(bw_ + 512 + cc * 8), w1b = *(const f32x4*)(bw_ + 512 + cc * 8 + 4),
                      w2a = *(const f32x4*)(bw_ + 1024 + cc * 8), w2b = *(const f32x4*)(bw_ + 1024 + cc * 8 + 4), bba = *(const f32x4*)(bb_ + cc * 8), bbb = *(const f32x4*)(bb_ + cc * 8 + 4);
          __builtin_amdgcn_sched_barrier(0);
          float x[6][8];
#pragma unroll
          for (int r = 0; r < 6; ++r) unpack8(xx[r], x[r]);
#pragma unroll
          for (int t = 0; t < 4; ++t) { float gbv[8]; unpack8(gb[t], gbv); f32x4 y0, y1;
#pragma unroll
              for (int j = 0; j < 4; ++j) { y0[j] = gbv[j] * (w0a[j] * x[t][j] + w1a[j] * x[t + 1][j] + w2a[j] * x[t + 2][j] + bba[j]);
                  y1[j] = gbv[4 + j] * (w0b[j] * x[t][4 + j] + w1b[j] * x[t + 1][4 + j] + w2b[j] * x[t + 2][4 + j] + bbb[j]); }
              *(u32x4*)(Mo + (size_t)(t0 + 4 * rgp + t) * D + 512 + cc * 8) = pack8(y0, y1); } }
    }
}

__device__ __forceinline__ void sgu_phase(LAS unsigned char* lds, const bf16_t* Z1, const float* vst, const bf16_t* Wsb, const float* bs, const float* lg, const float* lb, bf16_t* Y, int G, int c, int tid_in) {
    constexpr int RS = 272;
    int tid_ = tid_in; asm volatile("" : "+v"(tid_)); asm volatile("" : "+s"(c), "+s"(G));
    const int tid = tid_, lane = tid & 63, wid = tid >> 6, fr = lane & 15, fq = lane >> 4;
    LAS unsigned char* Wl = lds; LAS unsigned char* Vl = lds + 128 * RS;
    for (int u = c; u < G; ++u) {
        const int n = u >> 3, g = u & 7, t0 = n * 128, cg0 = g * 128;
        const int q = tid & 127, qc = tid >> 7;
        u32x4 wt[4], vr[4]; f32x4 sp[8];
#pragma unroll
        for (int i = 0; i < 4; ++i) { const int idx = tid + 512 * i, p = idx >> 4, chn = idx & 15; wt[i] = *(const u32x4*)(Wsb + ((size_t)g * 128 + p) * 128 + chn * 8); }
#pragma unroll
        for (int i = 0; i < 4; ++i) vr[i] = *(const u32x4*)(Z1 + (size_t)(t0 + q) * DZ1 + 1024 + cg0 + qc * 32 + i * 8);
#pragma unroll
        for (int j = 0; j < 8; ++j) sp[j] = *(const f32x4*)(vst + (size_t)(t0 + q) * 32 + 4 * j);
        const int pr = 16 * wid + fr, row = t0 + pr;
        u32x2 uu[8];
#pragma unroll
        for (int cb = 0; cb < 8; ++cb) uu[cb] = *(const u32x2*)(Z1 + (size_t)row * DZ1 + cg0 + 16 * cb + 4 * fq);
        const float bias = bs[g * 128 + pr];
        __builtin_amdgcn_sched_barrier(0);
        __syncthreads();
#pragma unroll
        for (int i = 0; i < 4; ++i) { const int idx = tid + 512 * i, p = idx >> 4, chn = idx & 15; *(LAS u32x4*)(Wl + p * RS + chn * 16) = wt[i]; }
        { float s1 = 0.f, s2 = 0.f;
#pragma unroll
          for (int j = 0; j < 8; ++j) { s1 += sp[j][0] + sp[j][2]; s2 += sp[j][1] + sp[j][3]; }
          const float mean = s1 * (1.0f / 1024.0f), var = s2 * (1.0f / 1024.0f) - mean * mean, rstd = rsqrtf(var + LN_EPS);
#pragma unroll
          for (int i = 0; i < 4; ++i) { const int c0 = qc * 32 + i * 8; float v[8]; unpack8(vr[i], v);
              const f32x4 g0 = *(const f32x4*)(lg + cg0 + c0), g1 = *(const f32x4*)(lg + cg0 + c0 + 4), b0 = *(const f32x4*)(lb + cg0 + c0), b1 = *(const f32x4*)(lb + cg0 + c0 + 4);
#pragma unroll
              for (int j = 0; j < 8; ++j) { const float gg = j < 4 ? g0[j & 3] : g1[j & 3], bbv = j < 4 ? b0[j & 3] : b1[j & 3];
                  *(LAS bf16_t*)(Vl + (c0 + j) * RS + q * 2) = f2bf((v[j] - mean) * rstd * gg + bbv); } } }
        __syncthreads();
        bf16x8 wf[4];
#pragma unroll
        for (int ks = 0; ks < 4; ++ks) wf[ks] = *(const LAS bf16x8*)(Wl + (16 * wid + fr) * RS + (32 * ks + 8 * fq) * 2);
        f32x4 acc[8];
#pragma unroll
        for (int cb = 0; cb < 8; ++cb) { acc[cb] = (f32x4){0.f, 0.f, 0.f, 0.f};
#pragma unroll
            for (int ks = 0; ks < 4; ++ks) { const bf16x8 vf = *(const LAS bf16x8*)(Vl + (16 * cb + fr) * RS + (32 * ks + 8 * fq) * 2);
                acc[cb] = __builtin_amdgcn_mfma_f32_16x16x32_bf16(vf, wf[ks], acc[cb], 0, 0, 0); } }
#pragma unroll
        for (int cb = 0; cb < 8; ++cb) { const int cc = cg0 + 16 * cb + 4 * fq;
            u32x2 o; o.x = cvt_pk_bf16(bflo(uu[cb].x) * (acc[cb][0] + bias), bfhi(uu[cb].x) * (acc[cb][1] + bias)); o.y = cvt_pk_bf16(bflo(uu[cb].y) * (acc[cb][2] + bias), bfhi(uu[cb].y) * (acc[cb][3] + bias));
            *(u32x2*)(Y + (size_t)row * D + cc) = o; }
    }
}

__device__ __forceinline__ void attn_phase(LAS unsigned char* lds, const bf16_t* Q, const bf16_t* Kb, const bf16_t* Vt, bf16_t* O, int G, int c, int tid_in) {
    constexpr int RS = 528;
    int tid_ = tid_in; asm volatile("" : "+v"(tid_)); asm volatile("" : "+s"(c), "+s"(G));
    const int tid = tid_, lane = tid & 63, wid = tid >> 6, fr = lane & 15, fq = lane >> 4;
    for (int u = c; u < 512; u += G) {
        const int qb = u >> 2, h = u & 3, b = qb >> 6, q0 = qb * 128;
        const bf16_t* qrow = Q + (size_t)(q0 + 16 * wid + fr) * D + h * 256 + 8 * fq;
        bf16x8 qf[8];
#pragma unroll
        for (int ks = 0; ks < 8; ++ks) qf[ks] = *(const bf16x8*)(qrow + 32 * ks);
        __syncthreads();
        { u32x4 tv[16];
#pragma unroll
          for (int i = 0; i < 16; ++i) { const int idx = tid + 512 * i, key = idx >> 5, ch = idx & 31; tv[i] = *(const u32x4*)(Kb + (size_t)(b * 256 + key) * D + h * 256 + ch * 8); }
          __builtin_amdgcn_sched_barrier(0);
#pragma unroll
          for (int i = 0; i < 16; ++i) { const int idx = tid + 512 * i, key = idx >> 5, ch = idx & 31; *(LAS u32x4*)(lds + key * RS + ch * 16) = tv[i]; } }
        __syncthreads();
        f32x4 S[16];
#pragma unroll
        for (int kb = 0; kb < 16; ++kb) { S[kb] = (f32x4){0.f, 0.f, 0.f, 0.f};
#pragma unroll
            for (int ks = 0; ks < 8; ++ks) { const bf16x8 kf = *(const LAS bf16x8*)(lds + (16 * kb + fr) * RS + (32 * ks + 8 * fq) * 2);
                S[kb] = __builtin_amdgcn_mfma_f32_16x16x32_bf16(kf, qf[ks], S[kb], 0, 0, 0); } }
        float mx = -3.0e38f;
#pragma unroll
        for (int kb = 0; kb < 16; ++kb) mx = fmaxf(mx, fmaxf(fmaxf(S[kb][0], S[kb][1]), fmaxf(S[kb][2], S[kb][3])));
        mx = xrow16_max(mx);
        float l = 0.f;
#pragma unroll
        for (int kb = 0; kb < 16; ++kb)
#pragma unroll
            for (int j = 0; j < 4; ++j) { const float p = __builtin_amdgcn_exp2f(S[kb][j] - mx); S[kb][j] = p; l += p; }
        l = xrow16_sum(l);
        bf16x8 pf[8];
#pragma unroll
        for (int cc = 0; cc < 8; ++cc) { const u32x4 w = pack8(S[2 * cc], S[2 * cc + 1]); pf[cc] = __builtin_bit_cast(bf16x8, w); }
        __syncthreads();
        { u32x4 tv[16];
#pragma unroll
          for (int i = 0; i < 16; ++i) { const int idx = tid + 512 * i, d = idx >> 5, ch = idx & 31; tv[i] = *(const u32x4*)(Vt + ((size_t)b * D + h * 256 + d) * NMEM + ch * 8); }
          __builtin_amdgcn_sched_barrier(0);
#pragma unroll
          for (int i = 0; i < 16; ++i) { const int idx = tid + 512 * i, d = idx >> 5, ch = idx & 31; *(LAS u32x4*)(lds + d * RS + ch * 16) = tv[i]; } }
        __syncthreads();
        const float inv = 1.0f / l;
        bf16_t* orow = O + (size_t)(q0 + 16 * wid + fr) * D + h * 256 + 4 * fq;
#pragma unroll
        for (int db = 0; db < 16; ++db) { f32x4 oa = (f32x4){0.f, 0.f, 0.f, 0.f};
#pragma unroll
            for (int cc = 0; cc < 8; ++cc) { const bf16x8 vf = *(const LAS bf16x8*)(lds + (16 * db + fr) * RS + (32 * cc + 8 * fq) * 2);
                oa = __builtin_amdgcn_mfma_f32_16x16x32_bf16(vf, pf[cc], oa, 0, 0, 0); }
            u32x2 o; o.x = cvt_pk_bf16(oa[0] * inv, oa[1] * inv); o.y = cvt_pk_bf16(oa[2] * inv, oa[3] * inv);
            *(u32x2*)(orow + 16 * db) = o; }
    }
}

struct EpiQAttn {
    static constexpr bool PERM = true, AFTER_DRAIN = true;
    const float* ssq; const bf16_t* Kb; const bf16_t* Vt; bf16_t* O;
    __device__ __forceinline__ void operator()(const f32x4 (&)[2][2][4][2], const Unit&, int, int, int, int) const {}
    __device__ __forceinline__ void fused(f32x4 (&acc)[2][2][4][2], const Unit& u, int wr, int wc, int fr, int fq, PG8_LAS unsigned char* lds, int wid, int lane) const {
        constexpr int RS = 528;
        const int tid = wid * 64 + lane, h = u.pn, b = u.pm >> 5;
        const unsigned r0 = (unsigned)tid >> 5, ch = (unsigned)tid & 31u;
        const bf16_t* kbase = Kb + (size_t)(b * 256) * D + h * 256; const bf16_t* vbase = Vt + ((size_t)b * D + h * 256) * NMEM;
        const unsigned goffk = r0 * (unsigned)(D * 2) + ch * 16u, goffv = r0 * (unsigned)(NMEM * 2) + ch * 16u, loff = r0 * (unsigned)RS + ch * 16u;
        unsigned loffa = loff, loffb = loff + 7 * 16 * RS; asm volatile("" : "+v"(loffa), "+v"(loffb));
#pragma unroll
        for (int ai = 0; ai < 2; ++ai)
#pragma unroll
            for (int m = 0; m < 4; ++m) { const int lr = ai * HALF + wr * 64 + m * 16 + fr; const float rs = ((const PG8_LAS float*)(lds + TAB_OFF))[lr];
#pragma unroll
                for (int bj = 0; bj < 2; ++bj) *(PG8_LAS u32x4*)(lds + lr * RS + (bj * HALF + wc * 32 + 8 * fq) * 2) = pack8(acc[ai][bj][m][0] * rs, acc[ai][bj][m][1] * rs); }
        __syncthreads();
        bf16x8 qf[2][8];
#pragma unroll
        for (int qb = 0; qb < 2; ++qb)
#pragma unroll
            for (int ks = 0; ks < 8; ++ks) qf[qb][ks] = *(const PG8_LAS bf16x8*)(lds + (32 * wid + 16 * qb + fr) * RS + (32 * ks + 8 * fq) * 2);
        __builtin_amdgcn_sched_barrier(0);
        u32x4 tv[16];
#pragma unroll
        for (int i = 0; i < 16; ++i) tv[i] = *(const u32x4*)((const char*)kbase + (goffk + (unsigned)(i * 16 * D * 2)));
        __builtin_amdgcn_sched_barrier(0);
        __syncthreads();
#pragma unroll
        for (int i = 0; i < 16; ++i) *(PG8_LAS u32x4*)(lds + (i < 7 ? loffa : loffb) + (i < 7 ? i : i - 7) * 16 * RS) = tv[i];
        __syncthreads();
        unsigned fb0 = (unsigned)(fr * RS + fq * 16), fb1 = fb0 + 8 * 16 * RS; asm volatile("" : "+v"(fb0), "+v"(fb1));
        f32x4 S[2][16];
#pragma unroll
        for (int kb = 0; kb < 16; ++kb) { S[0][kb] = (f32x4){0.f, 0.f, 0.f, 0.f}; S[1][kb] = (f32x4){0.f, 0.f, 0.f, 0.f};
#pragma unroll
            for (int ks = 0; ks < 8; ++ks) { const bf16x8 kf = *(const PG8_LAS bf16x8*)(lds + (kb < 8 ? fb0 : fb1) + ((kb & 7) * 16 * RS + ks * 64));
                S[0][kb] = __builtin_amdgcn_mfma_f32_16x16x32_bf16(kf, qf[0][ks], S[0][kb], 0, 0, 0);
                S[1][kb] = __builtin_amdgcn_mfma_f32_16x16x32_bf16(kf, qf[1][ks], S[1][kb], 0, 0, 0); } }
        __builtin_amdgcn_sched_barrier(0);
        bf16x8 pf[2][8]; float inv[2];
#pragma unroll
        for (int qb = 0; qb < 2; ++qb) {
            float mx = -3.0e38f;
#pragma unroll
            for (int kb = 0; kb < 16; ++kb) mx = fmaxf(mx, fmaxf(fmaxf(S[qb][kb][0], S[qb][kb][1]), fmaxf(S[qb][kb][2], S[qb][kb][3])));
            mx = xrow16_max(mx);
            float l = 0.f;
#pragma unroll
            for (int kb = 0; kb < 16; ++kb)
#pragma unroll
                for (int j = 0; j < 4; ++j) { const float p = __builtin_amdgcn_exp2f(S[qb][kb][j] - mx); S[qb][kb][j] = p; l += p; }
            l = xrow16_sum(l); inv[qb] = 1.0f / l;
#pragma unroll
            for (int cc = 0; cc < 8; ++cc) { const u32x4 w = pack8(S[qb][2 * cc], S[qb][2 * cc + 1]); pf[qb][cc] = __builtin_bit_cast(bf16x8, w); }
        }
        __builtin_amdgcn_sched_barrier(0);
        unsigned loff2a = r0 * (unsigned)RS + ((ch >> 2) * 32u + 16u * (ch & 1u) + 4u * ((ch >> 1) & 1u)) * 2u, loff2b = loff2a + 7 * 16 * RS; asm volatile("" : "+v"(loff2a), "+v"(loff2b));
#pragma unroll
        for (int i = 0; i < 16; ++i) tv[i] = *(const u32x4*)((const char*)vbase + (goffv + (unsigned)(i * 16 * NMEM * 2)));
        __builtin_amdgcn_sched_barrier(0);
        __syncthreads();
#pragma unroll
        for (int i = 0; i < 16; ++i) { PG8_LAS unsigned char* d = lds + (i < 7 ? loff2a : loff2b) + (i < 7 ? i : i - 7) * 16 * RS; *(PG8_LAS u32x2*)d = (u32x2){tv[i].x, tv[i].y}; *(PG8_LAS u32x2*)(d + 16) = (u32x2){tv[i].z, tv[i].w}; }
        __syncthreads();
        unsigned vb0 = (unsigned)(fr * RS + fq * 16), vb1 = vb0 + 8 * 16 * RS; asm volatile("" : "+v"(vb0), "+v"(vb1));
        bf16_t* orow = O + (size_t)(u.pm * BM + 32 * wid + fr) * D + h * 256 + 4 * fq;
#pragma unroll
        for (int db = 0; db < 16; ++db) { f32x4 o0 = (f32x4){0.f, 0.f, 0.f, 0.f}, o1 = (f32x4){0.f, 0.f, 0.f, 0.f};
#pragma unroll
            for (int cc = 0; cc < 8; ++cc) { const bf16x8 vf = *(const PG8_LAS bf16x8*)(lds + (db < 8 ? vb0 : vb1) + ((db & 7) * 16 * RS + cc * 64));
                o0 = __builtin_amdgcn_mfma_f32_16x16x32_bf16(vf, pf[0][cc], o0, 0, 0, 0); o1 = __builtin_amdgcn_mfma_f32_16x16x32_bf16(vf, pf[1][cc], o1, 0, 0, 0); }
            u32x2 w0, w1; w0.x = cvt_pk_bf16(o0[0] * inv[0], o0[1] * inv[0]); w0.y = cvt_pk_bf16(o0[2] * inv[0], o0[3] * inv[0]);
            w1.x = cvt_pk_bf16(o1[0] * inv[1], o1[1] * inv[1]); w1.y = cvt_pk_bf16(o1[2] * inv[1], o1[3] * inv[1]);
            *(u32x2*)(orow + 16 * db) = w0; *(u32x2*)(orow + (size_t)16 * D + 16 * db) = w1; }
        __syncthreads();
    }
};

__device__ __forceinline__ int lane_id_volatile() { int l; asm volatile("v_mbcnt_lo_u32_b32 %0, -1, 0\n\tv_mbcnt_hi_u32_b32 %0, -1, %0" : "=v"(l)); return l; }
#ifndef REP_P0
#define REP_P0 1
#endif
#ifndef REP_CONV
#define REP_CONV 1
#endif
#ifndef REP_SGU
#define REP_SGU 1
#endif
#ifndef REP_ATTN
#define REP_ATTN 1
#endif
#ifndef LSTART
#define LSTART 0
#endif
#ifndef LEND
#define LEND 2
#endif
struct PanelOrder {
    int pm, j, nN;
    __device__ __forceinline__ bool next(int i, Unit& u) const { const int pn = j + 4 * i; if (pn >= nN) return false; int pmv = pm; asm volatile("" : "+s"(pmv)); u.pm = pmv; u.pn = pn; return true; }
    __device__ __forceinline__ void a_ready(const Unit&) const {}
    __device__ __forceinline__ void done(const Unit&) const {}
};
__device__ __forceinline__ void group_barrier(unsigned* cnt, unsigned target, bool coxcd, unsigned* tmo, int ktid) {
    asm volatile("s_waitcnt vmcnt(0)" ::: "memory");
    __syncthreads();
    if (ktid == 0) {
        if (!coxcd) { __builtin_amdgcn_fence(__ATOMIC_RELEASE, "agent"); asm volatile("s_waitcnt vmcnt(0)" ::: "memory"); }
        (void)xb_add(cnt, 1u);
        unsigned sp = 0;
        while (xb_ld(cnt) < target) { if ((++sp & 255u) == 0u) { if (xb_ld(tmo)) break; if (sp > XB_SPIN_CAP) { atomicAdd(tmo, 1u); break; } } }
        __builtin_amdgcn_fence(__ATOMIC_ACQUIRE, "agent");
        asm volatile("s_waitcnt vmcnt(0)" ::: "memory");
    }
    __syncthreads();
}

struct EpiResFinal {
    static constexpr bool PERM = true, AFTER_DRAIN = true;
    const bf16_t* hb; float* ssq; float* out; const float* gfin; unsigned* cnt; unsigned target; bool coxcd; unsigned* tmo;
    __device__ __forceinline__ void operator()(const f32x4 (&)[2][2][4][2], const Unit&, int, int, int, int) const {}
    __device__ __forceinline__ void fused(f32x4 (&acc)[2][2][4][2], const Unit& u, int wr, int wc, int fr, int fq, PG8_LAS unsigned char* lds, int wid, int lane) const {
        const int row0 = u.pm * BM + wr * 64 + fr, col0 = u.pn * BM + wc * 32 + 8 * fq;
#pragma unroll
        for (int ai = 0; ai < 2; ++ai)
#pragma unroll
            for (int m = 0; m < 4; ++m) { const int row = row0 + ai * HALF + m * 16; const size_t off = (size_t)row * D + col0; f32x2 q2 = (f32x2){0.f, 0.f};
#pragma unroll
                for (int bj = 0; bj < 2; ++bj) { const u32x4 bb = *(const u32x4*)(hb + off + bj * HALF);
                    const f32x4 b0 = (f32x4){bflo(bb.x), bfhi(bb.x), bflo(bb.y), bfhi(bb.y)}, b1 = (f32x4){bflo(bb.z), bfhi(bb.z), bflo(bb.w), bfhi(bb.w)};
                    const f32x4 v0 = b0 + acc[ai][bj][m][0], v1 = b1 + acc[ai][bj][m][1];
                    acc[ai][bj][m][0] = v0; acc[ai][bj][m][1] = v1;
                    const f32x2 a0 = (f32x2){v0[0], v0[1]}, a1 = (f32x2){v0[2], v0[3]}, a2 = (f32x2){v1[0], v1[1]}, a3 = (f32x2){v1[2], v1[3]};
                    q2 += a0 * a0; q2 += a1 * a1; q2 += a2 * a2; q2 += a3 * a3; }
                const float q = xrow16_sum(q2.x + q2.y);
                if (fq == 0) ssq[(size_t)row * 16 + u.pn * 4 + wc] = q; }
        group_barrier(cnt, target, coxcd, tmo, wid * 64 + lane);
        f32x4 gv[2][2];
#pragma unroll
        for (int bj = 0; bj < 2; ++bj) { gv[bj][0] = *(const f32x4*)(gfin + col0 + bj * HALF); gv[bj][1] = *(const f32x4*)(gfin + col0 + bj * HALF + 4); }
#pragma unroll
        for (int ai = 0; ai < 2; ++ai)
#pragma unroll
            for (int m = 0; m < 4; ++m) { const int row = row0 + ai * HALF + m * 16; const float rs = row_rstd(ssq, row, fq); float* o = out + (size_t)row * D + col0;
#pragma unroll
                for (int bj = 0; bj < 2; ++bj) { *(f32x4*)(o + bj * HALF) = acc[ai][bj][m][0] * rs * gv[bj][0]; *(f32x4*)(o + bj * HALF + 4) = acc[ai][bj][m][1] * rs * gv[bj][1]; } }
    }
};

__global__ void __launch_bounds__(NTHR, 2) fwd_kernel(Args a) {
    extern __shared__ __attribute__((aligned(16))) unsigned char lds_raw[];
    LAS unsigned char* lds = (LAS unsigned char*)lds_raw;
    volatile LAS unsigned* MISC = (volatile LAS unsigned*)(lds + MISC_OFF);
    const int wave = __builtin_amdgcn_readfirstlane((int)threadIdx.x >> 6);
#define TID() (wave * 64 + lane_id_volatile())
    const int tid = TID(), lane = tid & 63;
    const int G = gridDim.x, bx = blockIdx.x, vcu = (bx % 8) * (G / 8) + bx / 8;
    unsigned char* ws = a.ws;
    unsigned* ctl = (unsigned*)(ws + WS_CTL);
    int pm, pj; { StaticOrder S0; S0.init(T, D, G, bx); Unit own; S0.next(0, own); pm = own.pm; pj = own.pn; }
    if (tid < 32) MISC[tid] = 0u;
    if (tid == 0) __hip_atomic_store(ctl + 8192 + pm * 4 + pj, xb_xcc_id() + 1u, __ATOMIC_RELAXED, __HIP_MEMORY_SCOPE_AGENT);
    __syncthreads();
    XcdBarrier bar = xcd_barrier_post(ctl, MISC + 8, tid);
    const int gw = vcu * NWAVES + wave, NGW = G * NWAVES;
    float* out = a.out; float* ssq = (float*)(ws + WS_SSQ); float* vst = (float*)(ws + WS_VST);
    bf16_t* HB = (bf16_t*)(ws + WS_HB); bf16_t* MB = (bf16_t*)(ws + WS_MB); bf16_t* BIG = (bf16_t*)(ws + WS_BIG);
    bf16_t* MEMN = (bf16_t*)(ws + WS_MEMN); bf16_t* KB = (bf16_t*)(ws + WS_KB); bf16_t* VT = (bf16_t*)(ws + WS_VT);
    unsigned gseq = 0u; int bn = 0; (void)bn;
#ifndef PROBE_BN
#define PROBE_BN 0
#endif
#ifdef PROBE_TIME
    unsigned long long tacc = 0ull, tt0 = 0ull;
#define TBEG(k) do { if (PROBE_TIME == (k)) tt0 = __builtin_amdgcn_s_memrealtime(); } while (0)
#define TEND(k) do { if (PROBE_TIME == (k)) tacc += __builtin_amdgcn_s_memrealtime() - tt0; } while (0)
#else
#define TBEG(k) do {} while (0)
#define TEND(k) do {} while (0)
#endif
#define GRID_BAR() do { ++bn; if (PROBE_BN == 0 || bn == PROBE_BN) TBEG(2); xcd_barrier(bar, TID()); if (PROBE_BN == 0 || bn == PROBE_BN) TEND(2); } while (0)
#define GROUP_BAR() do { ++bn; if (PROBE_BN == 0 || bn == PROBE_BN) TBEG(2); gseq += 4u; group_barrier(ctl + 4096 + 64 * pm, gseq, coxcd, ctl + XB_TMO, TID()); if (PROBE_BN == 0 || bn == PROBE_BN) TEND(2); } while (0)
#define GEMM(EpiT, E, Ap, Bp, M_, N_, K_, cc) do { Gemm g{(const bf16_t*)(Ap), (const bf16_t*)(Bp), (M_), (N_), (K_)}; int cc_ = (cc); asm volatile("" : "+s"(cc_)); StaticOrder S; S.init((M_), (N_), G, cc_); TBEG(1); gemm_phase<EpiT, StaticOrder, true, true>(lds, g, S, (E), TID()); TEND(1); } while (0)
#define GEMMP(EpiT, AL, E, Ap, Bp, N_, K_) do { Gemm g{(const bf16_t*)(Ap), (const bf16_t*)(Bp), T, (N_), (K_)}; int pm_ = pm, pj_ = pj; asm volatile("" : "+s"(pm_), "+s"(pj_)); PanelOrder S{pm_, pj_, (N_) / BM}; TBEG(1); gemm_phase<EpiT, PanelOrder, AL, true>(lds, g, S, (E), TID()); TEND(1); } while (0)

    TBEG(3); p0_weights(a, 0, 1 | 2 | 4 | 8, lds, gw, NGW, wave, lane); p0_weights(a, 1, 4, lds, gw, NGW, wave, lane); p0_prologue(a, lds, gw, NGW, wave, lane, pm * BM + pj * 64); TEND(3);
    if (a.ws == nullptr) cg::this_grid().sync();
    GRID_BAR();
    bool coxcd; { const unsigned x0 = xb_ld(ctl + 8192 + pm * 4), x1 = xb_ld(ctl + 8192 + pm * 4 + 1), x2 = xb_ld(ctl + 8192 + pm * 4 + 2), x3 = xb_ld(ctl + 8192 + pm * 4 + 3);
        coxcd = __builtin_amdgcn_readfirstlane((x0 != 0u && x0 == x1 && x1 == x2 && x2 == x3) ? 1 : 0) != 0; }
    const int kvidx = (pj >= 2 && (pm & 3) == 0) ? (pm >> 2) * 2 + (pj - 2) : (1 << 20);
    const int pbidx = (pj >= 2 && (pm & 3) != 0) ? (pm - (pm >> 2) - 1) * 2 + (pj - 2) : (1 << 20);
    const int spare = pj >= 2 ? pm * 2 + (pj - 2) : (1 << 20);

#pragma unroll
    for (int l = 0; l < 2; ++l) {
        unsigned char* wl = ws + WS_W + (size_t)l * W_LAYER;
        if (l == 0) {
            { rstd_table(lds, ssq, pm, TID()); EpiZ0 E{BIG, (const LAS float*)(lds + TAB_OFF)}; GEMMP(EpiZ0, true, E, HB, wl + W_IN, DZ0, D); }
#pragma unroll 1
            for (int l2 = 0; l2 < 2; ++l2) {
                const int sub = kvidx - 16 * l2; const bf16_t* mn = MEMN + (size_t)l2 * 512 * D; const bf16_t* wkv = (const bf16_t*)(ws + WS_W + (size_t)l2 * W_LAYER + W_KV);
                { EpiScale E{KB + (size_t)l2 * 512 * D, D, nullptr}; GEMM(EpiScale, E, mn, wkv, 512, D, D, (sub >= 0 && sub < 8) ? sub : (1 << 20)); }
                { EpiVt E{VT + (size_t)l2 * 2 * D * NMEM}; GEMM(EpiVt, E, wkv + (size_t)D * D, mn, D, 512, D, (sub >= 8 && sub < 16) ? sub - 8 : (1 << 20)); } }
            if (pbidx < 96) { const int t3 = TID(); p0_weights(a, 1, 1 | 2, lds, pbidx * NWAVES + wave, 96 * NWAVES, wave, t3 & 63); p0_weights(a, 0, 16, lds, pbidx * NWAVES + wave, 96 * NWAVES, wave, t3 & 63); }
            GRID_BAR();
            TBEG(4); conv_phase(lds, BIG, MB, a.in[8], a.in[9], a.in[10], a.in[11], a.in[12], a.in[13], 8 * pm + 2 * pj + 2, 8 * pm + 2 * pj, TID()); TEND(4);
            GRID_BAR();
            { EpiRes E{HB, ssq}; GEMMP(EpiRes, true, E, MB, wl + W_OUT, D, D); }
        } else {
            { rstd_table(lds, ssq, pm, TID()); EpiZ1 E{BIG, (const LAS float*)(lds + TAB_OFF), vst}; GEMMP(EpiZ1, true, E, HB, wl + W_IN, DZ1, D); }
            GROUP_BAR();
            TBEG(5); sgu_phase(lds, BIG, vst, (const bf16_t*)(ws + WS_WSB), a.in[19], a.in[16], a.in[17], MB, 16 * pm + 4 * pj + 4, 16 * pm + 4 * pj, TID()); TEND(5);
            GRID_BAR();
            { EpiRes E{HB, ssq}; GEMMP(EpiRes, true, E, MB, wl + W_OUT, D, D); }
        }
        GROUP_BAR();
        { rstd_table(lds, ssq, pm, TID()); EpiQAttn E{ssq, KB + (size_t)l * 512 * D, VT + (size_t)l * 2 * D * NMEM, MB}; GEMMP(EpiQAttn, false, E, HB, wl + W_Q, D, D); }
        GROUP_BAR();
        { EpiRes E{HB, ssq}; GEMMP(EpiRes, true, E, MB, wl + W_O, D, D); }
        GROUP_BAR();
        { rstd_table(lds, ssq, pm, TID()); EpiGU E{BIG, (const LAS float*)(lds + TAB_OFF)}; GEMMP(EpiGU, true, E, HB, wl + W_GU, NGU, D); }
#ifdef PROBE_G5X2
        { rstd_table(lds, ssq, pm, TID()); EpiGU E{BIG, (const LAS float*)(lds + TAB_OFF)}; GEMMP(EpiGU, true, E, HB, wl + W_GU, NGU, D); }
#endif
        if (l == 0 && spare < 128) { const int t3 = TID(); p0_weights(a, 1, 8 | 16, lds, spare * NWAVES + wave, 128 * NWAVES, wave, t3 & 63); }
        GROUP_BAR();
        if (l == 0) { EpiRes E{HB, ssq}; GEMMP(EpiRes, true, E, BIG, wl + W_DN, D, DFF); }
        else { gseq += 4u; EpiResFinal E{HB, ssq, out, a.in[6], ctl + 4096 + 64 * pm, gseq, coxcd, ctl + XB_TMO}; GEMMP(EpiResFinal, false, E, BIG, wl + W_DN, D, DFF); }
        if (l == 0) GRID_BAR();
    }
#ifdef PROBE_TIME
    __syncthreads();
    if (pm == PROBE_PM && pj == PROBE_PJ && TID() == 0) { asm volatile("s_waitcnt vmcnt(0)" ::: "memory"); const float tus = (float)tacc * 0.01f; out[(size_t)(pm * BM + pj * 64) * D] = floorf(tus * (1.0f / PROBE_Q) + 0.5f) * PROBE_Q * 1.0e4f; }
#endif
}

extern "C" void kernel_launch(void* const* d_in, const int* in_sizes, int n_in, void* d_out, int out_size, void* d_ws, size_t ws_size, hipStream_t stream) {
    static int grid = 0;
    if (grid == 0) {
        if (n_in != 28 || out_size != T * D || ws_size < WS_END) { fprintf(stderr, "kernel_launch: unexpected shapes (n_in %d out %d ws %zu)\n", n_in, out_size, ws_size); grid = -1; return; }
        int dev = 0, cus = 0, per_cu = 0;
        (void)hipGetDevice(&dev); (void)hipDeviceGetAttribute(&cus, hipDeviceAttributeMultiprocessorCount, dev);
        (void)hipFuncSetAttribute((const void*)fwd_kernel, hipFuncAttributeMaxDynamicSharedMemorySize, LDS_BYTES);
        (void)hipOccupancyMaxActiveBlocksPerMultiprocessor(&per_cu, (const void*)fwd_kernel, NTHR, LDS_BYTES);
        if (per_cu < 1) per_cu = 1;
        (void)hipGetLastError();
        grid = cus;
        if (grid != 256) { fprintf(stderr, "kernel_launch: built for a 256-CU device (one workgroup per CU, four per row panel); found %d CUs; nothing launched\n", grid); grid = -1; return; }
    }
    if (grid < 0) return;
    (void)hipMemsetAsync((char*)d_ws + WS_CTL, 0, CTL_ZERO_BYTES, stream);
    Args a{};
    for (int i = 0; i < 28; ++i) a.in[i] = (const float*)d_in[i];
    a.out = (float*)d_out; a.ws = (unsigned char*)d_ws;
    void* args[] = {&a};
    hipError_t e = hipLaunchCooperativeKernel((const void*)fwd_kernel, dim3(grid), dim3(NTHR), args, LDS_BYTES, stream);
    if (e != hipSuccess) fprintf(stderr, "cooperative launch failed: %s (grid %d)\n", hipGetErrorString(e), grid);
}
```

```cpp
#include <hip/hip_runtime.h>
#include <hip/hip_cooperative_groups.h>
#include <cstdio>
#include <cstdint>
namespace cg = cooperative_groups;
namespace pg8 {
#define PG8_LAS __attribute__((address_space(3)))
typedef unsigned short bf16_t;
typedef short bf16x8 __attribute__((ext_vector_type(8)));
typedef float f32x4 __attribute__((ext_vector_type(4)));
typedef unsigned u32x4 __attribute__((ext_vector_type(4)));
constexpr int BM = 256, BK = 64, HALF = 128, HTB = HALF * BK * 2  , STAGE_BYTES = 8 * HTB, NXCD = 8, WGM = 8;

__host__ __device__ __forceinline__ int lds_byte(int r, int c) { const int st = (r >> 4) * 2 + (c >> 5), rr = r & 15, cc = c & 31, ob = rr * 64 + cc * 2; return st * 1024 + (ob ^ (((ob >> 9) & 1) << 5)); }
__host__ __device__ __forceinline__ void stage_rc(int b, int& R, int& C) { const int st = b / 1024, sb = b % 1024, swz = sb ^ (((sb >> 9) & 1) << 5); R = (st >> 1) * 16 + swz / 64; C = (st & 1) * 32 + (swz % 64) / 2; }
__host__ __device__ __forceinline__ int perm32(int rho) { const int n = rho >> 4, i = rho & 15; return 8 * (i >> 2) + 4 * n + (i & 3); }

struct Unit { int pm, pn; };
struct Gemm { const bf16_t* A; const bf16_t* Bt; int M, N, K; };

struct StaticOrder {
    int nM, nN, nwg, G, c;
    __host__ __device__ void init(int M, int N, int G_, int c_) { nM = M / BM; nN = N / BM; nwg = nM * nN; G = G_; c = c_; }
    __host__ __device__ bool next(int i, Unit& u) const {
        const long L = (long)i * G + c; if (L >= nwg) return false;
        int wgid = (int)L; { const int q = nwg / NXCD, r = nwg % NXCD, xcd = wgid % NXCD, off = wgid / NXCD; wgid = (xcd < r ? xcd * (q + 1) : r * (q + 1) + (xcd - r) * q) + off; }
        const int nig = WGM * nN, gid = wgid / nig, fm = gid * WGM, gsz = (nM - fm) < WGM ? (nM - fm) : WGM;
        u.pm = fm + ((wgid % nig) % gsz); u.pn = (wgid % nig) / gsz; return true;
    }
    __device__ __forceinline__ void a_ready(const Unit&) const {}
    __device__ __forceinline__ void done(const Unit&) const {}
};

__device__ __forceinline__ unsigned cvt_pk_bf16(float lo, float hi) { unsigned r; asm volatile("v_cvt_pk_bf16_f32 %0, %1, %2" : "=v"(r) : "v"(lo), "v"(hi)); return r; }
typedef float f32x2 __attribute__((ext_vector_type(2)));
template <class Epi, class Sched, bool ALIGN_EPI = false, bool SP2 = false>
__device__ __forceinline__ void gemm_phase(PG8_LAS unsigned char* lds, const Gemm g, const Sched& S, const Epi& E, int tid_in) {
    int tid_ = tid_in; asm volatile("" : "+v"(tid_));
    const int tid = tid_, wid = __builtin_amdgcn_readfirstlane(tid >> 6), lane = tid & 63, wr = wid >> 2, wc = wid & 3, fr = lane & 15, fq = lane >> 4;
    const int K = g.K, nt = K / BK;
    unsigned voffA[2], voffB[2];
#pragma unroll
    for (int i = 0; i < 2; ++i) { int R, C; stage_rc(tid * 16 + i * 8192, R, C); const int Rb = Epi::PERM ? ((R & ~31) + perm32(R & 31)) : R;
        voffA[i] = (unsigned)(R * K + C) * 2u; voffB[i] = (unsigned)(Rb * K + C) * 2u; }
    const size_t kstep = (size_t)(BK * 2);
    const size_t hstep = (size_t)HALF * K * 2;
    const size_t tstep = 2 * hstep;
    const unsigned ldsw = (unsigned)wid * 1024u;
    const int aoff = lds_byte(wr * 64 + fr, fq * 8), boff = lds_byte(wc * 32 + fr, fq * 8);
#define PG8_SA(b, h) (((b) * 2 + (h)) * HTB)
#define PG8_SB(b, h) ((4 + (b) * 2 + (h)) * HTB)
#define PG8_STAGE(bufoff, gbase, voff) do { _Pragma("unroll") for (int _i = 0; _i < 2; ++_i) \
        __builtin_amdgcn_global_load_lds((const unsigned*)((const char*)(gbase) + (voff)[_i]), (PG8_LAS unsigned*)(lds + (bufoff) + ldsw + _i * 8192), 16, 0, 0); } while (0)
#define PG8_LDA(dst, b, h) do { _Pragma("unroll") for (int m = 0; m < 4; ++m) _Pragma("unroll") for (int k = 0; k < 2; ++k) dst[m][k] = *(const PG8_LAS bf16x8*)(lds + PG8_SA(b, h) + aoff + m * 2048 + k * 1024); } while (0)
#define PG8_LDB(dst, b, h) do { _Pragma("unroll") for (int n = 0; n < 2; ++n) _Pragma("unroll") for (int k = 0; k < 2; ++k) dst[n][k] = *(const PG8_LAS bf16x8*)(lds + PG8_SB(b, h) + boff + n * 2048 + k * 1024); } while (0)
#define PG8_MMA(ai, bj, At, Bt) do { __builtin_amdgcn_s_setprio(1); _Pragma("unroll") for (int m = 0; m < 4; ++m) _Pragma("unroll") for (int n = 0; n < 2; ++n) _Pragma("unroll") for (int k = 0; k < 2; ++k) \
        acc[ai][bj][m][n] = __builtin_amdgcn_mfma_f32_16x16x32_bf16(Bt[n][k], At[m][k], acc[ai][bj][m][n], 0, 0, 0); __builtin_amdgcn_s_setprio(0); } while (0)
#define PG8_WAIT_V(n) asm volatile("s_waitcnt vmcnt(" #n ")" ::: "memory")
#define PG8_WAIT_L(n) asm volatile("s_waitcnt lgkmcnt(" #n ")" ::: "memory")
#define PG8_BAR __builtin_amdgcn_s_barrier()
#define PG8_SCHED __builtin_amdgcn_sched_barrier(0)
    Unit cur, nxt; int ui = 0;
    if (!S.next(0, cur)) return;
    f32x4 acc[2][2][4][2];
#pragma unroll
    for (int a = 0; a < 2; ++a)
#pragma unroll
        for (int b = 0; b < 2; ++b)
#pragma unroll
            for (int m = 0; m < 4; ++m)
#pragma unroll
                for (int n = 0; n < 2; ++n) acc[a][b][m][n] = (f32x4){0.f, 0.f, 0.f, 0.f};
    bf16x8 At[4][2], B0[2][2], B1[2][2];
    const char* cA = (const char*)g.A + (size_t)cur.pm * tstep; const char* cB = (const char*)g.Bt + (size_t)cur.pn * tstep;
    S.a_ready(cur);
    if constexpr (SP2) {
        PG8_STAGE(PG8_SB(0, 0), cB, voffB); PG8_STAGE(PG8_SB(0, 1), cB + hstep, voffB); PG8_STAGE(PG8_SA(0, 0), cA, voffA); PG8_STAGE(PG8_SA(0, 1), cA + hstep, voffA);
        if (wr == 1) PG8_BAR;
        PG8_WAIT_V(2); PG8_BAR;
        PG8_STAGE(PG8_SB(1, 0), cB + kstep, voffB); PG8_STAGE(PG8_SA(1, 0), cA + kstep, voffA); PG8_STAGE(PG8_SB(1, 1), cB + hstep + kstep, voffB);
        PG8_WAIT_V(6); PG8_BAR;
    } else {
        PG8_STAGE(PG8_SB(0, 0), cB, voffB); PG8_STAGE(PG8_SA(0, 0), cA, voffA); PG8_STAGE(PG8_SB(0, 1), cB + hstep, voffB); PG8_STAGE(PG8_SA(0, 1), cA + hstep, voffA);
        if (wr == 1) PG8_BAR;
        PG8_WAIT_V(4); PG8_BAR;
        PG8_STAGE(PG8_SB(1, 0), cB + kstep, voffB); PG8_STAGE(PG8_SA(1, 0), cA + kstep, voffA); PG8_STAGE(PG8_SB(1, 1), cB + hstep + kstep, voffB);
        PG8_WAIT_V(6); PG8_BAR;
    }
    for (;;) {
        const bool has_next = S.next(ui + 1, nxt);
        const char* nA = has_next ? (const char*)g.A + (size_t)nxt.pm * tstep : cA; const char* nB = has_next ? (const char*)g.Bt + (size_t)nxt.pn * tstep : cB;
        for (int t = 0; t < nt; t += 2) {
            const bool last = (t == nt - 2);
            const char* a1 = cA + (size_t)(t + 1) * kstep;
            const char* a2 = last ? nA : cA + (size_t)(t + 2) * kstep; const char* b2 = last ? nB : cB + (size_t)(t + 2) * kstep;
            const char* a3 = a2 + kstep; const char* b3 = b2 + kstep;
            if (last && has_next) S.a_ready(nxt);
            if constexpr (SP2) {
            PG8_LDB(B0, 0, 0); PG8_LDB(B1, 0, 1); PG8_SCHED; PG8_LDA(At, 0, 0); PG8_STAGE(PG8_SA(1, 1), a1 + hstep, voffA);
            PG8_WAIT_V(8); PG8_WAIT_L(0); PG8_BAR; PG8_MMA(0, 0, At, B0); PG8_MMA(0, 1, At, B1); PG8_BAR; PG8_SCHED;
            PG8_LDA(At, 0, 1); PG8_STAGE(PG8_SB(0, 0), b2, voffB); PG8_STAGE(PG8_SB(0, 1), b2 + hstep, voffB); PG8_STAGE(PG8_SA(0, 0), a2, voffA);
            PG8_WAIT_V(8); PG8_WAIT_L(0); PG8_BAR; PG8_MMA(1, 0, At, B0); PG8_MMA(1, 1, At, B1); PG8_BAR; PG8_SCHED;
            PG8_LDB(B0, 1, 0); PG8_LDB(B1, 1, 1); PG8_SCHED; PG8_LDA(At, 1, 0); PG8_STAGE(PG8_SA(0, 1), a2 + hstep, voffA);
            PG8_WAIT_V(8); PG8_WAIT_L(0); PG8_BAR; PG8_MMA(0, 0, At, B0); PG8_MMA(0, 1, At, B1); PG8_BAR; PG8_SCHED;
            PG8_LDA(At, 1, 1); PG8_STAGE(PG8_SB(1, 0), b3, voffB); PG8_STAGE(PG8_SB(1, 1), b3 + hstep, voffB); PG8_STAGE(PG8_SA(1, 0), a3, voffA);
            PG8_WAIT_V(8); PG8_WAIT_L(0); PG8_BAR; PG8_MMA(1, 0, At, B0); PG8_MMA(1, 1, At, B1); PG8_BAR; PG8_SCHED;
            } else {
            PG8_LDB(B0, 0, 0); PG8_SCHED; PG8_LDA(At, 0, 0); PG8_STAGE(PG8_SA(1, 1), a1 + hstep, voffA);
            PG8_WAIT_L(8); PG8_BAR; PG8_WAIT_L(0); PG8_MMA(0, 0, At, B0); PG8_BAR; PG8_SCHED;
            PG8_LDB(B1, 0, 1); PG8_STAGE(PG8_SB(0, 0), b2, voffB);
            PG8_BAR; PG8_WAIT_L(0); PG8_MMA(0, 1, At, B1); PG8_BAR;
            PG8_LDA(At, 0, 1); PG8_STAGE(PG8_SA(0, 0), a2, voffA);
            PG8_BAR; PG8_WAIT_L(0); PG8_MMA(1, 0, At, B0); PG8_BAR; PG8_SCHED;
            PG8_STAGE(PG8_SB(0, 1), b2 + hstep, voffB);
            PG8_WAIT_V(6); PG8_BAR; PG8_MMA(1, 1, At, B1); PG8_BAR;
            PG8_LDB(B0, 1, 0); PG8_SCHED; PG8_LDA(At, 1, 0); PG8_STAGE(PG8_SA(0, 1), a2 + hstep, voffA);
            PG8_WAIT_L(8); PG8_BAR; PG8_WAIT_L(0); PG8_MMA(0, 0, At, B0); PG8_BAR; PG8_SCHED;
            PG8_LDB(B1, 1, 1); PG8_STAGE(PG8_SB(1, 0), b3, voffB);
            PG8_BAR; PG8_WAIT_L(0); PG8_MMA(0, 1, At, B1); PG8_BAR;
            PG8_LDA(At, 1, 1); PG8_STAGE(PG8_SA(1, 0), a3, voffA);
            PG8_BAR; PG8_WAIT_L(0); PG8_MMA(1, 0, At, B0); PG8_BAR; PG8_SCHED;
            PG8_STAGE(PG8_SB(1, 1), b3 + hstep, voffB);
            PG8_WAIT_V(6); PG8_BAR; PG8_MMA(1, 1, At, B1); PG8_BAR;
            }
        }
        if constexpr (ALIGN_EPI) { if (wr == 0) PG8_BAR; }
        if constexpr (!Epi::AFTER_DRAIN) { E(acc, cur, wr, wc, fr, fq); S.done(cur); }
        if (!has_next) break;
#pragma unroll
        for (int a = 0; a < 2; ++a)
#pragma unroll
            for (int b = 0; b < 2; ++b)
#pragma unroll
                for (int m = 0; m < 4; ++m)
#pragma unroll
                    for (int n = 0; n < 2; ++n) acc[a][b][m][n] = (f32x4){0.f, 0.f, 0.f, 0.f};
        cur = nxt; cA = nA; cB = nB; ++ui;
        if constexpr (ALIGN_EPI) { if (wr == 1) PG8_BAR; }
    }
    PG8_WAIT_V(0);
    if constexpr (!ALIGN_EPI) { if (wr == 0) PG8_BAR; }
    PG8_BAR;
    if constexpr (Epi::AFTER_DRAIN) { E.fused(acc, cur, wr, wc, fr, fq, lds, wid, lane); S.done(cur); }
#undef PG8_SA
#undef PG8_SB
#undef PG8_STAGE
#undef PG8_LDA
#undef PG8_LDB
#undef PG8_MMA
#undef PG8_WAIT_V
#undef PG8_WAIT_L
#undef PG8_BAR
#undef PG8_SCHED
}
}
#define LAS __attribute__((address_space(3)))
#define XB_TMO      128
#define XB_XCNT(j)  (256  + 64 * (j))
#define XB_XSUB(j)  (1280 + 64 * (j))
#define XB_XGEN(j)  (2304 + 64 * (j))
#define XB_TOP      3328
#define XB_TOPGEN   3392
#define XCD_BAR_WORDS 3456
#define XB_SPIN_CAP (1u << 18)

__device__ __forceinline__ unsigned xb_ld(unsigned* p)              { return __hip_atomic_load(p, __ATOMIC_RELAXED, __HIP_MEMORY_SCOPE_AGENT); }
__device__ __forceinline__ unsigned xb_add(unsigned* p, unsigned v) { return __hip_atomic_fetch_add(p, v, __ATOMIC_RELAXED, __HIP_MEMORY_SCOPE_AGENT); }
__device__ __forceinline__ unsigned xb_xcc_id() { return (unsigned)__builtin_amdgcn_s_getreg((3 << 11) | 20) & 0xFu; }
#define XB_SPIN(cond, bar) do { unsigned _sp = 0; while (cond) { __builtin_amdgcn_s_sleep(1); \
    if ((++_sp & 255u) == 0u) { if (xb_ld(&(bar)[XB_TMO])) break; if (_sp > XB_SPIN_CAP) { atomicAdd(&(bar)[XB_TMO], 1u); break; } } } } while (0)

struct XcdBarrier {
    unsigned* bar; unsigned x;
    volatile LAS unsigned* st;
};

__device__ __forceinline__ XcdBarrier xcd_barrier_post(unsigned* bar, volatile LAS unsigned* st, int ktid) {
    XcdBarrier b; b.bar = bar; b.x = xb_xcc_id(); b.st = st;
    if (ktid == 0) (void)xb_add(&bar[XB_XCNT(b.x)], 1u);
    return b;
}
__device__ __forceinline__ void xcd_barrier_complete(unsigned* bar, unsigned x, unsigned& nloc, unsigned& nx) {
    const unsigned G = gridDim.x * gridDim.y * gridDim.z;
    unsigned sum, cnt, mine, sp = 0u;
    for (;;) {
        sum = 0u; cnt = 0u; mine = 0u;
#pragma unroll
        for (unsigned j = 0; j < 16; ++j) { const unsigned c = xb_ld(&bar[XB_XCNT(j)]); sum += c; cnt += (c > 0u) ? 1u : 0u; mine = (j == x) ? c : mine; }
        if (sum == G) break;
        __builtin_amdgcn_s_sleep(1);
        if ((++sp & 255u) == 0u) { if (xb_ld(&bar[XB_TMO])) break; if (sp > XB_SPIN_CAP) { atomicAdd(&bar[XB_TMO], 1u); break; } }
    }
    nloc = mine > 0u ? mine : 1u; nx = cnt > 0u ? cnt : 1u;
}

__device__ __forceinline__ void xcd_barrier(const XcdBarrier& b, int ktid) {
    asm volatile("s_waitcnt vmcnt(0)" ::: "memory");
    __syncthreads();
    if (ktid == 0) {
        unsigned* bar = b.bar; const unsigned bx_ = xb_xcc_id();
        __builtin_amdgcn_s_waitcnt(0);
        unsigned nloc = b.st[0], nx = b.st[1];
        if (nloc == 0u) { xcd_barrier_complete(bar, bx_, nloc, nx); b.st[0] = nloc; b.st[1] = nx; }
        const unsigned old = xb_add(&bar[XB_XSUB(bx_)], 1u);
        const unsigned gen = old / nloc;
        if (old + 1u == (gen + 1u) * nloc) {
            __builtin_amdgcn_fence(__ATOMIC_RELEASE, "agent");
            asm volatile("s_waitcnt vmcnt(0)" ::: "memory");
            const unsigned og = xb_add(&bar[XB_TOP], 1u);
            const unsigned tg = og / nx;
            if (og + 1u == (tg + 1u) * nx) xb_add(&bar[XB_TOPGEN], 1u);
            else XB_SPIN(xb_ld(&bar[XB_TOPGEN]) == tg, bar);
            __builtin_amdgcn_fence(__ATOMIC_ACQUIRE, "agent");
            xb_add(&bar[XB_XGEN(bx_)], 1u);
            asm volatile("s_waitcnt vmcnt(0)" ::: "memory");
        } else {
            XB_SPIN(xb_ld(&bar[XB_XGEN(bx_)]) == gen, bar);
            __builtin_amdgcn_fence(__ATOMIC_ACQUIRE, "agent");
            asm volatile("s_waitcnt vmcnt(0)" ::: "memory");
        }
    }
    __syncthreads();
}
#undef LAS
using namespace pg8;
#define LAS __attribute__((address_space(3)))
typedef unsigned u32x2 __attribute__((ext_vector_type(2)));

constexpr int NWAVES = 8, NTHR = 512;
constexpr int SEQ = 8192, NBATCH = 2, T = NBATCH * SEQ, D = 1024, DZ0 = 2560, DZ1 = 2048, DFF = 2816, NGU = 2 * DFF, NMEM = 256;
constexpr float RMS_EPS = 1e-6f, LN_EPS = 1e-5f;
constexpr size_t MiB = 1u << 20;
constexpr size_t WS_CTL = 0, CTL_ZERO_BYTES = 64 * 1024;
constexpr size_t WS_W = 2 * MiB, W_LAYER = 32 * MiB;
constexpr size_t W_IN = 0, W_OUT = 5 * MiB, W_Q = 7 * MiB, W_KV = 9 * MiB, W_O = 13 * MiB, W_GU = 15 * MiB, W_DN = 26 * MiB;
constexpr size_t WS_WSB = 66 * MiB;
constexpr size_t WS_SSQ = 67 * MiB;
constexpr size_t WS_VST = 68 * MiB;
constexpr size_t WS_MEMN = 70 * MiB;
constexpr size_t WS_KB = 72 * MiB;
constexpr size_t WS_VT = 74 * MiB;
constexpr size_t WS_HB = 76 * MiB;
constexpr size_t WS_MB = 108 * MiB;
constexpr size_t WS_BIG = 140 * MiB;
constexpr size_t WS_END = 228 * MiB;
constexpr int LDS_BYTES = 147456, MISC_OFF = 139264, TAB_OFF = 135168;

template <int CTRL> __device__ __forceinline__ float dpp_mov(float v) { return __builtin_bit_cast(float, __builtin_amdgcn_update_dpp(0, __builtin_bit_cast(int, v), CTRL, 0xF, 0xF, true)); }
__device__ __forceinline__ float wave_sum(float v) {
    v += dpp_mov<0xB1>(v);
    v += dpp_mov<0x4E>(v);
    v += dpp_mov<0x141>(v);
    v += dpp_mov<0x140>(v);
    const int vi = __builtin_bit_cast(int, v);
    const float r0 = __builtin_bit_cast(float, __builtin_amdgcn_readlane(vi, 0)), r1 = __builtin_bit_cast(float, __builtin_amdgcn_readlane(vi, 16)),
                r2 = __builtin_bit_cast(float, __builtin_amdgcn_readlane(vi, 32)), r3 = __builtin_bit_cast(float, __builtin_amdgcn_readlane(vi, 48));
    return (r0 + r1) + (r2 + r3);
}
__device__ __forceinline__ float xrow16_sum(float x) {
    auto s = __builtin_amdgcn_permlane16_swap(__float_as_uint(x), __float_as_uint(x), false, false);
    x = __uint_as_float(s[0]) + __uint_as_float(s[1]);
    auto t = __builtin_amdgcn_permlane32_swap(__float_as_uint(x), __float_as_uint(x), false, false);
    return __uint_as_float(t[0]) + __uint_as_float(t[1]);
}
__device__ __forceinline__ float xrow16_max(float x) {
    auto s = __builtin_amdgcn_permlane16_swap(__float_as_uint(x), __float_as_uint(x), false, false);
    x = fmaxf(__uint_as_float(s[0]), __uint_as_float(s[1]));
    auto t = __builtin_amdgcn_permlane32_swap(__float_as_uint(x), __float_as_uint(x), false, false);
    return fmaxf(__uint_as_float(t[0]), __uint_as_float(t[1]));
}
__device__ __forceinline__ float bf2f(unsigned short b) { return __uint_as_float((unsigned)b << 16); }
__device__ __forceinline__ float bflo(unsigned w) { return __uint_as_float(w << 16); }
__device__ __forceinline__ float bfhi(unsigned w) { return __uint_as_float(w & 0xffff0000u); }
__device__ __forceinline__ unsigned short f2bf(float f) { return (unsigned short)(cvt_pk_bf16(f, 0.f) & 0xffffu); }
__device__ __forceinline__ float sigm(float x) { return __builtin_amdgcn_rcpf(1.f + __builtin_amdgcn_exp2f(-1.44269504f * x)); }
typedef float f32x2 __attribute__((ext_vector_type(2)));
__device__ __forceinline__ f32x2 exp2_pk(f32x2 t) { f32x2 e; e.x = __builtin_amdgcn_exp2f(t.x); e.y = __builtin_amdgcn_exp2f(t.y); return e; }
__device__ __forceinline__ f32x2 rcp_pk(f32x2 d) { f32x2 r; r.x = __builtin_amdgcn_rcpf(d.x); r.y = __builtin_amdgcn_rcpf(d.y); return r; }
__device__ __forceinline__ f32x2 swiglu_pk(f32x2 ag, f32x2 au, float c1, float c2) { const f32x2 r = rcp_pk(exp2_pk(ag * c1) + 1.0f); return (ag * au) * r * c2; }
__device__ __forceinline__ f32x2 gelu_tanh_pk(f32x2 x) { const f32x2 x2 = x * x, t = x * (x2 * (-2.3022081986f * 0.044715f) + (-2.3022081986f)); return x * rcp_pk(exp2_pk(t) + 1.0f); }
__device__ __forceinline__ float gelu_tanh(float x) { const float y = 1.5957691216f * (x + 0.044715f * x * x * x); return x * sigm(y); }

__device__ __forceinline__ float row_rstd(const float* ssq, int row, int fq) {
    const f32x4 a = *(const f32x4*)(ssq + (size_t)row * 16 + 4 * fq);
    float s = (a[0] + a[1]) + (a[2] + a[3]);
    s = xrow16_sum(s);
    return rsqrtf(s * (1.0f / 1024.0f) + RMS_EPS);
}
__device__ __forceinline__ void rstd_table(LAS unsigned char* lds, const float* ssq, int pm, int tid) {
    if (tid < 256) { const f32x4* p = (const f32x4*)(ssq + ((size_t)pm * 256 + tid) * 16); const f32x4 a = p[0], b = p[1], c = p[2], d = p[3];
        const float s = (((a[0] + a[1]) + (a[2] + a[3])) + ((b[0] + b[1]) + (b[2] + b[3]))) + (((c[0] + c[1]) + (c[2] + c[3])) + ((d[0] + d[1]) + (d[2] + d[3])));
        ((LAS float*)(lds + TAB_OFF))[tid] = rsqrtf(s * (1.0f / 1024.0f) + RMS_EPS); }
    __syncthreads();
}
__device__ __forceinline__ u32x4 pack8(const f32x4 v0, const f32x4 v1) { u32x4 w; w.x = cvt_pk_bf16(v0[0], v0[1]); w.y = cvt_pk_bf16(v0[2], v0[3]); w.z = cvt_pk_bf16(v1[0], v1[1]); w.w = cvt_pk_bf16(v1[2], v1[3]); return w; }

struct EpiScale {
    static constexpr bool PERM = true, AFTER_DRAIN = false;
    bf16_t* O; int ldc; const float* ssq;
    __device__ __forceinline__ void operator()(const f32x4 (&acc)[2][2][4][2], const Unit& u, int wr, int wc, int fr, int fq) const {
        const int row0 = u.pm * BM + wr * 64 + fr, col0 = u.pn * BM + wc * 32 + 8 * fq;
#pragma unroll
        for (int ai = 0; ai < 2; ++ai)
#pragma unroll
            for (int m = 0; m < 4; ++m) { const int row = row0 + ai * HALF + m * 16; const float rs = ssq ? row_rstd(ssq, row, fq) : 1.f; bf16_t* rowp = O + (size_t)row * ldc + col0;
#pragma unroll
                for (int bj = 0; bj < 2; ++bj) *(u32x4*)(rowp + bj * HALF) = pack8(acc[ai][bj][m][0] * rs, acc[ai][bj][m][1] * rs); }
    }
};
constexpr int DZ3 = 1536;
struct EpiZ0 {
    static constexpr bool PERM = true, AFTER_DRAIN = false;
    bf16_t* O; const LAS float* tab;
    __device__ __forceinline__ void operator()(const f32x4 (&acc)[2][2][4][2], const Unit& u, int wr, int wc, int fr, int fq) const {
        const int row0 = u.pm * BM + wr * 64 + fr, cin = wc * 32 + 8 * fq;
#pragma unroll
        for (int ai = 0; ai < 2; ++ai)
#pragma unroll
            for (int m = 0; m < 4; ++m) { const int row = row0 + ai * HALF + m * 16; const float rs = tab[ai * HALF + wr * 64 + m * 16 + fr]; bf16_t* rowp = O + (size_t)row * DZ3;
                if (u.pn >= 8) {
#pragma unroll
                    for (int bj = 0; bj < 2; ++bj) *(u32x4*)(rowp + 1024 + (u.pn - 8) * BM + bj * HALF + cin) = pack8(acc[ai][bj][m][0] * rs, acc[ai][bj][m][1] * rs);
                } else { f32x4 h[2]; const float c1 = -1.44269504f * rs, c2 = rs * rs;
#pragma unroll
                    for (int n = 0; n < 2; ++n) { const f32x4 ap = acc[ai][0][m][n], aq = acc[ai][1][m][n];
                        const f32x2 pl = (f32x2){ap[0], ap[1]}, ph = (f32x2){ap[2], ap[3]}, ql = (f32x2){aq[0], aq[1]}, qh = (f32x2){aq[2], aq[3]};
                        f32x2 lo, hi;
                        if (u.pn < 4) { lo = (pl * rs) * rcp_pk(exp2_pk(ql * c1) + 1.0f); hi = (ph * rs) * rcp_pk(exp2_pk(qh * c1) + 1.0f); }
                        else { lo = (pl * ql) * c2; hi = (ph * qh) * c2; }
                        h[n] = (f32x4){lo.x, lo.y, hi.x, hi.y}; }
                    *(u32x4*)(rowp + u.pn * HALF + cin) = pack8(h[0], h[1]); } }
    }
};
struct EpiRes {
    static constexpr bool PERM = true, AFTER_DRAIN = false;
    bf16_t* hb; float* ssq;
    __device__ __forceinline__ void operator()(const f32x4 (&acc)[2][2][4][2], const Unit& u, int wr, int wc, int fr, int fq) const {
        const int row0 = u.pm * BM + wr * 64 + fr, col0 = u.pn * BM + wc * 32 + 8 * fq;
#pragma unroll
        for (int ai = 0; ai < 2; ++ai)
#pragma unroll
            for (int m = 0; m < 4; ++m) { const int row = row0 + ai * HALF + m * 16; const size_t off = (size_t)row * D + col0; float q = 0.f; f32x2 q2 = (f32x2){0.f, 0.f};
#pragma unroll
                for (int bj = 0; bj < 2; ++bj) { const u32x4 bb = *(const u32x4*)(hb + off + bj * HALF);
                    const f32x4 b0 = (f32x4){bflo(bb.x), bfhi(bb.x), bflo(bb.y), bfhi(bb.y)}, b1 = (f32x4){bflo(bb.z), bfhi(bb.z), bflo(bb.w), bfhi(bb.w)};
                    const f32x4 v0 = b0 + acc[ai][bj][m][0], v1 = b1 + acc[ai][bj][m][1];
                    *(u32x4*)(hb + off + bj * HALF) = pack8(v0, v1);
                    const f32x2 a0 = (f32x2){v0[0], v0[1]}, a1 = (f32x2){v0[2], v0[3]}, a2 = (f32x2){v1[0], v1[1]}, a3 = (f32x2){v1[2], v1[3]};
                    q2 += a0 * a0; q2 += a1 * a1; q2 += a2 * a2; q2 += a3 * a3; }
                q = xrow16_sum(q2.x + q2.y);
                if (fq == 0) ssq[(size_t)row * 16 + u.pn * 4 + wc] = q; }
    }
};
struct EpiGU {
    static constexpr bool PERM = true, AFTER_DRAIN = false;
    bf16_t* O; const LAS float* tab;
    __device__ __forceinline__ void operator()(const f32x4 (&acc)[2][2][4][2], const Unit& u, int wr, int wc, int fr, int fq) const {
        const int row0 = u.pm * BM + wr * 64 + fr, col0 = u.pn * HALF + wc * 32 + 8 * fq;
#ifdef EPI_GU_REP
        _Pragma("unroll 1") for (int rep = 0; rep < EPI_GU_REP; ++rep) { asm volatile("" ::: "memory");
#else
        {
#endif
#pragma unroll
        for (int ai = 0; ai < 2; ++ai)
#pragma unroll
            for (int m = 0; m < 4; ++m) { const int row = row0 + ai * HALF + m * 16; const float rs = tab[ai * HALF + wr * 64 + m * 16 + fr];
                const float c1 = -1.44269504f * rs, c2 = rs * rs; f32x4 h[2];
#pragma unroll
                for (int n = 0; n < 2; ++n) { const f32x4 ag = acc[ai][0][m][n], au = acc[ai][1][m][n];
                    const f32x2 lo = swiglu_pk((f32x2){ag[0], ag[1]}, (f32x2){au[0], au[1]}, c1, c2), hi = swiglu_pk((f32x2){ag[2], ag[3]}, (f32x2){au[2], au[3]}, c1, c2);
                    h[n] = (f32x4){lo.x, lo.y, hi.x, hi.y}; }
                *(u32x4*)(O + (size_t)row * DFF + col0) = pack8(h[0], h[1]); }
        }
    }
};
struct EpiZ1 {
    static constexpr bool PERM = true, AFTER_DRAIN = false;
    bf16_t* O; const LAS float* tab; float* vst;
    __device__ __forceinline__ void operator()(const f32x4 (&acc)[2][2][4][2], const Unit& u, int wr, int wc, int fr, int fq) const {
        const int row0 = u.pm * BM + wr * 64 + fr, col0 = u.pn * BM + wc * 32 + 8 * fq;
#pragma unroll
        for (int ai = 0; ai < 2; ++ai)
#pragma unroll
            for (int m = 0; m < 4; ++m) { const int row = row0 + ai * HALF + m * 16; const float rs = tab[ai * HALF + wr * 64 + m * 16 + fr]; bf16_t* rowp = O + (size_t)row * DZ1 + col0; float s = 0.f, q = 0.f;
                f32x2 s2 = (f32x2){0.f, 0.f}, q2 = (f32x2){0.f, 0.f};
#pragma unroll
                for (int bj = 0; bj < 2; ++bj) { f32x4 v[2];
#pragma unroll
                    for (int n = 0; n < 2; ++n) { const f32x4 av = acc[ai][bj][m][n];
                        const f32x2 lo = gelu_tanh_pk((f32x2){av[0], av[1]} * rs), hi = gelu_tanh_pk((f32x2){av[2], av[3]} * rs);
                        s2 += lo; s2 += hi; q2 += lo * lo; q2 += hi * hi; v[n] = (f32x4){lo.x, lo.y, hi.x, hi.y}; }
                    *(u32x4*)(rowp + bj * HALF) = pack8(v[0], v[1]); }
                s = s2.x + s2.y; q = q2.x + q2.y;
                if (u.pn >= 4) { s = xrow16_sum(s); q = xrow16_sum(q);
                    if (fq == 0) { float* p = vst + ((size_t)row * 16 + (u.pn - 4) * 4 + wc) * 2; p[0] = s; p[1] = q; } } }
    }
};
struct EpiVt {
    static constexpr bool PERM = true, AFTER_DRAIN = false;
    bf16_t* Vt;
    __device__ __forceinline__ void operator()(const f32x4 (&acc)[2][2][4][2], const Unit& u, int wr, int wc, int fr, int fq) const {
        const int row0 = u.pm * BM + wr * 64 + fr, col0 = wc * 32 + 8 * fq;
#pragma unroll
        for (int ai = 0; ai < 2; ++ai)
#pragma unroll
            for (int m = 0; m < 4; ++m) { bf16_t* rowp = Vt + ((size_t)u.pn * D + row0 + ai * HALF + m * 16) * NMEM + col0;
#pragma unroll
                for (int bj = 0; bj < 2; ++bj) *(u32x4*)(rowp + bj * HALF) = pack8(acc[ai][bj][m][0], acc[ai][bj][m][1]); }
    }
};

__device__ __forceinline__ void tr_item(const float* W, int K, int N, bf16_t* WT, const float* g, float cs, int mode, LAS float* scr, int item, int lane) {
    const int nblk = N / 64, kb = item / nblk, nb = item % nblk, k0 = 64 * kb, n0 = 64 * nb;
    int orow;
    if (mode == 3) {
        const int sec = n0 >> 9, np = n0 & 511, il = (np >> 7) * 256 + (np & 127);
        orow = sec == 0 ? il : sec == 1 ? il + 128 : sec == 2 ? 1024 + il : sec == 3 ? 2048 + np : 1024 + il + 128;
    } else orow = mode == 0 ? n0 : ((n0 >> 7) * 256 + (n0 & 127) + (mode == 2 ? 128 : 0));
    const int kq = lane >> 4, n4 = (lane & 15) * 4;
    f32x4 v[16]; float sc[16];
#pragma unroll
    for (int i = 0; i < 16; ++i) { const int kk = 4 * i + kq; v[i] = *(const f32x4*)(W + (size_t)(k0 + kk) * N + n0 + n4); sc[i] = g ? g[k0 + kk] * cs : cs; }
    __builtin_amdgcn_sched_barrier(0);
#pragma unroll
    for (int i = 0; i < 16; ++i) { const int kk = 4 * i + kq; LAS float* d = scr + kk * 65 + n4; d[0] = v[i][0] * sc[i]; d[1] = v[i][1] * sc[i]; d[2] = v[i][2] * sc[i]; d[3] = v[i][3] * sc[i]; }
    asm volatile("s_waitcnt lgkmcnt(0)" ::: "memory");
    const int c = lane & 7;
#pragma unroll
    for (int j = 0; j < 8; ++j) { const int n = (lane >> 3) + 8 * j; const LAS float* p = scr + (8 * c) * 65 + n;
        u32x4 o; o.x = cvt_pk_bf16(p[0 * 65], p[1 * 65]); o.y = cvt_pk_bf16(p[2 * 65], p[3 * 65]); o.z = cvt_pk_bf16(p[4 * 65], p[5 * 65]); o.w = cvt_pk_bf16(p[6 * 65], p[7 * 65]);
        *(u32x4*)(WT + (size_t)(orow + n) * K + k0 + 8 * c) = o; }
    asm volatile("s_waitcnt lgkmcnt(0)" ::: "memory");
}

struct Args { const float* in[28]; float* out; unsigned char* ws; };

__device__ __forceinline__ void p0_weights(const Args& a, int l, int part, LAS unsigned char* lds, int gw, int NGW, int wave, int lane) {
    unsigned char* ws = a.ws;
    LAS float* scr = (LAS float*)(lds + wave * 16640);
    const float QS = 0.0625f * 1.44269504f;
    const int NIN = l ? DZ1 : DZ0, I_IN = 16 * (NIN / 64);
    constexpr int I_SQ = 16 * 16, I_GU = 16 * (DFF / 64), I_DN = (DFF / 64) * 16;
    const int I_A = (part & 1) ? I_IN : 0, I_S = (part & 2) ? I_SQ : 0, I_KV = (part & 4) ? I_SQ : 0, I_G = (part & 8) ? I_GU : 0, I_D = (part & 16) ? I_DN : 0;
    const int NITEMS = I_A + 3 * I_S + 2 * I_KV + 2 * I_G + I_D;
    unsigned char* wl = ws + WS_W + (size_t)l * W_LAYER;
    for (int it = gw; it < NITEMS; it += NGW) {
        int r = it; bool found = false; const float* W = nullptr; int K = 0, N = 0, mode = 0; bf16_t* WT = nullptr; const float* gv = nullptr; float cs = 1.f;
#define SEL(NI, Wp, K_, N_, WTp, g_, cs_, mode_) if (!found) { if (r < (NI)) { W = (Wp); K = (K_); N = (N_); WT = (bf16_t*)(WTp); gv = (g_); cs = (cs_); mode = (mode_); found = true; } else r -= (NI); }
        SEL(I_A, l ? a.in[15] : a.in[7], D, NIN, wl + W_IN, a.in[2] + l * D, 1.f, l ? 0 : 3)
        SEL(I_S, l ? a.in[20] : a.in[14], D, D, wl + W_OUT, nullptr, 1.f, 0)
        SEL(I_S, a.in[21] + (size_t)l * D * D, D, D, wl + W_Q, a.in[3] + l * D, QS, 0)
        SEL(I_KV, a.in[22] + (size_t)l * D * D, D, D, wl + W_KV, nullptr, 1.f, 0)
        SEL(I_KV, a.in[23] + (size_t)l * D * D, D, D, wl + W_KV + (size_t)D * D * 2, nullptr, 1.f, 0)
        SEL(I_S, a.in[24] + (size_t)l * D * D, D, D, wl + W_O, nullptr, 1.f, 0)
        SEL(I_G, a.in[25] + (size_t)l * D * DFF, D, DFF, wl + W_GU, a.in[5] + l * D, 1.f, 1)
        SEL(I_G, a.in[26] + (size_t)l * D * DFF, D, DFF, wl + W_GU, a.in[5] + l * D, 1.f, 2)
        SEL(I_D, a.in[27] + (size_t)l * D * DFF, DFF, D, wl + W_DN, nullptr, 1.f, 0)
#undef SEL
        tr_item(W, K, N, WT, gv, cs, mode, scr, r, lane);
    }
}
__device__ __forceinline__ void p0_prologue(const Args& a, LAS unsigned char* lds, int gw, int NGW, int wave, int lane, int xrow0) {
    unsigned char* ws = a.ws;
    { const f32x4* src = (const f32x4*)a.in[18]; u32x2* dst = (u32x2*)(ws + WS_WSB);
      for (int i = gw * 64 + lane; i < 8 * 128 * 128 / 4; i += NGW * 64) { const f32x4 v = src[i]; u32x2 o; o.x = cvt_pk_bf16(v[0], v[1]); o.y = cvt_pk_bf16(v[2], v[3]); dst[i] = o; } }
    { float* ssq = (float*)(ws + WS_SSQ); bf16_t* HB = (bf16_t*)(ws + WS_HB);
      _Pragma("unroll 1") for (int it = 0; it < 2; ++it) { const int m0 = xrow0 + wave * 8 + it * 4;
          f32x4 v[4][4];
#pragma unroll
          for (int r = 0; r < 4; ++r) { const f32x4* xr = (const f32x4*)(a.in[0] + (size_t)(m0 + r) * D) + lane;
#pragma unroll
              for (int j = 0; j < 4; ++j) v[r][j] = xr[64 * j]; }
          __builtin_amdgcn_sched_barrier(0);
#pragma unroll
          for (int r = 0; r < 4; ++r) { float s = 0.f;
#pragma unroll
              for (int j = 0; j < 4; ++j) s += (v[r][j][0] * v[r][j][0] + v[r][j][1] * v[r][j][1]) + (v[r][j][2] * v[r][j][2] + v[r][j][3] * v[r][j][3]);
              s = wave_sum(s);
              u32x2* o = (u32x2*)(HB + (size_t)(m0 + r) * D) + lane;
#pragma unroll
              for (int j = 0; j < 4; ++j) { u32x2 w; w.x = cvt_pk_bf16(v[r][j][0], v[r][j][1]); w.y = cvt_pk_bf16(v[r][j][2], v[r][j][3]); o[64 * j] = w; }
              if (lane < 16) ssq[(size_t)(m0 + r) * 16 + lane] = lane == 0 ? s : 0.f; }
      } }
    { bf16_t* MN = (bf16_t*)(ws + WS_MEMN);
      for (int m = gw; m < 2 * 512; m += NGW) { const int l = m >> 9, row = m & 511;
          const f32x4* xr = (const f32x4*)(a.in[1] + (size_t)row * D) + lane; const f32x4* gr = (const f32x4*)(a.in[4] + l * D) + lane; f32x4 v[4]; float s = 0.f;
#pragma unroll
          for (int j = 0; j < 4; ++j) { v[j] = xr[64 * j]; s += (v[j][0] * v[j][0] + v[j][1] * v[j][1]) + (v[j][2] * v[j][2] + v[j][3] * v[j][3]); }
          const float rs = rsqrtf(wave_sum(s) * (1.0f / 1024.0f) + RMS_EPS);
          u32x2* o = (u32x2*)(MN + ((size_t)l * 512 + row) * D) + lane;
#pragma unroll
          for (int j = 0; j < 4; ++j) { const f32x4 g = gr[64 * j]; u32x2 w; w.x = cvt_pk_bf16(v[j][0] * rs * g[0], v[j][1] * rs * g[1]); w.y = cvt_pk_bf16(v[j][2] * rs * g[2], v[j][3] * rs * g[3]); o[64 * j] = w; }
      } }
}

__device__ __forceinline__ void unpack8(const u32x4 r, float (&v)[8]) { v[0] = bflo(r.x); v[1] = bfhi(r.x); v[2] = bflo(r.y); v[3] = bfhi(r.y); v[4] = bflo(r.z); v[5] = bfhi(r.z); v[6] = bflo(r.w); v[7] = bfhi(r.w); }
__device__ __forceinline__ void conv_phase(LAS unsigned char* lds, const bf16_t* Z, bf16_t* Mo, const float* cw, const float* cb, const float* lg, const float* lb,
                                           const float* bw, const float* bb, int G, int c, int tid_in) {
    constexpr int TT = 32, RR = TT + 30;
    int tid_ = tid_in; asm volatile("" : "+v"(tid_)); asm volatile("" : "+s"(c), "+s"(G));
    const int tid = tid_, lane = tid & 63, wid = tid >> 6;
    LAS float* as = (LAS float*)lds;
    LAS float* os = (LAS float*)lds;
    for (int u = c; u < G; ++u) {
        const int t0 = u * TT, b = t0 / SEQ, s0 = t0 % SEQ;
        const bf16_t* zb = Z + (size_t)b * SEQ * DZ3;
        __syncthreads();
        { u32x4 rv[8];
#pragma unroll
          for (int i = 0; i < 8; ++i) { const int idx = tid + 512 * i, r = idx >> 6, cc = idx & 63, sq = s0 - 15 + r; const bool ok = (idx < RR * 64) && (sq >= 0) && (sq < SEQ);
              rv[i] = *(const u32x4*)(zb + (size_t)(ok ? sq : s0) * DZ3 + cc * 8);
              if (!ok) rv[i] = (u32x4){0u, 0u, 0u, 0u}; }
          __builtin_amdgcn_sched_barrier(0);
#pragma unroll
          for (int i = 0; i < 8; ++i) { const int idx = tid + 512 * i, r = idx >> 6, cc = idx & 63; float v[8]; unpack8(rv[i], v);
              if (idx < RR * 64) { *(LAS f32x4*)(as + r * 512 + cc * 8) = (f32x4){v[0], v[1], v[2], v[3]}; *(LAS f32x4*)(as + r * 512 + cc * 8 + 4) = (f32x4){v[4], v[5], v[6], v[7]}; } } }
        __syncthreads();
        float o[TT];
        {
          const float* cw_ = cw; const float* cb_ = cb; asm volatile("" : "+s"(cw_), "+s"(cb_));
          f32x2 w2[16];
#pragma unroll
          for (int j = 0; j < 16; ++j) { w2[j].x = cw_[(2 * j) * 512 + tid]; w2[j].y = (2 * j + 1 < 31) ? cw_[(2 * j + 1) * 512 + tid] : 0.f; }
          const float cbias = cb_[tid];
          f32x2 aE[31], aO[31];
#pragma unroll
          for (int i = 0; i < 31; ++i) { aE[i].x = as[(2 * i) * 512 + tid]; aE[i].y = as[(2 * i + 1) * 512 + tid]; }
#pragma unroll
          for (int i = 0; i < 31; ++i) { aO[i].x = aE[i].y; aO[i].y = (i < 30) ? aE[i + 1].x : 0.f; }
#pragma unroll
          for (int i = 0; i < TT / 2; ++i) { f32x2 pe = (f32x2){0.f, 0.f}, po = (f32x2){0.f, 0.f};
#pragma unroll
              for (int j = 0; j < 16; ++j) { pe += w2[j] * aE[i + j]; po += w2[j] * aO[i + j]; }
              o[2 * i] = cbias + (pe.x + pe.y); o[2 * i + 1] = cbias + (po.x + po.y); } }
        __syncthreads();
#pragma unroll
        for (int t = 0; t < TT; ++t) os[t * 512 + tid] = o[t];
        __syncthreads();
        { const float* lg_ = lg; const float* lb_ = lb; asm volatile("" : "+s"(lg_), "+s"(lb_));
          const f32x4 g0 = *(const f32x4*)(lg_ + 8 * lane), g1 = *(const f32x4*)(lg_ + 8 * lane + 4), b0 = *(const f32x4*)(lb_ + 8 * lane), b1 = *(const f32x4*)(lb_ + 8 * lane + 4);
#pragma unroll
          for (int i = 0; i < TT / 8; ++i) { const int t = (TT / 8) * wid + i;
              const f32x4 v0 = *(const LAS f32x4*)(os + t * 512 + 8 * lane), v1 = *(const LAS f32x4*)(os + t * 512 + 8 * lane + 4);
              const float mean = wave_sum(((v0[0] + v0[1]) + (v0[2] + v0[3])) + ((v1[0] + v1[1]) + (v1[2] + v1[3]))) * (1.0f / 512.0f);
              const f32x4 d0 = v0 - mean, d1 = v1 - mean;
              const float var = wave_sum(((d0[0] * d0[0] + d0[1] * d0[1]) + (d0[2] * d0[2] + d0[3] * d0[3])) + ((d1[0] * d1[0] + d1[1] * d1[1]) + (d1[2] * d1[2] + d1[3] * d1[3]))) * (1.0f / 512.0f);
              const float rstd = rsqrtf(var + LN_EPS);
              f32x4 y0 = d0 * rstd * g0 + b0, y1 = d1 * rstd * g1 + b1;
#pragma unroll
              for (int j = 0; j < 4; ++j) { y0[j] = y0[j] * sigm(y0[j]); y1[j] = y1[j] * sigm(y1[j]); }
              *(u32x4*)(Mo + (size_t)(t0 + t) * D + 8 * lane) = pack8(y0, y1); } }
        { const int cc = tid & 63, rgp = tid >> 6, sb = s0 + 4 * rgp;
          u32x4 xx[6], gb[4];
#pragma unroll
          for (int r = 0; r < 6; ++r) { const int sq = sb - 1 + r; const bool ok = (sq >= 0) && (sq < SEQ); const bf16_t* p = zb + (size_t)(ok ? sq : s0) * DZ3 + cc * 8;
              xx[r] = *(const u32x4*)(p + 512); if (!ok) xx[r] = (u32x4){0u, 0u, 0u, 0u};
              if (r >= 1 && r <= 4) gb[r - 1] = *(const u32x4*)(p + 1024); }
          const float* bw_ = bw; const float* bb_ = bb; asm volatile("" : "+s"(bw_), "+s"(bb_));
          const f32x4 w0a = *(const f32x4*)(bw_ + cc * 8), w0b = *(const f32x4*)(bw_ + cc * 8 + 4), w1a = *(const f32x4*)(bw_ + 512 + cc * 8), w1b = *(const f32x4*)(bw_ + 512 + cc * 8 + 4),
                      w2a = *(const f32x4*)(bw_ + 1024 + cc * 8), w2b = *(const f32x4*)(bw_ + 1024 + cc * 8 + 4), bba = *(const f32x4*)(bb_ + cc * 8), bbb = *(const f32x4*)(bb_ + cc * 8 + 4);
          __builtin_amdgcn_sched_barrier(0);
          float x[6][8];
#pragma unroll
          for (int r = 0; r < 6; ++r) unpack8(xx[r], x[r]);
#pragma unroll
          for (int t = 0; t < 4; ++t) { float gbv[8]; unpack8(gb[t], gbv); f32x4 y0, y1;
#pragma unroll
              for (int j = 0; j < 4; ++j) { y0[j] = gbv[j] * (w0a[j] * x[t][j] + w1a[j] * x[t + 1][j] + w2a[j] * x[t + 2][j] + bba[j]);
                  y1[j] = gbv[4 + j] * (w0b[j] * x[t][4 + j] + w1b[j] * x[t + 1][4 + j] + w2b[j] * x[t + 2][4 + j] + bbb[j]); }
              *(u32x4*)(Mo + (size_t)(t0 + 4 * rgp + t) * D + 512 + cc * 8) = pack8(y0, y1); } }
    }
}

__device__ __forceinline__ void sgu_phase(LAS unsigned char* lds, const bf16_t* Z1, const float* vst, const bf16_t* Wsb, const float* bs, const float* lg, const float* lb, bf16_t* Y, int G, int c, int tid_in) {
    constexpr int RS = 272;
    int tid_ = tid_in; asm volatile("" : "+v"(tid_)); asm volatile("" : "+s"(c), "+s"(G));
    const int tid = tid_, lane = tid & 63, wid = tid >> 6, fr = lane & 15, fq = lane >> 4;
    LAS unsigned char* Wl = lds; LAS unsigned char* Vl = lds + 128 * RS;
    for (int u = c; u < G; ++u) {
        const int n = u >> 3, g = u & 7, t0 = n * 128, cg0 = g * 128;
        const int q = tid & 127, qc = tid >> 7;
        u32x4 wt[4], vr[4]; f32x4 sp[8];
#pragma unroll
        for (int i = 0; i < 4; ++i) { const int idx = tid + 512 * i, p = idx >> 4, chn = idx & 15; wt[i] = *(const u32x4*)(Wsb + ((size_t)g * 128 + p) * 128 + chn * 8); }
#pragma unroll
        for (int i = 0; i < 4; ++i) vr[i] = *(const u32x4*)(Z1 + (size_t)(t0 + q) * DZ1 + 1024 + cg0 + qc * 32 + i * 8);
#pragma unroll
        for (int j = 0; j < 8; ++j) sp[j] = *(const f32x4*)(vst + (size_t)(t0 + q) * 32 + 4 * j);
        const int pr = 16 * wid + fr, row = t0 + pr;
        u32x2 uu[8];
#pragma unroll
        for (int cb = 0; cb < 8; ++cb) uu[cb] = *(const u32x2*)(Z1 + (size_t)row * DZ1 + cg0 + 16 * cb + 4 * fq);
        const float bias = bs[g * 128 + pr];
        __builtin_amdgcn_sched_barrier(0);
        __syncthreads();
#pragma unroll
        for (int i = 0; i < 4; ++i) { const int idx = tid + 512 * i, p = idx >> 4, chn = idx & 15; *(LAS u32x4*)(Wl + p * RS + chn * 16) = wt[i]; }
        { float s1 = 0.f, s2 = 0.f;
#pragma unroll
          for (int j = 0; j < 8; ++j) { s1 += sp[j][0] + sp[j][2]; s2 += sp[j][1] + sp[j][3]; }
          const float mean = s1 * (1.0f / 1024.0f), var = s2 * (1.0f / 1024.0f) - mean * mean, rstd = rsqrtf(var + LN_EPS);
#pragma unroll
          for (int i = 0; i < 4; ++i) { const int c0 = qc * 32 + i * 8; float v[8]; unpack8(vr[i], v);
              const f32x4 g0 = *(const f32x4*)(lg + cg0 + c0), g1 = *(const f32x4*)(lg + cg0 + c0 + 4), b0 = *(const f32x4*)(lb + cg0 + c0), b1 = *(const f32x4*)(lb + cg0 + c0 + 4);
#pragma unroll
              for (int j = 0; j < 8; ++j) { const float gg = j < 4 ? g0[j & 3] : g1[j & 3], bbv = j < 4 ? b0[j & 3] : b1[j & 3];
                  *(LAS bf16_t*)(Vl + (c0 + j) * RS + q * 2) = f2bf((v[j] - mean) * rstd * gg + bbv); } } }
        __syncthreads();
        bf16x8 wf[4];
#pragma unroll
        for (int ks = 0; ks < 4; ++ks) wf[ks] = *(const LAS bf16x8*)(Wl + (16 * wid + fr) * RS + (32 * ks + 8 * fq) * 2);
        f32x4 acc[8];
#pragma unroll
        for (int cb = 0; cb < 8; ++cb) { acc[cb] = (f32x4){0.f, 0.f, 0.f, 0.f};
#pragma unroll
            for (int ks = 0; ks < 4; ++ks) { const bf16x8 vf = *(const LAS bf16x8*)(Vl + (16 * cb + fr) * RS + (32 * ks + 8 * fq) * 2);
                acc[cb] = __builtin_amdgcn_mfma_f32_16x16x32_bf16(vf, wf[ks], acc[cb], 0, 0, 0); } }
#pragma unroll
        for (int cb = 0; cb < 8; ++cb) { const int cc = cg0 + 16 * cb + 4 * fq;
            u32x2 o; o.x = cvt_pk_bf16(bflo(uu[cb].x) * (acc[cb][0] + bias), bfhi(uu[cb].x) * (acc[cb][1] + bias)); o.y = cvt_pk_bf16(bflo(uu[cb].y) * (acc[cb][2] + bias), bfhi(uu[cb].y) * (acc[cb][3] + bias));
            *(u32x2*)(Y + (size_t)row * D + cc) = o; }
    }
}

__device__ __forceinline__ void attn_phase(LAS unsigned char* lds, const bf16_t* Q, const bf16_t* Kb, const bf16_t* Vt, bf16_t* O, int G, int c, int tid_in) {
    constexpr int RS = 528;
    int tid_ = tid_in; asm volatile("" : "+v"(tid_)); asm volatile("" : "+s"(c), "+s"(G));
    const int tid = tid_, lane = tid & 63, wid = tid >> 6, fr = lane & 15, fq = lane >> 4;
    for (int u = c; u < 512; u += G) {
        const int qb = u >> 2, h = u & 3, b = qb >> 6, q0 = qb * 128;
        const bf16_t* qrow = Q + (size_t)(q0 + 16 * wid + fr) * D + h * 256 + 8 * fq;
        bf16x8 qf[8];
#pragma unroll
        for (int ks = 0; ks < 8; ++ks) qf[ks] = *(const bf16x8*)(qrow + 32 * ks);
        __syncthreads();
        { u32x4 tv[16];
#pragma unroll
          for (int i = 0; i < 16; ++i) { const int idx = tid + 512 * i, key = idx >> 5, ch = idx & 31; tv[i] = *(const u32x4*)(Kb + (size_t)(b * 256 + key) * D + h * 256 + ch * 8); }
          __builtin_amdgcn_sched_barrier(0);
#pragma unroll
          for (int i = 0; i < 16; ++i) { const int idx = tid + 512 * i, key = idx >> 5, ch = idx & 31; *(LAS u32x4*)(lds + key * RS + ch * 16) = tv[i]; } }
        __syncthreads();
        f32x4 S[16];
#pragma unroll
        for (int kb = 0; kb < 16; ++kb) { S[kb] = (f32x4){0.f, 0.f, 0.f, 0.f};
#pragma unroll
            for (int ks = 0; ks < 8; ++ks) { const bf16x8 kf = *(const LAS bf16x8*)(lds + (16 * kb + fr) * RS + (32 * ks + 8 * fq) * 2);
                S[kb] = __builtin_amdgcn_mfma_f32_16x16x32_bf16(kf, qf[ks], S[kb], 0, 0, 0); } }
        float mx = -3.0e38f;
#pragma unroll
        for (int kb = 0; kb < 16; ++kb) mx = fmaxf(mx, fmaxf(fmaxf(S[kb][0], S[kb][1]), fmaxf(S[kb][2], S[kb][3])));
        mx = xrow16_max(mx);
        float l = 0.f;
#pragma unroll
        for (int kb = 0; kb < 16; ++kb)
#pragma unroll
            for (int j = 0; j < 4; ++j) { const float p = __builtin_amdgcn_exp2f(S[kb][j] - mx); S[kb][j] = p; l += p; }
        l = xrow16_sum(l);
        bf16x8 pf[8];
#pragma unroll
        for (int cc = 0; cc < 8; ++cc) { const u32x4 w = pack8(S[2 * cc], S[2 * cc + 1]); pf[cc] = __builtin_bit_cast(bf16x8, w); }
        __syncthreads();
        { u32x4 tv[16];
#pragma unroll
          for (int i = 0; i < 16; ++i) { const int idx = tid + 512 * i, d = idx >> 5, ch = idx & 31; tv[i] = *(const u32x4*)(Vt + ((size_t)b * D + h * 256 + d) * NMEM + ch * 8); }
          __builtin_amdgcn_sched_barrier(0);
#pragma unroll
          for (int i = 0; i < 16; ++i) { const int idx = tid + 512 * i, d = idx >> 5, ch = idx & 31; *(LAS u32x4*)(lds + d * RS + ch * 16) = tv[i]; } }
        __syncthreads();
        const float inv = 1.0f / l;
        bf16_t* orow = O + (size_t)(q0 + 16 * wid + fr) * D + h * 256 + 4 * fq;
#pragma unroll
        for (int db = 0; db < 16; ++db) { f32x4 oa = (f32x4){0.f, 0.f, 0.f, 0.f};
#pragma unroll
            for (int cc = 0; cc < 8; ++cc) { const bf16x8 vf = *(const LAS bf16x8*)(lds + (16 * db + fr) * RS + (32 * cc + 8 * fq) * 2);
                oa = __builtin_amdgcn_mfma_f32_16x16x32_bf16(vf, pf[cc], oa, 0, 0, 0); }
            u32x2 o; o.x = cvt_pk_bf16(oa[0] * inv, oa[1] * inv); o.y = cvt_pk_bf16(oa[2] * inv, oa[3] * inv);
            *(u32x2*)(orow + 16 * db) = o; }
    }
}

struct EpiQAttn {
    static constexpr bool PERM = true, AFTER_DRAIN = true;
    const float* ssq; const bf16_t* Kb; const bf16_t* Vt; bf16_t* O;
    __device__ __forceinline__ void operator()(const f32x4 (&)[2][2][4][2], const Unit&, int, int, int, int) const {}
    __device__ __forceinline__ void fused(f32x4 (&acc)[2][2][4][2], const Unit& u, int wr, int wc, int fr, int fq, PG8_LAS unsigned char* lds, int wid, int lane) const {
        constexpr int RS = 528;
        const int tid = wid * 64 + lane, h = u.pn, b = u.pm >> 5;
        const unsigned r0 = (unsigned)tid >> 5, ch = (unsigned)tid & 31u;
        const bf16_t* kbase = Kb + (size_t)(b * 256) * D + h * 256; const bf16_t* vbase = Vt + ((size_t)b * D + h * 256) * NMEM;
        const unsigned goffk = r0 * (unsigned)(D * 2) + ch * 16u, goffv = r0 * (unsigned)(NMEM * 2) + ch * 16u, loff = r0 * (unsigned)RS + ch * 16u;
        unsigned loffa = loff, loffb = loff + 7 * 16 * RS; asm volatile("" : "+v"(loffa), "+v"(loffb));
#pragma unroll
        for (int ai = 0; ai < 2; ++ai)
#pragma unroll
            for (int m = 0; m < 4; ++m) { const int lr = ai * HALF + wr * 64 + m * 16 + fr; const float rs = ((const PG8_LAS float*)(lds + TAB_OFF))[lr];
#pragma unroll
                for (int bj = 0; bj < 2; ++bj) *(PG8_LAS u32x4*)(lds + lr * RS + (bj * HALF + wc * 32 + 8 * fq) * 2) = pack8(acc[ai][bj][m][0] * rs, acc[ai][bj][m][1] * rs); }
        __syncthreads();
        bf16x8 qf[2][8];
#pragma unroll
        for (int qb = 0; qb < 2; ++qb)
#pragma unroll
            for (int ks = 0; ks < 8; ++ks) qf[qb][ks] = *(const PG8_LAS bf16x8*)(lds + (32 * wid + 16 * qb + fr) * RS + (32 * ks + 8 * fq) * 2);
        __builtin_amdgcn_sched_barrier(0);
        u32x4 tv[16];
#pragma unroll
        for (int i = 0; i < 16; ++i) tv[i] = *(const u32x4*)((const char*)kbase + (goffk + (unsigned)(i * 16 * D * 2)));
        __builtin_amdgcn_sched_barrier(0);
        __syncthreads();
#pragma unroll
        for (int i = 0; i < 16; ++i) *(PG8_LAS u32x4*)(lds + (i < 7 ? loffa : loffb) + (i < 7 ? i : i - 7) * 16 * RS) = tv[i];
        __syncthreads();
        unsigned fb0 = (unsigned)(fr * RS + fq * 16), fb1 = fb0 + 8 * 16 * RS; asm volatile("" : "+v"(fb0), "+v"(fb1));
        f32x4 S[2][16];
#pragma unroll
        for (int kb = 0; kb < 16; ++kb) { S[0][kb] = (f32x4){0.f, 0.f, 0.f, 0.f}; S[1][kb] = (f32x4){0.f, 0.f, 0.f, 0.f};
#pragma unroll
            for (int ks = 0; ks < 8; ++ks) { const bf16x8 kf = *(const PG8_LAS bf16x8*)(lds + (kb < 8 ? fb0 : fb1) + ((kb & 7) * 16 * RS + ks * 64));
                S[0][kb] = __builtin_amdgcn_mfma_f32_16x16x32_bf16(kf, qf[0][ks], S[0][kb], 0, 0, 0);
                S[1][kb] = __builtin_amdgcn_mfma_f32_16x16x32_bf16(kf, qf[1][ks], S[1][kb], 0, 0, 0); } }
        __builtin_amdgcn_sched_barrier(0);
        bf16x8 pf[2][8]; float inv[2];
#pragma unroll
        for (int qb = 0; qb < 2; ++qb) {
            float mx = -3.0e38f;
#pragma unroll
            for (int kb = 0; kb < 16; ++kb) mx = fmaxf(mx, fmaxf(fmaxf(S[qb][kb][0], S[qb][kb][1]), fmaxf(S[qb][kb][2], S[qb][kb][3])));
            mx = xrow16_max(mx);
            float l = 0.f;
#pragma unroll
            for (int kb = 0; kb < 16; ++kb)
#pragma unroll
                for (int j = 0; j < 4; ++j) { const float p = __builtin_amdgcn_exp2f(S[qb][kb][j] - mx); S[qb][kb][j] = p; l += p; }
            l = xrow16_sum(l); inv[qb] = 1.0f / l;
#pragma unroll
            for (int cc = 0; cc < 8; ++cc) { const u32x4 w = pack8(S[qb][2 * cc], S[qb][2 * cc + 1]); pf[qb][cc] = __builtin_bit_cast(bf16x8, w); }
        }
        __builtin_amdgcn_sched_barrier(0);
        unsigned loff2a = r0 * (unsigned)RS + ((ch >> 2) * 32u + 16u * (ch & 1u) + 4u * ((ch >> 1) & 1u)) * 2u, loff2b = loff2a + 7 * 16 * RS; asm volatile("" : "+v"(loff2a), "+v"(loff2b));
#pragma unroll
        for (int i = 0; i < 16; ++i) tv[i] = *(const u32x4*)((const char*)vbase + (goffv + (unsigned)(i * 16 * NMEM * 2)));
        __builtin_amdgcn_sched_barrier(0);
        __syncthreads();
#pragma unroll
        for (int i = 0; i < 16; ++i) { PG8_LAS unsigned char* d = lds + (i < 7 ? loff2a : loff2b) + (i < 7 ? i : i - 7) * 16 * RS; *(PG8_LAS u32x2*)d = (u32x2){tv[i].x, tv[i].y}; *(PG8_LAS u32x2*)(d + 16) = (u32x2){tv[i].z, tv[i].w}; }
        __syncthreads();
        unsigned vb0 = (unsigned)(fr * RS + fq * 16), vb1 = vb0 + 8 * 16 * RS; asm volatile("" : "+v"(vb0), "+v"(vb1));
        bf16_t* orow = O + (size_t)(u.pm * BM + 32 * wid + fr) * D + h * 256 + 4 * fq;
#pragma unroll
        for (int db = 0; db < 16; ++db) { f32x4 o0 = (f32x4){0.f, 0.f, 0.f, 0.f}, o1 = (f32x4){0.f, 0.f, 0.f, 0.f};
#pragma unroll
            for (int cc = 0; cc < 8; ++cc) { const bf16x8 vf = *(const PG8_LAS bf16x8*)(lds + (db < 8 ? vb0 : vb1) + ((db & 7) * 16 * RS + cc * 64));
                o0 = __builtin_amdgcn_mfma_f32_16x16x32_bf16(vf, pf[0][cc], o0, 0, 0, 0); o1 = __builtin_amdgcn_mfma_f32_16x16x32_bf16(vf, pf[1][cc], o1, 0, 0, 0); }
            u32x2 w0, w1; w0.x = cvt_pk_bf16(o0[0] * inv[0], o0[1] * inv[0]); w0.y = cvt_pk_bf16(o0[2] * inv[0], o0[3] * inv[0]);
            w1.x = cvt_pk_bf16(o1[0] * inv[1], o1[1] * inv[1]); w1.y = cvt_pk_bf16(o1[2] * inv[1], o1[3] * inv[1]);
            *(u32x2*)(orow + 16 * db) = w0; *(u32x2*)(orow + (size_t)16 * D + 16 * db) = w1; }
        __syncthreads();
    }
};

__device__ __forceinline__ int lane_id_volatile() { int l; asm volatile("v_mbcnt_lo_u32_b32 %0, -1, 0\n\tv_mbcnt_hi_u32_b32 %0, -1, %0" : "=v"(l)); return l; }
#ifndef REP_P0
#define REP_P0 1
#endif
#ifndef REP_CONV
#define REP_CONV 1
#endif
#ifndef REP_SGU
#define REP_SGU 1
#endif
#ifndef REP_ATTN
#define REP_ATTN 1
#endif
#ifndef LSTART
#define LSTART 0
#endif
#ifndef LEND
#define LEND 2
#endif
struct PanelOrder {
    int pm, j, nN;
    __device__ __forceinline__ bool next(int i, Unit& u) const { const int pn = j + 4 * i; if (pn >= nN) return false; int pmv = pm; asm volatile("" : "+s"(pmv)); u.pm = pmv; u.pn = pn; return true; }
    __device__ __forceinline__ void a_ready(const Unit&) const {}
    __device__ __forceinline__ void done(const Unit&) const {}
};
__device__ __forceinline__ void group_barrier(unsigned* cnt, unsigned target, bool coxcd, unsigned* tmo, int ktid) {
    asm volatile("s_waitcnt vmcnt(0)" ::: "memory");
    __syncthreads();
    if (ktid == 0) {
        if (!coxcd) { __builtin_amdgcn_fence(__ATOMIC_RELEASE, "agent"); asm volatile("s_waitcnt vmcnt(0)" ::: "memory"); }
        (void)xb_add(cnt, 1u);
        unsigned sp = 0;
        while (xb_ld(cnt) < target) { if ((++sp & 255u) == 0u) { if (xb_ld(tmo)) break; if (sp > XB_SPIN_CAP) { atomicAdd(tmo, 1u); break; } } }
        __builtin_amdgcn_fence(__ATOMIC_ACQUIRE, "agent");
        asm volatile("s_waitcnt vmcnt(0)" ::: "memory");
    }
    __syncthreads();
}

__global__ void __launch_bounds__(NTHR, 2) fwd_kernel(Args a) {
    extern __shared__ __attribute__((aligned(16))) unsigned char lds_raw[];
    LAS unsigned char* lds = (LAS unsigned char*)lds_raw;
    volatile LAS unsigned* MISC = (volatile LAS unsigned*)(lds + MISC_OFF);
    const int wave = __builtin_amdgcn_readfirstlane((int)threadIdx.x >> 6);
#define TID() (wave * 64 + lane_id_volatile())
    const int tid = TID(), lane = tid & 63;
    const int G = gridDim.x, bx = blockIdx.x, vcu = (bx % 8) * (G / 8) + bx / 8;
    unsigned char* ws = a.ws;
    unsigned* ctl = (unsigned*)(ws + WS_CTL);
    int pm, pj; { StaticOrder S0; S0.init(T, D, G, bx); Unit own; S0.next(0, own); pm = own.pm; pj = own.pn; }
    if (tid < 32) MISC[tid] = 0u;
    if (tid == 0) __hip_atomic_store(ctl + 8192 + pm * 4 + pj, xb_xcc_id() + 1u, __ATOMIC_RELAXED, __HIP_MEMORY_SCOPE_AGENT);
    __syncthreads();
    XcdBarrier bar = xcd_barrier_post(ctl, MISC + 8, tid);
    const int gw = vcu * NWAVES + wave, NGW = G * NWAVES;
    float* out = a.out; float* ssq = (float*)(ws + WS_SSQ); float* vst = (float*)(ws + WS_VST);
    bf16_t* HB = (bf16_t*)(ws + WS_HB); bf16_t* MB = (bf16_t*)(ws + WS_MB); bf16_t* BIG = (bf16_t*)(ws + WS_BIG);
    bf16_t* MEMN = (bf16_t*)(ws + WS_MEMN); bf16_t* KB = (bf16_t*)(ws + WS_KB); bf16_t* VT = (bf16_t*)(ws + WS_VT);
    unsigned gseq = 0u; int bn = 0; (void)bn;
#ifndef PROBE_BN
#define PROBE_BN 0
#endif
#ifdef PROBE_TIME
    unsigned long long tacc = 0ull, tt0 = 0ull;
#define TBEG(k) do { if (PROBE_TIME == (k)) tt0 = __builtin_amdgcn_s_memrealtime(); } while (0)
#define TEND(k) do { if (PROBE_TIME == (k)) tacc += __builtin_amdgcn_s_memrealtime() - tt0; } while (0)
#else
#define TBEG(k) do {} while (0)
#define TEND(k) do {} while (0)
#endif
#define GRID_BAR() do { ++bn; if (PROBE_BN == 0 || bn == PROBE_BN) TBEG(2); xcd_barrier(bar, TID()); if (PROBE_BN == 0 || bn == PROBE_BN) TEND(2); } while (0)
#define GROUP_BAR() do { ++bn; if (PROBE_BN == 0 || bn == PROBE_BN) TBEG(2); gseq += 4u; group_barrier(ctl + 4096 + 64 * pm, gseq, coxcd, ctl + XB_TMO, TID()); if (PROBE_BN == 0 || bn == PROBE_BN) TEND(2); } while (0)
#define GEMM(EpiT, E, Ap, Bp, M_, N_, K_, cc) do { Gemm g{(const bf16_t*)(Ap), (const bf16_t*)(Bp), (M_), (N_), (K_)}; int cc_ = (cc); asm volatile("" : "+s"(cc_)); StaticOrder S; S.init((M_), (N_), G, cc_); TBEG(1); gemm_phase<EpiT, StaticOrder, true, true>(lds, g, S, (E), TID()); TEND(1); } while (0)
#define GEMMP(EpiT, AL, E, Ap, Bp, N_, K_) do { Gemm g{(const bf16_t*)(Ap), (const bf16_t*)(Bp), T, (N_), (K_)}; int pm_ = pm, pj_ = pj; asm volatile("" : "+s"(pm_), "+s"(pj_)); PanelOrder S{pm_, pj_, (N_) / BM}; TBEG(1); gemm_phase<EpiT, PanelOrder, AL, true>(lds, g, S, (E), TID()); TEND(1); } while (0)

    TBEG(3); p0_weights(a, 0, 1 | 2 | 4, lds, gw, NGW, wave, lane); p0_weights(a, 1, 4, lds, gw, NGW, wave, lane); p0_prologue(a, lds, gw, NGW, wave, lane, pm * BM + pj * 64); TEND(3);
    if (a.ws == nullptr) cg::this_grid().sync();
    GRID_BAR();
    bool coxcd; { const unsigned x0 = xb_ld(ctl + 8192 + pm * 4), x1 = xb_ld(ctl + 8192 + pm * 4 + 1), x2 = xb_ld(ctl + 8192 + pm * 4 + 2), x3 = xb_ld(ctl + 8192 + pm * 4 + 3);
        coxcd = __builtin_amdgcn_readfirstlane((x0 != 0u && x0 == x1 && x1 == x2 && x2 == x3) ? 1 : 0) != 0; }
    const int kvidx = (pj >= 2 && (pm & 3) == 0) ? (pm >> 2) * 2 + (pj - 2) : (1 << 20);
    const int pbidx = (pj >= 2 && (pm & 3) != 0) ? (pm - (pm >> 2) - 1) * 2 + (pj - 2) : (1 << 20);
    const int spare = pj >= 2 ? pm * 2 + (pj - 2) : (1 << 20);

#pragma unroll
    for (int l = 0; l < 2; ++l) {
        unsigned char* wl = ws + WS_W + (size_t)l * W_LAYER;
        if (l == 0) {
            { rstd_table(lds, ssq, pm, TID()); EpiZ0 E{BIG, (const LAS float*)(lds + TAB_OFF)}; GEMMP(EpiZ0, true, E, HB, wl + W_IN, DZ0, D); }
#pragma unroll 1
            for (int l2 = 0; l2 < 2; ++l2) {
                const int sub = kvidx - 16 * l2; const bf16_t* mn = MEMN + (size_t)l2 * 512 * D; const bf16_t* wkv = (const bf16_t*)(ws + WS_W + (size_t)l2 * W_LAYER + W_KV);
                { EpiScale E{KB + (size_t)l2 * 512 * D, D, nullptr}; GEMM(EpiScale, E, mn, wkv, 512, D, D, (sub >= 0 && sub < 8) ? sub : (1 << 20)); }
                { EpiVt E{VT + (size_t)l2 * 2 * D * NMEM}; GEMM(EpiVt, E, wkv + (size_t)D * D, mn, D, 512, D, (sub >= 8 && sub < 16) ? sub - 8 : (1 << 20)); } }
            if (pbidx < 96) { const int t3 = TID(); p0_weights(a, 0, 8 | 16, lds, pbidx * NWAVES + wave, 96 * NWAVES, wave, t3 & 63); }
            GRID_BAR();
            TBEG(4); conv_phase(lds, BIG, MB, a.in[8], a.in[9], a.in[10], a.in[11], a.in[12], a.in[13], 8 * pm + 2 * pj + 2, 8 * pm + 2 * pj, TID()); TEND(4);
            GRID_BAR();
            { EpiRes E{HB, ssq}; GEMMP(EpiRes, true, E, MB, wl + W_OUT, D, D); }
        } else {
            { rstd_table(lds, ssq, pm, TID()); EpiZ1 E{BIG, (const LAS float*)(lds + TAB_OFF), vst}; GEMMP(EpiZ1, true, E, HB, wl + W_IN, DZ1, D); }
            GROUP_BAR();
            TBEG(5); sgu_phase(lds, BIG, vst, (const bf16_t*)(ws + WS_WSB), a.in[19], a.in[16], a.in[17], MB, 16 * pm + 4 * pj + 4, 16 * pm + 4 * pj, TID()); TEND(5);
            GRID_BAR();
            { EpiRes E{HB, ssq}; GEMMP(EpiRes, true, E, MB, wl + W_OUT, D, D); }
        }
        GROUP_BAR();
        { rstd_table(lds, ssq, pm, TID()); EpiQAttn E{ssq, KB + (size_t)l * 512 * D, VT + (size_t)l * 2 * D * NMEM, MB}; GEMMP(EpiQAttn, false, E, HB, wl + W_Q, D, D); }
        GROUP_BAR();
        { EpiRes E{HB, ssq}; GEMMP(EpiRes, true, E, MB, wl + W_O, D, D); }
        GROUP_BAR();
        { rstd_table(lds, ssq, pm, TID()); EpiGU E{BIG, (const LAS float*)(lds + TAB_OFF)}; GEMMP(EpiGU, true, E, HB, wl + W_GU, NGU, D); }
#ifdef PROBE_G5X2
        { rstd_table(lds, ssq, pm, TID()); EpiGU E{BIG, (const LAS float*)(lds + TAB_OFF)}; GEMMP(EpiGU, true, E, HB, wl + W_GU, NGU, D); }
#endif
        if (l == 0 && spare < 128) { const int t3 = TID(); p0_weights(a, 1, 1 | 2 | 8 | 16, lds, spare * NWAVES + wave, 128 * NWAVES, wave, t3 & 63); }
        GROUP_BAR();
        { EpiRes E{HB, ssq}; GEMMP(EpiRes, true, E, BIG, wl + W_DN, D, DFF); }
        if (l == 0) GRID_BAR(); else GROUP_BAR();
    }
    { int t2 = TID(); asm volatile("" : "+v"(t2)); const int lane = t2 & 63, wv = __builtin_amdgcn_readfirstlane(t2 >> 6);
      const f32x4 g0 = *(const f32x4*)(a.in[6] + 8 * lane), g1 = *(const f32x4*)(a.in[6] + 8 * lane + 4), g2 = *(const f32x4*)(a.in[6] + 512 + 8 * lane), g3 = *(const f32x4*)(a.in[6] + 512 + 8 * lane + 4);
#pragma unroll 1
      for (int it = 0; it < 2; ++it) { const int m0 = pm * BM + pj * 64 + wv * 8 + it * 4;
          u32x4 r0[4], r1[4];
#pragma unroll
          for (int r = 0; r < 4; ++r) { const bf16_t* p = HB + (size_t)(m0 + r) * D + 8 * lane; r0[r] = *(const u32x4*)p; r1[r] = *(const u32x4*)(p + 512); }
          __builtin_amdgcn_sched_barrier(0);
#pragma unroll
          for (int r = 0; r < 4; ++r) { float v[8], w[8]; unpack8(r0[r], v); unpack8(r1[r], w); float sq = 0.f;
#pragma unroll
              for (int j = 0; j < 8; ++j) sq += v[j] * v[j] + w[j] * w[j];
              const float rs = rsqrtf(wave_sum(sq) * (1.0f / 1024.0f) + RMS_EPS);
              float* o = out + (size_t)(m0 + r) * D + 8 * lane;
              *(f32x4*)o = (f32x4){v[0], v[1], v[2], v[3]} * rs * g0; *(f32x4*)(o + 4) = (f32x4){v[4], v[5], v[6], v[7]} * rs * g1;
              *(f32x4*)(o + 512) = (f32x4){w[0], w[1], w[2], w[3]} * rs * g2; *(f32x4*)(o + 516) = (f32x4){w[4], w[5], w[6], w[7]} * rs * g3; } } }
#ifdef PROBE_TIME
    __syncthreads();
    if (pm == PROBE_PM && pj == PROBE_PJ && TID() == 0) { asm volatile("s_waitcnt vmcnt(0)" ::: "memory"); const float tus = (float)tacc * 0.01f; out[(size_t)(pm * BM + pj * 64) * D] = floorf(tus * (1.0f / PROBE_Q) + 0.5f) * PROBE_Q * 1.0e4f; }
#endif
}

extern "C" void kernel_launch(void* const* d_in, const int* in_sizes, int n_in, void* d_out, int out_size, void* d_ws, size_t ws_size, hipStream_t stream) {
    static int grid = 0;
    if (grid == 0) {
        if (n_in != 28 || out_size != T * D || ws_size < WS_END) { fprintf(stderr, "kernel_launch: unexpected shapes (n_in %d out %d ws %zu)\n", n_in, out_size, ws_size); grid = -1; return; }
        int dev = 0, cus = 0, per_cu = 0;
        (void)hipGetDevice(&dev); (void)hipDeviceGetAttribute(&cus, hipDeviceAttributeMultiprocessorCount, dev);
        (void)hipFuncSetAttribute((const void*)fwd_kernel, hipFuncAttributeMaxDynamicSharedMemorySize, LDS_BYTES);
        (void)hipOccupancyMaxActiveBlocksPerMultiprocessor(&per_cu, (const void*)fwd_kernel, NTHR, LDS_BYTES);
        if (per_cu < 1) per_cu = 1;
        (void)hipGetLastError();
        grid = cus;
        if (grid != 256) { fprintf(stderr, "kernel_launch: built for a 256-CU device (one workgroup per CU, four per row panel); found %d CUs; nothing launched\n", grid); grid = -1; return; }
    }
    if (grid < 0) return;
    (void)hipMemsetAsync((char*)d_ws + WS_CTL, 0, CTL_ZERO_BYTES, stream);
    Args a{};
    for (int i = 0; i < 28; ++i) a.in[i] = (const float*)d_in[i];
    a.out = (float*)d_out; a.ws = (unsigned char*)d_ws;
    void* args[] = {&a};
    hipError_t e = hipLaunchCooperativeKernel((const void*)fwd_kernel, dim3(grid), dim3(NTHR), args, LDS_BYTES, stream);
    if (e != hipSuccess) fprintf(stderr, "cooperative launch failed: %s (grid %d)\n", hipGetErrorString(e), grid);
}
```

```cpp
#include <hip/hip_runtime.h>
#include <hip/hip_cooperative_groups.h>
#include <cstdio>
#include <cstdint>
namespace cg = cooperative_groups;
namespace pg8 {
#define PG8_LAS __attribute__((address_space(3)))
typedef unsigned short bf16_t;
typedef short bf16x8 __attribute__((ext_vector_type(8)));
typedef float f32x4 __attribute__((ext_vector_type(4)));
typedef unsigned u32x4 __attribute__((ext_vector_type(4)));
constexpr int BM = 256, BK = 64, HALF = 128, HTB = HALF * BK * 2  , STAGE_BYTES = 8 * HTB, NXCD = 8, WGM = 8;

__host__ __device__ __forceinline__ int lds_byte(int r, int c) { const int st = (r >> 4) * 2 + (c >> 5), rr = r & 15, cc = c & 31, ob = rr * 64 + cc * 2; return st * 1024 + (ob ^ (((ob >> 9) & 1) << 5)); }
__host__ __device__ __forceinline__ void stage_rc(int b, int& R, int& C) { const int st = b / 1024, sb = b % 1024, swz = sb ^ (((sb >> 9) & 1) << 5); R = (st >> 1) * 16 + swz / 64; C = (st & 1) * 32 + (swz % 64) / 2; }
__host__ __device__ __forceinline__ int perm32(int rho) { const int n = rho >> 4, i = rho & 15; return 8 * (i >> 2) + 4 * n + (i & 3); }

struct Unit { int pm, pn; };
struct Gemm { const bf16_t* A; const bf16_t* Bt; int M, N, K; };

struct StaticOrder {
    int nM, nN, nwg, G, c;
    __host__ __device__ void init(int M, int N, int G_, int c_) { nM = M / BM; nN = N / BM; nwg = nM * nN; G = G_; c = c_; }
    __host__ __device__ bool next(int i, Unit& u) const {
        const long L = (long)i * G + c; if (L >= nwg) return false;
        int wgid = (int)L; { const int q = nwg / NXCD, r = nwg % NXCD, xcd = wgid % NXCD, off = wgid / NXCD; wgid = (xcd < r ? xcd * (q + 1) : r * (q + 1) + (xcd - r) * q) + off; }
        const int nig = WGM * nN, gid = wgid / nig, fm = gid * WGM, gsz = (nM - fm) < WGM ? (nM - fm) : WGM;
        u.pm = fm + ((wgid % nig) % gsz); u.pn = (wgid % nig) / gsz; return true;
    }
    __device__ __forceinline__ void a_ready(const Unit&) const {}
    __device__ __forceinline__ void done(const Unit&) const {}
};

__device__ __forceinline__ unsigned cvt_pk_bf16(float lo, float hi) { unsigned r; asm volatile("v_cvt_pk_bf16_f32 %0, %1, %2" : "=v"(r) : "v"(lo), "v"(hi)); return r; }
typedef float f32x2 __attribute__((ext_vector_type(2)));
template <class Epi, class Sched, bool ALIGN_EPI = false, bool SP2 = false>
__device__ __forceinline__ void gemm_phase(PG8_LAS unsigned char* lds, const Gemm g, const Sched& S, const Epi& E, int tid_in) {
    int tid_ = tid_in; asm volatile("" : "+v"(tid_));
    const int tid = tid_, wid = __builtin_amdgcn_readfirstlane(tid >> 6), lane = tid & 63, wr = wid >> 2, wc = wid & 3, fr = lane & 15, fq = lane >> 4;
    const int K = g.K, nt = K / BK;
    unsigned voffA[2], voffB[2];
#pragma unroll
    for (int i = 0; i < 2; ++i) { int R, C; stage_rc(tid * 16 + i * 8192, R, C); const int Rb = Epi::PERM ? ((R & ~31) + perm32(R & 31)) : R;
        voffA[i] = (unsigned)(R * K + C) * 2u; voffB[i] = (unsigned)(Rb * K + C) * 2u; }
    const size_t kstep = (size_t)(BK * 2);
    const size_t hstep = (size_t)HALF * K * 2;
    const size_t tstep = 2 * hstep;
    const unsigned ldsw = (unsigned)wid * 1024u;
    const int aoff = lds_byte(wr * 64 + fr, fq * 8), boff = lds_byte(wc * 32 + fr, fq * 8);
#define PG8_SA(b, h) (((b) * 2 + (h)) * HTB)
#define PG8_SB(b, h) ((4 + (b) * 2 + (h)) * HTB)
#define PG8_STAGE(bufoff, gbase, voff) do { _Pragma("unroll") for (int _i = 0; _i < 2; ++_i) \
        __builtin_amdgcn_global_load_lds((const unsigned*)((const char*)(gbase) + (voff)[_i]), (PG8_LAS unsigned*)(lds + (bufoff) + ldsw + _i * 8192), 16, 0, 0); } while (0)
#define PG8_LDA(dst, b, h) do { _Pragma("unroll") for (int m = 0; m < 4; ++m) _Pragma("unroll") for (int k = 0; k < 2; ++k) dst[m][k] = *(const PG8_LAS bf16x8*)(lds + PG8_SA(b, h) + aoff + m * 2048 + k * 1024); } while (0)
#define PG8_LDB(dst, b, h) do { _Pragma("unroll") for (int n = 0; n < 2; ++n) _Pragma("unroll") for (int k = 0; k < 2; ++k) dst[n][k] = *(const PG8_LAS bf16x8*)(lds + PG8_SB(b, h) + boff + n * 2048 + k * 1024); } while (0)
#define PG8_MMA(ai, bj, At, Bt) do { __builtin_amdgcn_s_setprio(1); _Pragma("unroll") for (int m = 0; m < 4; ++m) _Pragma("unroll") for (int n = 0; n < 2; ++n) _Pragma("unroll") for (int k = 0; k < 2; ++k) \
        acc[ai][bj][m][n] = __builtin_amdgcn_mfma_f32_16x16x32_bf16(Bt[n][k], At[m][k], acc[ai][bj][m][n], 0, 0, 0); __builtin_amdgcn_s_setprio(0); } while (0)
#define PG8_WAIT_V(n) asm volatile("s_waitcnt vmcnt(" #n ")" ::: "memory")
#define PG8_WAIT_L(n) asm volatile("s_waitcnt lgkmcnt(" #n ")" ::: "memory")
#define PG8_BAR __builtin_amdgcn_s_barrier()
#define PG8_SCHED __builtin_amdgcn_sched_barrier(0)
    Unit cur, nxt; int ui = 0;
    if (!S.next(0, cur)) return;
    f32x4 acc[2][2][4][2];
#pragma unroll
    for (int a = 0; a < 2; ++a)
#pragma unroll
        for (int b = 0; b < 2; ++b)
#pragma unroll
            for (int m = 0; m < 4; ++m)
#pragma unroll
                for (int n = 0; n < 2; ++n) acc[a][b][m][n] = (f32x4){0.f, 0.f, 0.f, 0.f};
    bf16x8 At[4][2], B0[2][2], B1[2][2];
    const char* cA = (const char*)g.A + (size_t)cur.pm * tstep; const char* cB = (const char*)g.Bt + (size_t)cur.pn * tstep;
    S.a_ready(cur);
    if constexpr (SP2) {
        PG8_STAGE(PG8_SB(0, 0), cB, voffB); PG8_STAGE(PG8_SB(0, 1), cB + hstep, voffB); PG8_STAGE(PG8_SA(0, 0), cA, voffA); PG8_STAGE(PG8_SA(0, 1), cA + hstep, voffA);
        if (wr == 1) PG8_BAR;
        PG8_WAIT_V(2); PG8_BAR;
        PG8_STAGE(PG8_SB(1, 0), cB + kstep, voffB); PG8_STAGE(PG8_SA(1, 0), cA + kstep, voffA); PG8_STAGE(PG8_SB(1, 1), cB + hstep + kstep, voffB);
        PG8_WAIT_V(6); PG8_BAR;
    } else {
        PG8_STAGE(PG8_SB(0, 0), cB, voffB); PG8_STAGE(PG8_SA(0, 0), cA, voffA); PG8_STAGE(PG8_SB(0, 1), cB + hstep, voffB); PG8_STAGE(PG8_SA(0, 1), cA + hstep, voffA);
        if (wr == 1) PG8_BAR;
        PG8_WAIT_V(4); PG8_BAR;
        PG8_STAGE(PG8_SB(1, 0), cB + kstep, voffB); PG8_STAGE(PG8_SA(1, 0), cA + kstep, voffA); PG8_STAGE(PG8_SB(1, 1), cB + hstep + kstep, voffB);
        PG8_WAIT_V(6); PG8_BAR;
    }
    for (;;) {
        const bool has_next = S.next(ui + 1, nxt);
        const char* nA = has_next ? (const char*)g.A + (size_t)nxt.pm * tstep : cA; const char* nB = has_next ? (const char*)g.Bt + (size_t)nxt.pn * tstep : cB;
        for (int t = 0; t < nt; t += 2) {
            const bool last = (t == nt - 2);
            const char* a1 = cA + (size_t)(t + 1) * kstep;
            const char* a2 = last ? nA : cA + (size_t)(t + 2) * kstep; const char* b2 = last ? nB : cB + (size_t)(t + 2) * kstep;
            const char* a3 = a2 + kstep; const char* b3 = b2 + kstep;
            if (last && has_next) S.a_ready(nxt);
            if constexpr (SP2) {
            PG8_LDB(B0, 0, 0); PG8_LDB(B1, 0, 1); PG8_SCHED; PG8_LDA(At, 0, 0); PG8_STAGE(PG8_SA(1, 1), a1 + hstep, voffA);
            PG8_WAIT_V(8); PG8_WAIT_L(0); PG8_BAR; PG8_MMA(0, 0, At, B0); PG8_MMA(0, 1, At, B1); PG8_BAR; PG8_SCHED;
            PG8_LDA(At, 0, 1); PG8_STAGE(PG8_SB(0, 0), b2, voffB); PG8_STAGE(PG8_SB(0, 1), b2 + hstep, voffB); PG8_STAGE(PG8_SA(0, 0), a2, voffA);
            PG8_WAIT_V(8); PG8_WAIT_L(0); PG8_BAR; PG8_MMA(1, 0, At, B0); PG8_MMA(1, 1, At, B1); PG8_BAR; PG8_SCHED;
            PG8_LDB(B0, 1, 0); PG8_LDB(B1, 1, 1); PG8_SCHED; PG8_LDA(At, 1, 0); PG8_STAGE(PG8_SA(0, 1), a2 + hstep, voffA);
            PG8_WAIT_V(8); PG8_WAIT_L(0); PG8_BAR; PG8_MMA(0, 0, At, B0); PG8_MMA(0, 1, At, B1); PG8_BAR; PG8_SCHED;
            PG8_LDA(At, 1, 1); PG8_STAGE(PG8_SB(1, 0), b3, voffB); PG8_STAGE(PG8_SB(1, 1), b3 + hstep, voffB); PG8_STAGE(PG8_SA(1, 0), a3, voffA);
            PG8_WAIT_V(8); PG8_WAIT_L(0); PG8_BAR; PG8_MMA(1, 0, At, B0); PG8_MMA(1, 1, At, B1); PG8_BAR; PG8_SCHED;
            } else {
            PG8_LDB(B0, 0, 0); PG8_SCHED; PG8_LDA(At, 0, 0); PG8_STAGE(PG8_SA(1, 1), a1 + hstep, voffA);
            PG8_WAIT_L(8); PG8_BAR; PG8_WAIT_L(0); PG8_MMA(0, 0, At, B0); PG8_BAR; PG8_SCHED;
            PG8_LDB(B1, 0, 1); PG8_STAGE(PG8_SB(0, 0), b2, voffB);
            PG8_BAR; PG8_WAIT_L(0); PG8_MMA(0, 1, At, B1); PG8_BAR;
            PG8_LDA(At, 0, 1); PG8_STAGE(PG8_SA(0, 0), a2, voffA);
            PG8_BAR; PG8_WAIT_L(0); PG8_MMA(1, 0, At, B0); PG8_BAR; PG8_SCHED;
            PG8_STAGE(PG8_SB(0, 1), b2 + hstep, voffB);
            PG8_WAIT_V(6); PG8_BAR; PG8_MMA(1, 1, At, B1); PG8_BAR;
            PG8_LDB(B0, 1, 0); PG8_SCHED; PG8_LDA(At, 1, 0); PG8_STAGE(PG8_SA(0, 1), a2 + hstep, voffA);
            PG8_WAIT_L(8); PG8_BAR; PG8_WAIT_L(0); PG8_MMA(0, 0, At, B0); PG8_BAR; PG8_SCHED;
            PG8_LDB(B1, 1, 1); PG8_STAGE(PG8_SB(1, 0), b3, voffB);
            PG8_BAR; PG8_WAIT_L(0); PG8_MMA(0, 1, At, B1); PG8_BAR;
            PG8_LDA(At, 1, 1); PG8_STAGE(PG8_SA(1, 0), a3, voffA);
            PG8_BAR; PG8_WAIT_L(0); PG8_MMA(1, 0, At, B0); PG8_BAR; PG8_SCHED;
            PG8_STAGE(PG8_SB(1, 1), b3 + hstep, voffB);
            PG8_WAIT_V(6); PG8_BAR; PG8_MMA(1, 1, At, B1); PG8_BAR;
            }
        }
        if constexpr (ALIGN_EPI) { if (wr == 0) PG8_BAR; }
        if constexpr (!Epi::AFTER_DRAIN) { E(acc, cur, wr, wc, fr, fq); S.done(cur); }
        if (!has_next) break;
#pragma unroll
        for (int a = 0; a < 2; ++a)
#pragma unroll
            for (int b = 0; b < 2; ++b)
#pragma unroll
                for (int m = 0; m < 4; ++m)
#pragma unroll
                    for (int n = 0; n < 2; ++n) acc[a][b][m][n] = (f32x4){0.f, 0.f, 0.f, 0.f};
        cur = nxt; cA = nA; cB = nB; ++ui;
        if constexpr (ALIGN_EPI) { if (wr == 1) PG8_BAR; }
    }
    PG8_WAIT_V(0);
    if constexpr (!ALIGN_EPI) { if (wr == 0) PG8_BAR; }
    PG8_BAR;
    if constexpr (Epi::AFTER_DRAIN) { E.fused(acc, cur, wr, wc, fr, fq, lds, wid, lane); S.done(cur); }
#undef PG8_SA
#undef PG8_SB
#undef PG8_STAGE
#undef PG8_LDA
#undef PG8_LDB
#undef PG8_MMA
#undef PG8_WAIT_V
#undef PG8_WAIT_L
#undef PG8_BAR
#undef PG8_SCHED
}
}
#define LAS __attribute__((address_space(3)))
#define XB_TMO      128
#define XB_XCNT(j)  (256  + 64 * (j))
#define XB_XSUB(j)  (1280 + 64 * (j))
#define XB_XGEN(j)  (2304 + 64 * (j))
#define XB_TOP      3328
#define XB_TOPGEN   3392
#define XCD_BAR_WORDS 3456
#define XB_SPIN_CAP (1u << 18)

__device__ __forceinline__ unsigned xb_ld(unsigned* p)              { return __hip_atomic_load(p, __ATOMIC_RELAXED, __HIP_MEMORY_SCOPE_AGENT); }
__device__ __forceinline__ unsigned xb_add(unsigned* p, unsigned v) { return __hip_atomic_fetch_add(p, v, __ATOMIC_RELAXED, __HIP_MEMORY_SCOPE_AGENT); }
__device__ __forceinline__ unsigned xb_xcc_id() { return (unsigned)__builtin_amdgcn_s_getreg((3 << 11) | 20) & 0xFu; }
#define XB_SPIN(cond, bar) do { unsigned _sp = 0; while (cond) { __builtin_amdgcn_s_sleep(1); \
    if ((++_sp & 255u) == 0u) { if (xb_ld(&(bar)[XB_TMO])) break; if (_sp > XB_SPIN_CAP) { atomicAdd(&(bar)[XB_TMO], 1u); break; } } } } while (0)

struct XcdBarrier {
    unsigned* bar; unsigned x;
    volatile LAS unsigned* st;
};

__device__ __forceinline__ XcdBarrier xcd_barrier_post(unsigned* bar, volatile LAS unsigned* st, int ktid) {
    XcdBarrier b; b.bar = bar; b.x = xb_xcc_id(); b.st = st;
    if (ktid == 0) (void)xb_add(&bar[XB_XCNT(b.x)], 1u);
    return b;
}
__device__ __forceinline__ void xcd_barrier_complete(unsigned* bar, unsigned x, unsigned& nloc, unsigned& nx) {
    const unsigned G = gridDim.x * gridDim.y * gridDim.z;
    unsigned sum, cnt, mine, sp = 0u;
    for (;;) {
        sum = 0u; cnt = 0u; mine = 0u;
#pragma unroll
        for (unsigned j = 0; j < 16; ++j) { const unsigned c = xb_ld(&bar[XB_XCNT(j)]); sum += c; cnt += (c > 0u) ? 1u : 0u; mine = (j == x) ? c : mine; }
        if (sum == G) break;
        __builtin_amdgcn_s_sleep(1);
        if ((++sp & 255u) == 0u) { if (xb_ld(&bar[XB_TMO])) break; if (sp > XB_SPIN_CAP) { atomicAdd(&bar[XB_TMO], 1u); break; } }
    }
    nloc = mine > 0u ? mine : 1u; nx = cnt > 0u ? cnt : 1u;
}

__device__ __forceinline__ void xcd_barrier(const XcdBarrier& b, int ktid) {
    asm volatile("s_waitcnt vmcnt(0)" ::: "memory");
    __syncthreads();
    if (ktid == 0) {
        unsigned* bar = b.bar; const unsigned bx_ = xb_xcc_id();
        __builtin_amdgcn_s_waitcnt(0);
        unsigned nloc = b.st[0], nx = b.st[1];
        if (nloc == 0u) { xcd_barrier_complete(bar, bx_, nloc, nx); b.st[0] = nloc; b.st[1] = nx; }
        const unsigned old = xb_add(&bar[XB_XSUB(bx_)], 1u);
        const unsigned gen = old / nloc;
        if (old + 1u == (gen + 1u) * nloc) {
            __builtin_amdgcn_fence(__ATOMIC_RELEASE, "agent");
            asm volatile("s_waitcnt vmcnt(0)" ::: "memory");
            const unsigned og = xb_add(&bar[XB_TOP], 1u);
            const unsigned tg = og / nx;
            if (og + 1u == (tg + 1u) * nx) xb_add(&bar[XB_TOPGEN], 1u);
            else XB_SPIN(xb_ld(&bar[XB_TOPGEN]) == tg, bar);
            __builtin_amdgcn_fence(__ATOMIC_ACQUIRE, "agent");
            xb_add(&bar[XB_XGEN(bx_)], 1u);
            asm volatile("s_waitcnt vmcnt(0)" ::: "memory");
        } else {
            XB_SPIN(xb_ld(&bar[XB_XGEN(bx_)]) == gen, bar);
            __builtin_amdgcn_fence(__ATOMIC_ACQUIRE, "agent");
            asm volatile("s_waitcnt vmcnt(0)" ::: "memory");
        }
    }
    __syncthreads();
}
#undef LAS
using namespace pg8;
#define LAS __attribute__((address_space(3)))
typedef unsigned u32x2 __attribute__((ext_vector_type(2)));

constexpr int NWAVES = 8, NTHR = 512;
constexpr int SEQ = 8192, NBATCH = 2, T = NBATCH * SEQ, D = 1024, DZ0 = 2560, DZ1 = 2048, DFF = 2816, NGU = 2 * DFF, NMEM = 256;
constexpr float RMS_EPS = 1e-6f, LN_EPS = 1e-5f;
constexpr size_t MiB = 1u << 20;
constexpr size_t WS_CTL = 0, CTL_ZERO_BYTES = 64 * 1024;
constexpr size_t WS_W = 2 * MiB, W_LAYER = 32 * MiB;
constexpr size_t W_IN = 0, W_OUT = 5 * MiB, W_Q = 7 * MiB, W_KV = 9 * MiB, W_O = 13 * MiB, W_GU = 15 * MiB, W_DN = 26 * MiB;
constexpr size_t WS_WSB = 66 * MiB;
constexpr size_t WS_SSQ = 67 * MiB;
constexpr size_t WS_VST = 68 * MiB;
constexpr size_t WS_MEMN = 70 * MiB;
constexpr size_t WS_KB = 72 * MiB;
constexpr size_t WS_VT = 74 * MiB;
constexpr size_t WS_HB = 76 * MiB;
constexpr size_t WS_MB = 108 * MiB;
constexpr size_t WS_BIG = 140 * MiB;
constexpr size_t WS_END = 228 * MiB;
constexpr int LDS_BYTES = 147456, MISC_OFF = 139264, TAB_OFF = 135168;

template <int CTRL> __device__ __forceinline__ float dpp_mov(float v) { return __builtin_bit_cast(float, __builtin_amdgcn_update_dpp(0, __builtin_bit_cast(int, v), CTRL, 0xF, 0xF, true)); }
__device__ __forceinline__ float wave_sum(float v) {
    v += dpp_mov<0xB1>(v);
    v += dpp_mov<0x4E>(v);
    v += dpp_mov<0x141>(v);
    v += dpp_mov<0x140>(v);
    const int vi = __builtin_bit_cast(int, v);
    const float r0 = __builtin_bit_cast(float, __builtin_amdgcn_readlane(vi, 0)), r1 = __builtin_bit_cast(float, __builtin_amdgcn_readlane(vi, 16)),
                r2 = __builtin_bit_cast(float, __builtin_amdgcn_readlane(vi, 32)), r3 = __builtin_bit_cast(float, __builtin_amdgcn_readlane(vi, 48));
    return (r0 + r1) + (r2 + r3);
}
__device__ __forceinline__ float xrow16_sum(float x) {
    auto s = __builtin_amdgcn_permlane16_swap(__float_as_uint(x), __float_as_uint(x), false, false);
    x = __uint_as_float(s[0]) + __uint_as_float(s[1]);
    auto t = __builtin_amdgcn_permlane32_swap(__float_as_uint(x), __float_as_uint(x), false, false);
    return __uint_as_float(t[0]) + __uint_as_float(t[1]);
}
__device__ __forceinline__ float xrow16_max(float x) {
    auto s = __builtin_amdgcn_permlane16_swap(__float_as_uint(x), __float_as_uint(x), false, false);
    x = fmaxf(__uint_as_float(s[0]), __uint_as_float(s[1]));
    auto t = __builtin_amdgcn_permlane32_swap(__float_as_uint(x), __float_as_uint(x), false, false);
    return fmaxf(__uint_as_float(t[0]), __uint_as_float(t[1]));
}
__device__ __forceinline__ float bf2f(unsigned short b) { return __uint_as_float((unsigned)b << 16); }
__device__ __forceinline__ float bflo(unsigned w) { return __uint_as_float(w << 16); }
__device__ __forceinline__ float bfhi(unsigned w) { return __uint_as_float(w & 0xffff0000u); }
__device__ __forceinline__ unsigned short f2bf(float f) { return (unsigned short)(cvt_pk_bf16(f, 0.f) & 0xffffu); }
__device__ __forceinline__ float sigm(float x) { return __builtin_amdgcn_rcpf(1.f + __builtin_amdgcn_exp2f(-1.44269504f * x)); }
typedef float f32x2 __attribute__((ext_vector_type(2)));
__device__ __forceinline__ f32x2 exp2_pk(f32x2 t) { f32x2 e; e.x = __builtin_amdgcn_exp2f(t.x); e.y = __builtin_amdgcn_exp2f(t.y); return e; }
__device__ __forceinline__ f32x2 rcp_pk(f32x2 d) { f32x2 r; r.x = __builtin_amdgcn_rcpf(d.x); r.y = __builtin_amdgcn_rcpf(d.y); return r; }
__device__ __forceinline__ f32x2 swiglu_pk(f32x2 ag, f32x2 au, float c1, float c2) { const f32x2 r = rcp_pk(exp2_pk(ag * c1) + 1.0f); return (ag * au) * r * c2; }
__device__ __forceinline__ f32x2 gelu_tanh_pk(f32x2 x) { const f32x2 x2 = x * x, t = x * (x2 * (-2.3022081986f * 0.044715f) + (-2.3022081986f)); return x * rcp_pk(exp2_pk(t) + 1.0f); }
__device__ __forceinline__ float gelu_tanh(float x) { const float y = 1.5957691216f * (x + 0.044715f * x * x * x); return x * sigm(y); }

__device__ __forceinline__ float row_rstd(const float* ssq, int row, int fq) {
    const f32x4 a = *(const f32x4*)(ssq + (size_t)row * 16 + 4 * fq);
    float s = (a[0] + a[1]) + (a[2] + a[3]);
    s = xrow16_sum(s);
    return rsqrtf(s * (1.0f / 1024.0f) + RMS_EPS);
}
__device__ __forceinline__ void rstd_table(LAS unsigned char* lds, const float* ssq, int pm, int tid) {
    if (tid < 256) { const f32x4* p = (const f32x4*)(ssq + ((size_t)pm * 256 + tid) * 16); const f32x4 a = p[0], b = p[1], c = p[2], d = p[3];
        const float s = (((a[0] + a[1]) + (a[2] + a[3])) + ((b[0] + b[1]) + (b[2] + b[3]))) + (((c[0] + c[1]) + (c[2] + c[3])) + ((d[0] + d[1]) + (d[2] + d[3])));
        ((LAS float*)(lds + TAB_OFF))[tid] = rsqrtf(s * (1.0f / 1024.0f) + RMS_EPS); }
    __syncthreads();
}
__device__ __forceinline__ u32x4 pack8(const f32x4 v0, const f32x4 v1) { u32x4 w; w.x = cvt_pk_bf16(v0[0], v0[1]); w.y = cvt_pk_bf16(v0[2], v0[3]); w.z = cvt_pk_bf16(v1[0], v1[1]); w.w = cvt_pk_bf16(v1[2], v1[3]); return w; }

struct EpiScale {
    static constexpr bool PERM = true, AFTER_DRAIN = false;
    bf16_t* O; int ldc; const float* ssq;
    __device__ __forceinline__ void operator()(const f32x4 (&acc)[2][2][4][2], const Unit& u, int wr, int wc, int fr, int fq) const {
        const int row0 = u.pm * BM + wr * 64 + fr, col0 = u.pn * BM + wc * 32 + 8 * fq;
#pragma unroll
        for (int ai = 0; ai < 2; ++ai)
#pragma unroll
            for (int m = 0; m < 4; ++m) { const int row = row0 + ai * HALF + m * 16; const float rs = ssq ? row_rstd(ssq, row, fq) : 1.f; bf16_t* rowp = O + (size_t)row * ldc + col0;
#pragma unroll
                for (int bj = 0; bj < 2; ++bj) *(u32x4*)(rowp + bj * HALF) = pack8(acc[ai][bj][m][0] * rs, acc[ai][bj][m][1] * rs); }
    }
};
constexpr int DZ3 = 1536;
struct EpiZ0 {
    static constexpr bool PERM = true, AFTER_DRAIN = false;
    bf16_t* O; const LAS float* tab;
    __device__ __forceinline__ void operator()(const f32x4 (&acc)[2][2][4][2], const Unit& u, int wr, int wc, int fr, int fq) const {
        const int row0 = u.pm * BM + wr * 64 + fr, cin = wc * 32 + 8 * fq;
#pragma unroll
        for (int ai = 0; ai < 2; ++ai)
#pragma unroll
            for (int m = 0; m < 4; ++m) { const int row = row0 + ai * HALF + m * 16; const float rs = tab[ai * HALF + wr * 64 + m * 16 + fr]; bf16_t* rowp = O + (size_t)row * DZ3;
                if (u.pn >= 8) {
#pragma unroll
                    for (int bj = 0; bj < 2; ++bj) *(u32x4*)(rowp + 1024 + (u.pn - 8) * BM + bj * HALF + cin) = pack8(acc[ai][bj][m][0] * rs, acc[ai][bj][m][1] * rs);
                } else { f32x4 h[2]; const float c1 = -1.44269504f * rs, c2 = rs * rs;
#pragma unroll
                    for (int n = 0; n < 2; ++n) { const f32x4 ap = acc[ai][0][m][n], aq = acc[ai][1][m][n];
                        const f32x2 pl = (f32x2){ap[0], ap[1]}, ph = (f32x2){ap[2], ap[3]}, ql = (f32x2){aq[0], aq[1]}, qh = (f32x2){aq[2], aq[3]};
                        f32x2 lo, hi;
                        if (u.pn < 4) { lo = (pl * rs) * rcp_pk(exp2_pk(ql * c1) + 1.0f); hi = (ph * rs) * rcp_pk(exp2_pk(qh * c1) + 1.0f); }
                        else { lo = (pl * ql) * c2; hi = (ph * qh) * c2; }
                        h[n] = (f32x4){lo.x, lo.y, hi.x, hi.y}; }
                    *(u32x4*)(rowp + u.pn * HALF + cin) = pack8(h[0], h[1]); } }
    }
};
struct EpiRes {
    static constexpr bool PERM = true, AFTER_DRAIN = false;
    bf16_t* hb; float* ssq;
    __device__ __forceinline__ void operator()(const f32x4 (&acc)[2][2][4][2], const Unit& u, int wr, int wc, int fr, int fq) const {
        const int row0 = u.pm * BM + wr * 64 + fr, col0 = u.pn * BM + wc * 32 + 8 * fq;
#pragma unroll
        for (int ai = 0; ai < 2; ++ai)
#pragma unroll
            for (int m = 0; m < 4; ++m) { const int row = row0 + ai * HALF + m * 16; const size_t off = (size_t)row * D + col0; float q = 0.f; f32x2 q2 = (f32x2){0.f, 0.f};
#pragma unroll
                for (int bj = 0; bj < 2; ++bj) { const u32x4 bb = *(const u32x4*)(hb + off + bj * HALF);
                    const f32x4 b0 = (f32x4){bflo(bb.x), bfhi(bb.x), bflo(bb.y), bfhi(bb.y)}, b1 = (f32x4){bflo(bb.z), bfhi(bb.z), bflo(bb.w), bfhi(bb.w)};
                    const f32x4 v0 = b0 + acc[ai][bj][m][0], v1 = b1 + acc[ai][bj][m][1];
                    *(u32x4*)(hb + off + bj * HALF) = pack8(v0, v1);
                    const f32x2 a0 = (f32x2){v0[0], v0[1]}, a1 = (f32x2){v0[2], v0[3]}, a2 = (f32x2){v1[0], v1[1]}, a3 = (f32x2){v1[2], v1[3]};
                    q2 += a0 * a0; q2 += a1 * a1; q2 += a2 * a2; q2 += a3 * a3; }
                q = xrow16_sum(q2.x + q2.y);
                if (fq == 0) ssq[(size_t)row * 16 + u.pn * 4 + wc] = q; }
    }
};
struct EpiGU {
    static constexpr bool PERM = true, AFTER_DRAIN = false;
    bf16_t* O; const LAS float* tab;
    __device__ __forceinline__ void operator()(const f32x4 (&acc)[2][2][4][2], const Unit& u, int wr, int wc, int fr, int fq) const {
        const int row0 = u.pm * BM + wr * 64 + fr, col0 = u.pn * HALF + wc * 32 + 8 * fq;
#ifdef EPI_GU_REP
        _Pragma("unroll 1") for (int rep = 0; rep < EPI_GU_REP; ++rep) { asm volatile("" ::: "memory");
#else
        {
#endif
#pragma unroll
        for (int ai = 0; ai < 2; ++ai)
#pragma unroll
            for (int m = 0; m < 4; ++m) { const int row = row0 + ai * HALF + m * 16; const float rs = tab[ai * HALF + wr * 64 + m * 16 + fr];
                const float c1 = -1.44269504f * rs, c2 = rs * rs; f32x4 h[2];
#pragma unroll
                for (int n = 0; n < 2; ++n) { const f32x4 ag = acc[ai][0][m][n], au = acc[ai][1][m][n];
                    const f32x2 lo = swiglu_pk((f32x2){ag[0], ag[1]}, (f32x2){au[0], au[1]}, c1, c2), hi = swiglu_pk((f32x2){ag[2], ag[3]}, (f32x2){au[2], au[3]}, c1, c2);
                    h[n] = (f32x4){lo.x, lo.y, hi.x, hi.y}; }
                *(u32x4*)(O + (size_t)row * DFF + col0) = pack8(h[0], h[1]); }
        }
    }
};
struct EpiZ1 {
    static constexpr bool PERM = true, AFTER_DRAIN = false;
    bf16_t* O; const LAS float* tab; float* vst;
    __device__ __forceinline__ void operator()(const f32x4 (&acc)[2][2][4][2], const Unit& u, int wr, int wc, int fr, int fq) const {
        const int row0 = u.pm * BM + wr * 64 + fr, col0 = u.pn * BM + wc * 32 + 8 * fq;
#pragma unroll
        for (int ai = 0; ai < 2; ++ai)
#pragma unroll
            for (int m = 0; m < 4; ++m) { const int row = row0 + ai * HALF + m * 16; const float rs = tab[ai * HALF + wr * 64 + m * 16 + fr]; bf16_t* rowp = O + (size_t)row * DZ1 + col0; float s = 0.f, q = 0.f;
                f32x2 s2 = (f32x2){0.f, 0.f}, q2 = (f32x2){0.f, 0.f};
#pragma unroll
                for (int bj = 0; bj < 2; ++bj) { f32x4 v[2];
#pragma unroll
                    for (int n = 0; n < 2; ++n) { const f32x4 av = acc[ai][bj][m][n];
                        const f32x2 lo = gelu_tanh_pk((f32x2){av[0], av[1]} * rs), hi = gelu_tanh_pk((f32x2){av[2], av[3]} * rs);
                        s2 += lo; s2 += hi; q2 += lo * lo; q2 += hi * hi; v[n] = (f32x4){lo.x, lo.y, hi.x, hi.y}; }
                    *(u32x4*)(rowp + bj * HALF) = pack8(v[0], v[1]); }
                s = s2.x + s2.y; q = q2.x + q2.y;
                if (u.pn >= 4) { s = xrow16_sum(s); q = xrow16_sum(q);
                    if (fq == 0) { float* p = vst + ((size_t)row * 16 + (u.pn - 4) * 4 + wc) * 2; p[0] = s; p[1] = q; } } }
    }
};
struct EpiVt {
    static constexpr bool PERM = true, AFTER_DRAIN = false;
    bf16_t* Vt;
    __device__ __forceinline__ void operator()(const f32x4 (&acc)[2][2][4][2], const Unit& u, int wr, int wc, int fr, int fq) const {
        const int row0 = u.pm * BM + wr * 64 + fr, col0 = wc * 32 + 8 * fq;
#pragma unroll
        for (int ai = 0; ai < 2; ++ai)
#pragma unroll
            for (int m = 0; m < 4; ++m) { bf16_t* rowp = Vt + ((size_t)u.pn * D + row0 + ai * HALF + m * 16) * NMEM + col0;
#pragma unroll
                for (int bj = 0; bj < 2; ++bj) *(u32x4*)(rowp + bj * HALF) = pack8(acc[ai][bj][m][0], acc[ai][bj][m][1]); }
    }
};

__device__ __forceinline__ void tr_item(const float* W, int K, int N, bf16_t* WT, const float* g, float cs, int mode, LAS float* scr, int item, int lane) {
    const int nblk = N / 64, kb = item / nblk, nb = item % nblk, k0 = 64 * kb, n0 = 64 * nb;
    int orow;
    if (mode == 3) {
        const int sec = n0 >> 9, np = n0 & 511, il = (np >> 7) * 256 + (np & 127);
        orow = sec == 0 ? il : sec == 1 ? il + 128 : sec == 2 ? 1024 + il : sec == 3 ? 2048 + np : 1024 + il + 128;
    } else orow = mode == 0 ? n0 : ((n0 >> 7) * 256 + (n0 & 127) + (mode == 2 ? 128 : 0));
    const int kq = lane >> 4, n4 = (lane & 15) * 4;
    f32x4 v[16]; float sc[16];
#pragma unroll
    for (int i = 0; i < 16; ++i) { const int kk = 4 * i + kq; v[i] = *(const f32x4*)(W + (size_t)(k0 + kk) * N + n0 + n4); sc[i] = g ? g[k0 + kk] * cs : cs; }
    __builtin_amdgcn_sched_barrier(0);
#pragma unroll
    for (int i = 0; i < 16; ++i) { const int kk = 4 * i + kq; LAS float* d = scr + kk * 65 + n4; d[0] = v[i][0] * sc[i]; d[1] = v[i][1] * sc[i]; d[2] = v[i][2] * sc[i]; d[3] = v[i][3] * sc[i]; }
    asm volatile("s_waitcnt lgkmcnt(0)" ::: "memory");
    const int c = lane & 7;
#pragma unroll
    for (int j = 0; j < 8; ++j) { const int n = (lane >> 3) + 8 * j; const LAS float* p = scr + (8 * c) * 65 + n;
        u32x4 o; o.x = cvt_pk_bf16(p[0 * 65], p[1 * 65]); o.y = cvt_pk_bf16(p[2 * 65], p[3 * 65]); o.z = cvt_pk_bf16(p[4 * 65], p[5 * 65]); o.w = cvt_pk_bf16(p[6 * 65], p[7 * 65]);
        *(u32x4*)(WT + (size_t)(orow + n) * K + k0 + 8 * c) = o; }
    asm volatile("s_waitcnt lgkmcnt(0)" ::: "memory");
}

struct Args { const float* in[28]; float* out; unsigned char* ws; };

__device__ __forceinline__ void p0_weights(const Args& a, int l, int part, LAS unsigned char* lds, int gw, int NGW, int wave, int lane) {
    unsigned char* ws = a.ws;
    LAS float* scr = (LAS float*)(lds + wave * 16640);
    const float QS = 0.0625f * 1.44269504f;
    const int NIN = l ? DZ1 : DZ0, I_IN = 16 * (NIN / 64);
    constexpr int I_SQ = 16 * 16, I_GU = 16 * (DFF / 64), I_DN = (DFF / 64) * 16;
    const int I_A = (part & 1) ? I_IN : 0, I_S = (part & 2) ? I_SQ : 0, I_KV = (part & 4) ? I_SQ : 0, I_G = (part & 8) ? I_GU : 0, I_D = (part & 16) ? I_DN : 0;
    const int NITEMS = I_A + 3 * I_S + 2 * I_KV + 2 * I_G + I_D;
    unsigned char* wl = ws + WS_W + (size_t)l * W_LAYER;
    for (int it = gw; it < NITEMS; it += NGW) {
        int r = it; bool found = false; const float* W = nullptr; int K = 0, N = 0, mode = 0; bf16_t* WT = nullptr; const float* gv = nullptr; float cs = 1.f;
#define SEL(NI, Wp, K_, N_, WTp, g_, cs_, mode_) if (!found) { if (r < (NI)) { W = (Wp); K = (K_); N = (N_); WT = (bf16_t*)(WTp); gv = (g_); cs = (cs_); mode = (mode_); found = true; } else r -= (NI); }
        SEL(I_A, l ? a.in[15] : a.in[7], D, NIN, wl + W_IN, a.in[2] + l * D, 1.f, l ? 0 : 3)
        SEL(I_S, l ? a.in[20] : a.in[14], D, D, wl + W_OUT, nullptr, 1.f, 0)
        SEL(I_S, a.in[21] + (size_t)l * D * D, D, D, wl + W_Q, a.in[3] + l * D, QS, 0)
        SEL(I_KV, a.in[22] + (size_t)l * D * D, D, D, wl + W_KV, nullptr, 1.f, 0)
        SEL(I_KV, a.in[23] + (size_t)l * D * D, D, D, wl + W_KV + (size_t)D * D * 2, nullptr, 1.f, 0)
        SEL(I_S, a.in[24] + (size_t)l * D * D, D, D, wl + W_O, nullptr, 1.f, 0)
        SEL(I_G, a.in[25] + (size_t)l * D * DFF, D, DFF, wl + W_GU, a.in[5] + l * D, 1.f, 1)
        SEL(I_G, a.in[26] + (size_t)l * D * DFF, D, DFF, wl + W_GU, a.in[5] + l * D, 1.f, 2)
        SEL(I_D, a.in[27] + (size_t)l * D * DFF, DFF, D, wl + W_DN, nullptr, 1.f, 0)
#undef SEL
        tr_item(W, K, N, WT, gv, cs, mode, scr, r, lane);
    }
}
__device__ __forceinline__ void p0_prologue(const Args& a, LAS unsigned char* lds, int gw, int NGW, int wave, int lane, int xrow0) {
    unsigned char* ws = a.ws;
    { const f32x4* src = (const f32x4*)a.in[18]; u32x2* dst = (u32x2*)(ws + WS_WSB);
      for (int i = gw * 64 + lane; i < 8 * 128 * 128 / 4; i += NGW * 64) { const f32x4 v = src[i]; u32x2 o; o.x = cvt_pk_bf16(v[0], v[1]); o.y = cvt_pk_bf16(v[2], v[3]); dst[i] = o; } }
    { float* ssq = (float*)(ws + WS_SSQ); bf16_t* HB = (bf16_t*)(ws + WS_HB);
      _Pragma("unroll 1") for (int it = 0; it < 2; ++it) { const int m0 = xrow0 + wave * 8 + it * 4;
          f32x4 v[4][4];
#pragma unroll
          for (int r = 0; r < 4; ++r) { const f32x4* xr = (const f32x4*)(a.in[0] + (size_t)(m0 + r) * D) + lane;
#pragma unroll
              for (int j = 0; j < 4; ++j) v[r][j] = xr[64 * j]; }
          __builtin_amdgcn_sched_barrier(0);
#pragma unroll
          for (int r = 0; r < 4; ++r) { float s = 0.f;
#pragma unroll
              for (int j = 0; j < 4; ++j) s += (v[r][j][0] * v[r][j][0] + v[r][j][1] * v[r][j][1]) + (v[r][j][2] * v[r][j][2] + v[r][j][3] * v[r][j][3]);
              s = wave_sum(s);
              u32x2* o = (u32x2*)(HB + (size_t)(m0 + r) * D) + lane;
#pragma unroll
              for (int j = 0; j < 4; ++j) { u32x2 w; w.x = cvt_pk_bf16(v[r][j][0], v[r][j][1]); w.y = cvt_pk_bf16(v[r][j][2], v[r][j][3]); o[64 * j] = w; }
              if (lane < 16) ssq[(size_t)(m0 + r) * 16 + lane] = lane == 0 ? s : 0.f; }
      } }
    { bf16_t* MN = (bf16_t*)(ws + WS_MEMN);
      for (int m = gw; m < 2 * 512; m += NGW) { const int l = m >> 9, row = m & 511;
          const f32x4* xr = (const f32x4*)(a.in[1] + (size_t)row * D) + lane; const f32x4* gr = (const f32x4*)(a.in[4] + l * D) + lane; f32x4 v[4]; float s = 0.f;
#pragma unroll
          for (int j = 0; j < 4; ++j) { v[j] = xr[64 * j]; s += (v[j][0] * v[j][0] + v[j][1] * v[j][1]) + (v[j][2] * v[j][2] + v[j][3] * v[j][3]); }
          const float rs = rsqrtf(wave_sum(s) * (1.0f / 1024.0f) + RMS_EPS);
          u32x2* o = (u32x2*)(MN + ((size_t)l * 512 + row) * D) + lane;
#pragma unroll
          for (int j = 0; j < 4; ++j) { const f32x4 g = gr[64 * j]; u32x2 w; w.x = cvt_pk_bf16(v[j][0] * rs * g[0], v[j][1] * rs * g[1]); w.y = cvt_pk_bf16(v[j][2] * rs * g[2], v[j][3] * rs * g[3]); o[64 * j] = w; }
      } }
}

__device__ __forceinline__ void unpack8(const u32x4 r, float (&v)[8]) { v[0] = bflo(r.x); v[1] = bfhi(r.x); v[2] = bflo(r.y); v[3] = bfhi(r.y); v[4] = bflo(r.z); v[5] = bfhi(r.z); v[6] = bflo(r.w); v[7] = bfhi(r.w); }
__device__ __forceinline__ void conv_phase(LAS unsigned char* lds, const bf16_t* Z, bf16_t* Mo, const float* cw, const float* cb, const float* lg, const float* lb,
                                           const float* bw, const float* bb, int G, int c, int tid_in) {
    constexpr int TT = 32, RR = TT + 30;
    int tid_ = tid_in; asm volatile("" : "+v"(tid_)); asm volatile("" : "+s"(c), "+s"(G));
    const int tid = tid_, lane = tid & 63, wid = tid >> 6;
    LAS float* as = (LAS float*)lds;
    LAS float* os = (LAS float*)lds;
    for (int u = c; u < G; ++u) {
        const int t0 = u * TT, b = t0 / SEQ, s0 = t0 % SEQ;
        const bf16_t* zb = Z + (size_t)b * SEQ * DZ3;
        __syncthreads();
        { u32x4 rv[8];
#pragma unroll
          for (int i = 0; i < 8; ++i) { const int idx = tid + 512 * i, r = idx >> 6, cc = idx & 63, sq = s0 - 15 + r; const bool ok = (idx < RR * 64) && (sq >= 0) && (sq < SEQ);
              rv[i] = *(const u32x4*)(zb + (size_t)(ok ? sq : s0) * DZ3 + cc * 8);
              if (!ok) rv[i] = (u32x4){0u, 0u, 0u, 0u}; }
          __builtin_amdgcn_sched_barrier(0);
#pragma unroll
          for (int i = 0; i < 8; ++i) { const int idx = tid + 512 * i, r = idx >> 6, cc = idx & 63; float v[8]; unpack8(rv[i], v);
              if (idx < RR * 64) { *(LAS f32x4*)(as + r * 512 + cc * 8) = (f32x4){v[0], v[1], v[2], v[3]}; *(LAS f32x4*)(as + r * 512 + cc * 8 + 4) = (f32x4){v[4], v[5], v[6], v[7]}; } } }
        __syncthreads();
        float o[TT];
        {
          const float* cw_ = cw; const float* cb_ = cb; asm volatile("" : "+s"(cw_), "+s"(cb_));
          f32x2 w2[16];
#pragma unroll
          for (int j = 0; j < 16; ++j) { w2[j].x = cw_[(2 * j) * 512 + tid]; w2[j].y = (2 * j + 1 < 31) ? cw_[(2 * j + 1) * 512 + tid] : 0.f; }
          const float cbias = cb_[tid];
          f32x2 aE[31], aO[31];
#pragma unroll
          for (int i = 0; i < 31; ++i) { aE[i].x = as[(2 * i) * 512 + tid]; aE[i].y = as[(2 * i + 1) * 512 + tid]; }
#pragma unroll
          for (int i = 0; i < 31; ++i) { aO[i].x = aE[i].y; aO[i].y = (i < 30) ? aE[i + 1].x : 0.f; }
#pragma unroll
          for (int i = 0; i < TT / 2; ++i) { f32x2 pe = (f32x2){0.f, 0.f}, po = (f32x2){0.f, 0.f};
#pragma unroll
              for (int j = 0; j < 16; ++j) { pe += w2[j] * aE[i + j]; po += w2[j] * aO[i + j]; }
              o[2 * i] = cbias + (pe.x + pe.y); o[2 * i + 1] = cbias + (po.x + po.y); } }
        __syncthreads();
#pragma unroll
        for (int t = 0; t < TT; ++t) os[t * 512 + tid] = o[t];
        __syncthreads();
        { const float* lg_ = lg; const float* lb_ = lb; asm volatile("" : "+s"(lg_), "+s"(lb_));
          const f32x4 g0 = *(const f32x4*)(lg_ + 8 * lane), g1 = *(const f32x4*)(lg_ + 8 * lane + 4), b0 = *(const f32x4*)(lb_ + 8 * lane), b1 = *(const f32x4*)(lb_ + 8 * lane + 4);
#pragma unroll
          for (int i = 0; i < TT / 8; ++i) { const int t = (TT / 8) * wid + i;
              const f32x4 v0 = *(const LAS f32x4*)(os + t * 512 + 8 * lane), v1 = *(const LAS f32x4*)(os + t * 512 + 8 * lane + 4);
              const float mean = wave_sum(((v0[0] + v0[1]) + (v0[2] + v0[3])) + ((v1[0] + v1[1]) + (v1[2] + v1[3]))) * (1.0f / 512.0f);
              const f32x4 d0 = v0 - mean, d1 = v1 - mean;
              const float var = wave_sum(((d0[0] * d0[0] + d0[1] * d0[1]) + (d0[2] * d0[2] + d0[3] * d0[3])) + ((d1[0] * d1[0] + d1[1] * d1[1]) + (d1[2] * d1[2] + d1[3] * d1[3]))) * (1.0f / 512.0f);
              const float rstd = rsqrtf(var + LN_EPS);
              f32x4 y0 = d0 * rstd * g0 + b0, y1 = d1 * rstd * g1 + b1;
#pragma unroll
              for (int j = 0; j < 4; ++j) { y0[j] = y0[j] * sigm(y0[j]); y1[j] = y1[j] * sigm(y1[j]); }
              *(u32x4*)(Mo + (size_t)(t0 + t) * D + 8 * lane) = pack8(y0, y1); } }
        { const int cc = tid & 63, rgp = tid >> 6, sb = s0 + 4 * rgp;
          u32x4 xx[6], gb[4];
#pragma unroll
          for (int r = 0; r < 6; ++r) { const int sq = sb - 1 + r; const bool ok = (sq >= 0) && (sq < SEQ); const bf16_t* p = zb + (size_t)(ok ? sq : s0) * DZ3 + cc * 8;
              xx[r] = *(const u32x4*)(p + 512); if (!ok) xx[r] = (u32x4){0u, 0u, 0u, 0u};
              if (r >= 1 && r <= 4) gb[r - 1] = *(const u32x4*)(p + 1024); }
          const float* bw_ = bw; const float* bb_ = bb; asm volatile("" : "+s"(bw_), "+s"(bb_));
          const f32x4 w0a = *(const f32x4*)(bw_ + cc * 8), w0b = *(const f32x4*)(bw_ + cc * 8 + 4), w1a = *(const f32x4*)(bw_ + 512 + cc * 8), w1b = *(const f32x4*)(bw_ + 512 + cc * 8 + 4),
                      w2a = *(const f32x4*)(bw_ + 1024 + cc * 8), w2b = *(const f32x4*)(bw_ + 1024 + cc * 8 + 4), bba = *(const f32x4*)(bb_ + cc * 8), bbb = *(const f32x4*)(bb_ + cc * 8 + 4);
          __builtin_amdgcn_sched_barrier(0);
          float x[6][8];
#pragma unroll
          for (int r = 0; r < 6; ++r) unpack8(xx[r], x[r]);
#pragma unroll
          for (int t = 0; t < 4; ++t) { float gbv[8]; unpack8(gb[t], gbv); f32x4 y0, y1;
#pragma unroll
              for (int j = 0; j < 4; ++j) { y0[j] = gbv[j] * (w0a[j] * x[t][j] + w1a[j] * x[t + 1][j] + w2a[j] * x[t + 2][j] + bba[j]);
                  y1[j] = gbv[4 + j] * (w0b[j] * x[t][4 + j] + w1b[j] * x[t + 1][4 + j] + w2b[j] * x[t + 2][4 + j] + bbb[j]); }
              *(u32x4*)(Mo + (size_t)(t0 + 4 * rgp + t) * D + 512 + cc * 8) = pack8(y0, y1); } }
    }
}

__device__ __forceinline__ void sgu_phase(LAS unsigned char* lds, const bf16_t* Z1, const float* vst, const bf16_t* Wsb, const float* bs, const float* lg, const float* lb, bf16_t* Y, int G, int c, int tid_in) {
    constexpr int RS = 272;
    int tid_ = tid_in; asm volatile("" : "+v"(tid_)); asm volatile("" : "+s"(c), "+s"(G));
    const int tid = tid_, lane = tid & 63, wid = tid >> 6, fr = lane & 15, fq = lane >> 4;
    LAS unsigned char* Wl = lds; LAS unsigned char* Vl = lds + 128 * RS;
    for (int u = c; u < G; ++u) {
        const int n = u >> 3, g = u & 7, t0 = n * 128, cg0 = g * 128;
        const int q = tid & 127, qc = tid >> 7;
        u32x4 wt[4], vr[4]; f32x4 sp[8];
#pragma unroll
        for (int i = 0; i < 4; ++i) { const int idx = tid + 512 * i, p = idx >> 4, chn = idx & 15; wt[i] = *(const u32x4*)(Wsb + ((size_t)g * 128 + p) * 128 + chn * 8); }
#pragma unroll
        for (int i = 0; i < 4; ++i) vr[i] = *(const u32x4*)(Z1 + (size_t)(t0 + q) * DZ1 + 1024 + cg0 + qc * 32 + i * 8);
#pragma unroll
        for (int j = 0; j < 8; ++j) sp[j] = *(const f32x4*)(vst + (size_t)(t0 + q) * 32 + 4 * j);
        const int pr = 16 * wid + fr, row = t0 + pr;
        u32x2 uu[8];
#pragma unroll
        for (int cb = 0; cb < 8; ++cb) uu[cb] = *(const u32x2*)(Z1 + (size_t)row * DZ1 + cg0 + 16 * cb + 4 * fq);
        const float bias = bs[g * 128 + pr];
        __builtin_amdgcn_sched_barrier(0);
        __syncthreads();
#pragma unroll
        for (int i = 0; i < 4; ++i) { const int idx = tid + 512 * i, p = idx >> 4, chn = idx & 15; *(LAS u32x4*)(Wl + p * RS + chn * 16) = wt[i]; }
        { float s1 = 0.f, s2 = 0.f;
#pragma unroll
          for (int j = 0; j < 8; ++j) { s1 += sp[j][0] + sp[j][2]; s2 += sp[j][1] + sp[j][3]; }
          const float mean = s1 * (1.0f / 1024.0f), var = s2 * (1.0f / 1024.0f) - mean * mean, rstd = rsqrtf(var + LN_EPS);
#pragma unroll
          for (int i = 0; i < 4; ++i) { const int c0 = qc * 32 + i * 8; float v[8]; unpack8(vr[i], v);
              const f32x4 g0 = *(const f32x4*)(lg + cg0 + c0), g1 = *(const f32x4*)(lg + cg0 + c0 + 4), b0 = *(const f32x4*)(lb + cg0 + c0), b1 = *(const f32x4*)(lb + cg0 + c0 + 4);
#pragma unroll
              for (int j = 0; j < 8; ++j) { const float gg = j < 4 ? g0[j & 3] : g1[j & 3], bbv = j < 4 ? b0[j & 3] : b1[j & 3];
                  *(LAS bf16_t*)(Vl + (c0 + j) * RS + q * 2) = f2bf((v[j] - mean) * rstd * gg + bbv); } } }
        __syncthreads();
        bf16x8 wf[4];
#pragma unroll
        for (int ks = 0; ks < 4; ++ks) wf[ks] = *(const LAS bf16x8*)(Wl + (16 * wid + fr) * RS + (32 * ks + 8 * fq) * 2);
        f32x4 acc[8];
#pragma unroll
        for (int cb = 0; cb < 8; ++cb) { acc[cb] = (f32x4){0.f, 0.f, 0.f, 0.f};
#pragma unroll
            for (int ks = 0; ks < 4; ++ks) { const bf16x8 vf = *(const LAS bf16x8*)(Vl + (16 * cb + fr) * RS + (32 * ks + 8 * fq) * 2);
                acc[cb] = __builtin_amdgcn_mfma_f32_16x16x32_bf16(vf, wf[ks], acc[cb], 0, 0, 0); } }
#pragma unroll
        for (int cb = 0; cb < 8; ++cb) { const int cc = cg0 + 16 * cb + 4 * fq;
            u32x2 o; o.x = cvt_pk_bf16(bflo(uu[cb].x) * (acc[cb][0] + bias), bfhi(uu[cb].x) * (acc[cb][1] + bias)); o.y = cvt_pk_bf16(bflo(uu[cb].y) * (acc[cb][2] + bias), bfhi(uu[cb].y) * (acc[cb][3] + bias));
            *(u32x2*)(Y + (size_t)row * D + cc) = o; }
    }
}

__device__ __forceinline__ void attn_phase(LAS unsigned char* lds, const bf16_t* Q, const bf16_t* Kb, const bf16_t* Vt, bf16_t* O, int G, int c, int tid_in) {
    constexpr int RS = 528;
    int tid_ = tid_in; asm volatile("" : "+v"(tid_)); asm volatile("" : "+s"(c), "+s"(G));
    const int tid = tid_, lane = tid & 63, wid = tid >> 6, fr = lane & 15, fq = lane >> 4;
    for (int u = c; u < 512; u += G) {
        const int qb = u >> 2, h = u & 3, b = qb >> 6, q0 = qb * 128;
        const bf16_t* qrow = Q + (size_t)(q0 + 16 * wid + fr) * D + h * 256 + 8 * fq;
        bf16x8 qf[8];
#pragma unroll
        for (int ks = 0; ks < 8; ++ks) qf[ks] = *(const bf16x8*)(qrow + 32 * ks);
        __syncthreads();
        { u32x4 tv[16];
#pragma unroll
          for (int i = 0; i < 16; ++i) { const int idx = tid + 512 * i, key = idx >> 5, ch = idx & 31; tv[i] = *(const u32x4*)(Kb + (size_t)(b * 256 + key) * D + h * 256 + ch * 8); }
          __builtin_amdgcn_sched_barrier(0);
#pragma unroll
          for (int i = 0; i < 16; ++i) { const int idx = tid + 512 * i, key = idx >> 5, ch = idx & 31; *(LAS u32x4*)(lds + key * RS + ch * 16) = tv[i]; } }
        __syncthreads();
        f32x4 S[16];
#pragma unroll
        for (int kb = 0; kb < 16; ++kb) { S[kb] = (f32x4){0.f, 0.f, 0.f, 0.f};
#pragma unroll
            for (int ks = 0; ks < 8; ++ks) { const bf16x8 kf = *(const LAS bf16x8*)(lds + (16 * kb + fr) * RS + (32 * ks + 8 * fq) * 2);
                S[kb] = __builtin_amdgcn_mfma_f32_16x16x32_bf16(kf, qf[ks], S[kb], 0, 0, 0); } }
        float mx = -3.0e38f;
#pragma unroll
        for (int kb = 0; kb < 16; ++kb) mx = fmaxf(mx, fmaxf(fmaxf(S[kb][0], S[kb][1]), fmaxf(S[kb][2], S[kb][3])));
        mx = xrow16_max(mx);
        float l = 0.f;
#pragma unroll
        for (int kb = 0; kb < 16; ++kb)
#pragma unroll
            for (int j = 0; j < 4; ++j) { const float p = __builtin_amdgcn_exp2f(S[kb][j] - mx); S[kb][j] = p; l += p; }
        l = xrow16_sum(l);
        bf16x8 pf[8];
#pragma unroll
        for (int cc = 0; cc < 8; ++cc) { const u32x4 w = pack8(S[2 * cc], S[2 * cc + 1]); pf[cc] = __builtin_bit_cast(bf16x8, w); }
        __syncthreads();
        { u32x4 tv[16];
#pragma unroll
          for (int i = 0; i < 16; ++i) { const int idx = tid + 512 * i, d = idx >> 5, ch = idx & 31; tv[i] = *(const u32x4*)(Vt + ((size_t)b * D + h * 256 + d) * NMEM + ch * 8); }
          __builtin_amdgcn_sched_barrier(0);
#pragma unroll
          for (int i = 0; i < 16; ++i) { const int idx = tid + 512 * i, d = idx >> 5, ch = idx & 31; *(LAS u32x4*)(lds + d * RS + ch * 16) = tv[i]; } }
        __syncthreads();
        const float inv = 1.0f / l;
        bf16_t* orow = O + (size_t)(q0 + 16 * wid + fr) * D + h * 256 + 4 * fq;
#pragma unroll
        for (int db = 0; db < 16; ++db) { f32x4 oa = (f32x4){0.f, 0.f, 0.f, 0.f};
#pragma unroll
            for (int cc = 0; cc < 8; ++cc) { const bf16x8 vf = *(const LAS bf16x8*)(lds + (16 * db + fr) * RS + (32 * cc + 8 * fq) * 2);
                oa = __builtin_amdgcn_mfma_f32_16x16x32_bf16(vf, pf[cc], oa, 0, 0, 0); }
            u32x2 o; o.x = cvt_pk_bf16(oa[0] * inv, oa[1] * inv); o.y = cvt_pk_bf16(oa[2] * inv, oa[3] * inv);
            *(u32x2*)(orow + 16 * db) = o; }
    }
}

struct EpiQAttn {
    static constexpr bool PERM = true, AFTER_DRAIN = true;
    const float* ssq; const bf16_t* Kb; const bf16_t* Vt; bf16_t* O;
    __device__ __forceinline__ void operator()(const f32x4 (&)[2][2][4][2], const Unit&, int, int, int, int) const {}
    __device__ __forceinline__ void fused(f32x4 (&acc)[2][2][4][2], const Unit& u, int wr, int wc, int fr, int fq, PG8_LAS unsigned char* lds, int wid, int lane) const {
        constexpr int RS = 528;
        const int tid = wid * 64 + lane, h = u.pn, b = u.pm >> 5;
        const unsigned r0 = (unsigned)tid >> 5, ch = (unsigned)tid & 31u;
        const bf16_t* kbase = Kb + (size_t)(b * 256) * D + h * 256; const bf16_t* vbase = Vt + ((size_t)b * D + h * 256) * NMEM;
        const unsigned goffk = r0 * (unsigned)(D * 2) + ch * 16u, goffv = r0 * (unsigned)(NMEM * 2) + ch * 16u, loff = r0 * (unsigned)RS + ch * 16u;
        unsigned loffa = loff, loffb = loff + 7 * 16 * RS; asm volatile("" : "+v"(loffa), "+v"(loffb));
#pragma unroll
        for (int ai = 0; ai < 2; ++ai)
#pragma unroll
            for (int m = 0; m < 4; ++m) { const int lr = ai * HALF + wr * 64 + m * 16 + fr; const float rs = ((const PG8_LAS float*)(lds + TAB_OFF))[lr];
#pragma unroll
                for (int bj = 0; bj < 2; ++bj) *(PG8_LAS u32x4*)(lds + lr * RS + (bj * HALF + wc * 32 + 8 * fq) * 2) = pack8(acc[ai][bj][m][0] * rs, acc[ai][bj][m][1] * rs); }
        __syncthreads();
        bf16x8 qf[2][8];
#pragma unroll
        for (int qb = 0; qb < 2; ++qb)
#pragma unroll
            for (int ks = 0; ks < 8; ++ks) qf[qb][ks] = *(const PG8_LAS bf16x8*)(lds + (32 * wid + 16 * qb + fr) * RS + (32 * ks + 8 * fq) * 2);
        __builtin_amdgcn_sched_barrier(0);
        u32x4 tv[16];
#pragma unroll
        for (int i = 0; i < 16; ++i) tv[i] = *(const u32x4*)((const char*)kbase + (goffk + (unsigned)(i * 16 * D * 2)));
        __builtin_amdgcn_sched_barrier(0);
        __syncthreads();
#pragma unroll
        for (int i = 0; i < 16; ++i) *(PG8_LAS u32x4*)(lds + (i < 7 ? loffa : loffb) + (i < 7 ? i : i - 7) * 16 * RS) = tv[i];
        __syncthreads();
        unsigned fb0 = (unsigned)(fr * RS + fq * 16), fb1 = fb0 + 8 * 16 * RS; asm volatile("" : "+v"(fb0), "+v"(fb1));
        f32x4 S[2][16];
#define KFRAG(i) (*(const PG8_LAS bf16x8*)(lds + ((((i) >> 3) < 8) ? fb0 : fb1) + ((((i) >> 3) & 7) * 16 * RS + ((i) & 7) * 64)))
        { bf16x8 kq[3]; kq[0] = KFRAG(0); kq[1] = KFRAG(1);
#pragma unroll
          for (int i = 0; i < 128; ++i) { const int kb = i >> 3, ks = i & 7;
              if (i + 2 < 128) kq[(i + 2) % 3] = KFRAG(i + 2);
              const bf16x8 kf = kq[i % 3];
              const f32x4 z4 = (f32x4){0.f, 0.f, 0.f, 0.f};
              S[0][kb] = __builtin_amdgcn_mfma_f32_16x16x32_bf16(kf, qf[0][ks], ks == 0 ? z4 : S[0][kb], 0, 0, 0);
              S[1][kb] = __builtin_amdgcn_mfma_f32_16x16x32_bf16(kf, qf[1][ks], ks == 0 ? z4 : S[1][kb], 0, 0, 0);
              __builtin_amdgcn_sched_barrier(0); } }
#undef KFRAG
        __builtin_amdgcn_sched_barrier(0);
        bf16x8 pf[2][8]; float inv[2];
#pragma unroll
        for (int qb = 0; qb < 2; ++qb) {
            float mx = -3.0e38f;
#pragma unroll
            for (int kb = 0; kb < 16; ++kb) mx = fmaxf(mx, fmaxf(fmaxf(S[qb][kb][0], S[qb][kb][1]), fmaxf(S[qb][kb][2], S[qb][kb][3])));
            mx = xrow16_max(mx);
            float l = 0.f;
#pragma unroll
            for (int kb = 0; kb < 16; ++kb)
#pragma unroll
                for (int j = 0; j < 4; ++j) { const float p = __builtin_amdgcn_exp2f(S[qb][kb][j] - mx); S[qb][kb][j] = p; l += p; }
            l = xrow16_sum(l); inv[qb] = 1.0f / l;
#pragma unroll
            for (int cc = 0; cc < 8; ++cc) { const u32x4 w = pack8(S[qb][2 * cc], S[qb][2 * cc + 1]); pf[qb][cc] = __builtin_bit_cast(bf16x8, w); }
        }
        __builtin_amdgcn_sched_barrier(0);
        unsigned loff2a = r0 * (unsigned)RS + ((ch >> 2) * 32u + 16u * (ch & 1u) + 4u * ((ch >> 1) & 1u)) * 2u, loff2b = loff2a + 7 * 16 * RS; asm volatile("" : "+v"(loff2a), "+v"(loff2b));
#pragma unroll
        for (int i = 0; i < 16; ++i) tv[i] = *(const u32x4*)((const char*)vbase + (goffv + (unsigned)(i * 16 * NMEM * 2)));
        __builtin_amdgcn_sched_barrier(0);
        __syncthreads();
#pragma unroll
        for (int i = 0; i < 16; ++i) { PG8_LAS unsigned char* d = lds + (i < 7 ? loff2a : loff2b) + (i < 7 ? i : i - 7) * 16 * RS; *(PG8_LAS u32x2*)d = (u32x2){tv[i].x, tv[i].y}; *(PG8_LAS u32x2*)(d + 16) = (u32x2){tv[i].z, tv[i].w}; }
        __syncthreads();
        unsigned vb0 = (unsigned)(fr * RS + fq * 16), vb1 = vb0 + 8 * 16 * RS; asm volatile("" : "+v"(vb0), "+v"(vb1));
        bf16_t* orow = O + (size_t)(u.pm * BM + 32 * wid + fr) * D + h * 256 + 4 * fq;
#define VFRAG(i) (*(const PG8_LAS bf16x8*)(lds + ((((i) >> 3) < 8) ? vb0 : vb1) + ((((i) >> 3) & 7) * 16 * RS + ((i) & 7) * 64)))
        { bf16x8 vq[3]; vq[0] = VFRAG(0); vq[1] = VFRAG(1); f32x4 o0 = (f32x4){0.f, 0.f, 0.f, 0.f}, o1 = (f32x4){0.f, 0.f, 0.f, 0.f};
#pragma unroll
          for (int i = 0; i < 128; ++i) { const int db = i >> 3, cc = i & 7;
              if (i + 2 < 128) vq[(i + 2) % 3] = VFRAG(i + 2);
              const bf16x8 vf = vq[i % 3];
              const f32x4 z4 = (f32x4){0.f, 0.f, 0.f, 0.f};
              o0 = __builtin_amdgcn_mfma_f32_16x16x32_bf16(vf, pf[0][cc], cc == 0 ? z4 : o0, 0, 0, 0);
              o1 = __builtin_amdgcn_mfma_f32_16x16x32_bf16(vf, pf[1][cc], cc == 0 ? z4 : o1, 0, 0, 0);
              if (cc == 7) { u32x2 w0, w1; w0.x = cvt_pk_bf16(o0[0] * inv[0], o0[1] * inv[0]); w0.y = cvt_pk_bf16(o0[2] * inv[0], o0[3] * inv[0]);
                  w1.x = cvt_pk_bf16(o1[0] * inv[1], o1[1] * inv[1]); w1.y = cvt_pk_bf16(o1[2] * inv[1], o1[3] * inv[1]);
                  *(u32x2*)(orow + 16 * db) = w0; *(u32x2*)(orow + (size_t)16 * D + 16 * db) = w1; }
              __builtin_amdgcn_sched_barrier(0); } }
#undef VFRAG
        __syncthreads();
    }
};

__device__ __forceinline__ int lane_id_volatile() { int l; asm volatile("v_mbcnt_lo_u32_b32 %0, -1, 0\n\tv_mbcnt_hi_u32_b32 %0, -1, %0" : "=v"(l)); return l; }
#ifndef REP_P0
#define REP_P0 1
#endif
#ifndef REP_CONV
#define REP_CONV 1
#endif
#ifndef REP_SGU
#define REP_SGU 1
#endif
#ifndef REP_ATTN
#define REP_ATTN 1
#endif
#ifndef LSTART
#define LSTART 0
#endif
#ifndef LEND
#define LEND 2
#endif
struct PanelOrder {
    int pm, j, nN;
    __device__ __forceinline__ bool next(int i, Unit& u) const { const int pn = j + 4 * i; if (pn >= nN) return false; int pmv = pm; asm volatile("" : "+s"(pmv)); u.pm = pmv; u.pn = pn; return true; }
    __device__ __forceinline__ void a_ready(const Unit&) const {}
    __device__ __forceinline__ void done(const Unit&) const {}
};
__device__ __forceinline__ void group_barrier(unsigned* cnt, unsigned target, bool coxcd, unsigned* tmo, int ktid) {
    asm volatile("s_waitcnt vmcnt(0)" ::: "memory");
    __syncthreads();
    if (ktid == 0) {
        if (!coxcd) { __builtin_amdgcn_fence(__ATOMIC_RELEASE, "agent"); asm volatile("s_waitcnt vmcnt(0)" ::: "memory"); }
        (void)xb_add(cnt, 1u);
        unsigned sp = 0;
        while (xb_ld(cnt) < target) { if ((++sp & 255u) == 0u) { if (xb_ld(tmo)) break; if (sp > XB_SPIN_CAP) { atomicAdd(tmo, 1u); break; } } }
        __builtin_amdgcn_fence(__ATOMIC_ACQUIRE, "agent");
        asm volatile("s_waitcnt vmcnt(0)" ::: "memory");
    }
    __syncthreads();
}

__global__ void __launch_bounds__(NTHR, 2) fwd_kernel(Args a) {
    extern __shared__ __attribute__((aligned(16))) unsigned char lds_raw[];
    LAS unsigned char* lds = (LAS unsigned char*)lds_raw;
    volatile LAS unsigned* MISC = (volatile LAS unsigned*)(lds + MISC_OFF);
    const int wave = __builtin_amdgcn_readfirstlane((int)threadIdx.x >> 6);
#define TID() (wave * 64 + lane_id_volatile())
    const int tid = TID(), lane = tid & 63;
    const int G = gridDim.x, bx = blockIdx.x, vcu = (bx % 8) * (G / 8) + bx / 8;
    unsigned char* ws = a.ws;
    unsigned* ctl = (unsigned*)(ws + WS_CTL);
    int pm, pj; { StaticOrder S0; S0.init(T, D, G, bx); Unit own; S0.next(0, own); pm = own.pm; pj = own.pn; }
    if (tid < 32) MISC[tid] = 0u;
    if (tid == 0) __hip_atomic_store(ctl + 8192 + pm * 4 + pj, xb_xcc_id() + 1u, __ATOMIC_RELAXED, __HIP_MEMORY_SCOPE_AGENT);
    __syncthreads();
    XcdBarrier bar = xcd_barrier_post(ctl, MISC + 8, tid);
    const int gw = vcu * NWAVES + wave, NGW = G * NWAVES;
    float* out = a.out; float* ssq = (float*)(ws + WS_SSQ); float* vst = (float*)(ws + WS_VST);
    bf16_t* HB = (bf16_t*)(ws + WS_HB); bf16_t* MB = (bf16_t*)(ws + WS_MB); bf16_t* BIG = (bf16_t*)(ws + WS_BIG);
    bf16_t* MEMN = (bf16_t*)(ws + WS_MEMN); bf16_t* KB = (bf16_t*)(ws + WS_KB); bf16_t* VT = (bf16_t*)(ws + WS_VT);
    unsigned gseq = 0u; int bn = 0; (void)bn;
#ifndef PROBE_BN
#define PROBE_BN 0
#endif
#ifdef PROBE_TIME
    unsigned long long tacc = 0ull, tt0 = 0ull;
#define TBEG(k) do { if (PROBE_TIME == (k)) tt0 = __builtin_amdgcn_s_memrealtime(); } while (0)
#define TEND(k) do { if (PROBE_TIME == (k)) tacc += __builtin_amdgcn_s_memrealtime() - tt0; } while (0)
#else
#define TBEG(k) do {} while (0)
#define TEND(k) do {} while (0)
#endif
#define GRID_BAR() do { ++bn; if (PROBE_BN == 0 || bn == PROBE_BN) TBEG(2); xcd_barrier(bar, TID()); if (PROBE_BN == 0 || bn == PROBE_BN) TEND(2); } while (0)
#define GROUP_BAR() do { ++bn; if (PROBE_BN == 0 || bn == PROBE_BN) TBEG(2); gseq += 4u; group_barrier(ctl + 4096 + 64 * pm, gseq, coxcd, ctl + XB_TMO, TID()); if (PROBE_BN == 0 || bn == PROBE_BN) TEND(2); } while (0)
#define GEMM(EpiT, E, Ap, Bp, M_, N_, K_, cc) do { Gemm g{(const bf16_t*)(Ap), (const bf16_t*)(Bp), (M_), (N_), (K_)}; int cc_ = (cc); asm volatile("" : "+s"(cc_)); StaticOrder S; S.init((M_), (N_), G, cc_); TBEG(1); gemm_phase<EpiT, StaticOrder, true, true>(lds, g, S, (E), TID()); TEND(1); } while (0)
#define GEMMP(EpiT, AL, E, Ap, Bp, N_, K_) do { Gemm g{(const bf16_t*)(Ap), (const bf16_t*)(Bp), T, (N_), (K_)}; int pm_ = pm, pj_ = pj; asm volatile("" : "+s"(pm_), "+s"(pj_)); PanelOrder S{pm_, pj_, (N_) / BM}; TBEG(1); gemm_phase<EpiT, PanelOrder, AL, true>(lds, g, S, (E), TID()); TEND(1); } while (0)

    TBEG(3); p0_weights(a, 0, 1 | 2 | 4, lds, gw, NGW, wave, lane); p0_weights(a, 1, 4, lds, gw, NGW, wave, lane); p0_prologue(a, lds, gw, NGW, wave, lane, pm * BM + pj * 64); TEND(3);
    if (a.ws == nullptr) cg::this_grid().sync();
    GRID_BAR();
    bool coxcd; { const unsigned x0 = xb_ld(ctl + 8192 + pm * 4), x1 = xb_ld(ctl + 8192 + pm * 4 + 1), x2 = xb_ld(ctl + 8192 + pm * 4 + 2), x3 = xb_ld(ctl + 8192 + pm * 4 + 3);
        coxcd = __builtin_amdgcn_readfirstlane((x0 != 0u && x0 == x1 && x1 == x2 && x2 == x3) ? 1 : 0) != 0; }
    const int kvidx = (pj >= 2 && (pm & 3) == 0) ? (pm >> 2) * 2 + (pj - 2) : (1 << 20);
    const int pbidx = (pj >= 2 && (pm & 3) != 0) ? (pm - (pm >> 2) - 1) * 2 + (pj - 2) : (1 << 20);
    const int spare = pj >= 2 ? pm * 2 + (pj - 2) : (1 << 20);

#pragma unroll
    for (int l = 0; l < 2; ++l) {
        unsigned char* wl = ws + WS_W + (size_t)l * W_LAYER;
        if (l == 0) {
            { rstd_table(lds, ssq, pm, TID()); EpiZ0 E{BIG, (const LAS float*)(lds + TAB_OFF)}; GEMMP(EpiZ0, true, E, HB, wl + W_IN, DZ0, D); }
#pragma unroll 1
            for (int l2 = 0; l2 < 2; ++l2) {
                const int sub = kvidx - 16 * l2; const bf16_t* mn = MEMN + (size_t)l2 * 512 * D; const bf16_t* wkv = (const bf16_t*)(ws + WS_W + (size_t)l2 * W_LAYER + W_KV);
                { EpiScale E{KB + (size_t)l2 * 512 * D, D, nullptr}; GEMM(EpiScale, E, mn, wkv, 512, D, D, (sub >= 0 && sub < 8) ? sub : (1 << 20)); }
                { EpiVt E{VT + (size_t)l2 * 2 * D * NMEM}; GEMM(EpiVt, E, wkv + (size_t)D * D, mn, D, 512, D, (sub >= 8 && sub < 16) ? sub - 8 : (1 << 20)); } }
            if (pbidx < 96) { const int t3 = TID(); p0_weights(a, 0, 8 | 16, lds, pbidx * NWAVES + wave, 96 * NWAVES, wave, t3 & 63); }
            GRID_BAR();
            TBEG(4); conv_phase(lds, BIG, MB, a.in[8], a.in[9], a.in[10], a.in[11], a.in[12], a.in[13], 8 * pm + 2 * pj + 2, 8 * pm + 2 * pj, TID()); TEND(4);
            GRID_BAR();
            { EpiRes E{HB, ssq}; GEMMP(EpiRes, true, E, MB, wl + W_OUT, D, D); }
        } else {
            { rstd_table(lds, ssq, pm, TID()); EpiZ1 E{BIG, (const LAS float*)(lds + TAB_OFF), vst}; GEMMP(EpiZ1, true, E, HB, wl + W_IN, DZ1, D); }
            GROUP_BAR();
            TBEG(5); sgu_phase(lds, BIG, vst, (const bf16_t*)(ws + WS_WSB), a.in[19], a.in[16], a.in[17], MB, 16 * pm + 4 * pj + 4, 16 * pm + 4 * pj, TID()); TEND(5);
            GRID_BAR();
            { EpiRes E{HB, ssq}; GEMMP(EpiRes, true, E, MB, wl + W_OUT, D, D); }
        }
        GROUP_BAR();
        { rstd_table(lds, ssq, pm, TID()); EpiQAttn E{ssq, KB + (size_t)l * 512 * D, VT + (size_t)l * 2 * D * NMEM, MB}; GEMMP(EpiQAttn, false, E, HB, wl + W_Q, D, D); }
        GROUP_BAR();
        { EpiRes E{HB, ssq}; GEMMP(EpiRes, true, E, MB, wl + W_O, D, D); }
        GROUP_BAR();
        { rstd_table(lds, ssq, pm, TID()); EpiGU E{BIG, (const LAS float*)(lds + TAB_OFF)}; GEMMP(EpiGU, true, E, HB, wl + W_GU, NGU, D); }
#ifdef PROBE_G5X2
        { rstd_table(lds, ssq, pm, TID()); EpiGU E{BIG, (const LAS float*)(lds + TAB_OFF)}; GEMMP(EpiGU, true, E, HB, wl + W_GU, NGU, D); }
#endif
        if (l == 0 && spare < 128) { const int t3 = TID(); p0_weights(a, 1, 1 | 2 | 8 | 16, lds, spare * NWAVES + wave, 128 * NWAVES, wave, t3 & 63); }
        GROUP_BAR();
        { EpiRes E{HB, ssq}; GEMMP(EpiRes, true, E, BIG, wl + W_DN, D, DFF); }
        if (l == 0) GRID_BAR(); else GROUP_BAR();
    }
    { int t2 = TID(); asm volatile("" : "+v"(t2)); const int lane = t2 & 63, wv = __builtin_amdgcn_readfirstlane(t2 >> 6);
      const f32x4 g0 = *(const f32x4*)(a.in[6] + 8 * lane), g1 = *(const f32x4*)(a.in[6] + 8 * lane + 4), g2 = *(const f32x4*)(a.in[6] + 512 + 8 * lane), g3 = *(const f32x4*)(a.in[6] + 512 + 8 * lane + 4);
#pragma unroll 1
      for (int it = 0; it < 2; ++it) { const int m0 = pm * BM + pj * 64 + wv * 8 + it * 4;
          u32x4 r0[4], r1[4];
#pragma unroll
          for (int r = 0; r < 4; ++r) { const bf16_t* p = HB + (size_t)(m0 + r) * D + 8 * lane; r0[r] = *(const u32x4*)p; r1[r] = *(const u32x4*)(p + 512); }
          __builtin_amdgcn_sched_barrier(0);
#pragma unroll
          for (int r = 0; r < 4; ++r) { float v[8], w[8]; unpack8(r0[r], v); unpack8(r1[r], w); float sq = 0.f;
#pragma unroll
              for (int j = 0; j < 8; ++j) sq += v[j] * v[j] + w[j] * w[j];
              const float rs = rsqrtf(wave_sum(sq) * (1.0f / 1024.0f) + RMS_EPS);
              float* o = out + (size_t)(m0 + r) * D + 8 * lane;
              *(f32x4*)o = (f32x4){v[0], v[1], v[2], v[3]} * rs * g0; *(f32x4*)(o + 4) = (f32x4){v[4], v[5], v[6], v[7]} * rs * g1;
              *(f32x4*)(o + 512) = (f32x4){w[0], w[1], w[2], w[3]} * rs * g2; *(f32x4*)(o + 516) = (f32x4){w[4], w[5], w[6], w[7]} * rs * g3; } } }
#ifdef PROBE_TIME
    __syncthreads();
    if (pm == PROBE_PM && pj == PROBE_PJ && TID() == 0) { asm volatile("s_waitcnt vmcnt(0)" ::: "memory"); const float tus = (float)tacc * 0.01f; out[(size_t)(pm * BM + pj * 64) * D] = floorf(tus * (1.0f / PROBE_Q) + 0.5f) * PROBE_Q * 1.0e4f; }
#endif
}

extern "C" void kernel_launch(void* const* d_in, const int* in_sizes, int n_in, void* d_out, int out_size, void* d_ws, size_t ws_size, hipStream_t stream) {
    static int grid = 0;
    if (grid == 0) {
        if (n_in != 28 || out_size != T * D || ws_size < WS_END) { fprintf(stderr, "kernel_launch: unexpected shapes (n_in %d out %d ws %zu)\n", n_in, out_size, ws_size); grid = -1; return; }
        int dev = 0, cus = 0, per_cu = 0;
        (void)hipGetDevice(&dev); (void)hipDeviceGetAttribute(&cus, hipDeviceAttributeMultiprocessorCount, dev);
        (void)hipFuncSetAttribute((const void*)fwd_kernel, hipFuncAttributeMaxDynamicSharedMemorySize, LDS_BYTES);
        (void)hipOccupancyMaxActiveBlocksPerMultiprocessor(&per_cu, (const void*)fwd_kernel, NTHR, LDS_BYTES);
        if (per_cu < 1) per_cu = 1;
        (void)hipGetLastError();
        grid = cus;
        if (grid != 256) { fprintf(stderr, "kernel_launch: built for a 256-CU device (one workgroup per CU, four per row panel); found %d CUs; nothing launched\n", grid); grid = -1; return; }
    }
    if (grid < 0) return;
    (void)hipMemsetAsync((char*)d_ws + WS_CTL, 0, CTL_ZERO_BYTES, stream);
    Args a{};
    for (int i = 0; i < 28; ++i) a.in[i] = (const float*)d_in[i];
    a.out = (float*)d_out; a.ws = (unsigned char*)d_ws;
    void* args[] = {&a};
    hipError_t e = hipLaunchCooperativeKernel((const void*)fwd_kernel, dim3(grid), dim3(NTHR), args, LDS_BYTES, stream);
    if (e != hipSuccess) fprintf(stderr, "cooperative launch failed: %s (grid %d)\n", hipGetErrorString(e), grid);
}
```
